# Optimizing an MI355X kernel written in HIP

```python
import math
import jax, jax.numpy as jnp
from jax import lax
import numpy as np

D_MODEL = 1024
BATCH = 4
SEQ = 4096
DEPTH = 4

N_MIXERS = 2
N_HEADS = 8
HEAD_DIM = D_MODEL // N_HEADS
MOBA_BLOCK = 256
MOBA_TOPK = 3
MOBA_QCHUNK = 128
NUM_BUCKETS = 32
REL_MAX_DISTANCE = 128
LRU_WIDTH = D_MODEL
LRU_BLOCKS = 4
LRU_BLOCK_WIDTH = LRU_WIDTH // LRU_BLOCKS
CONV_WIDTH = 4
LRU_C = 8.0
N_EXPERTS = 32
EXPERT_TOPK = 4
D_FF = D_MODEL
SWIGLU_LIMIT = 7.0
SWIGLU_ALPHA = 1.702
EXPERT_CHUNK = 128
LN_EPS = 1e-5
DEEPNORM_ALPHA = (2 * DEPTH) ** 0.25
DEEPNORM_BETA = (8 * DEPTH) ** -0.25
N_MOBA_LAYERS = (DEPTH + N_MIXERS - 1) // N_MIXERS
N_LRU_LAYERS = DEPTH // N_MIXERS

kernel_name = 'hybrid_moba_rglru_moe_deepnorm'


def _layer_norm(x, g, b):
    xf = x.astype(jnp.float32)
    mu = jnp.mean(xf, axis=-1, keepdims=True)
    var = jnp.mean(jnp.square(xf - mu), axis=-1, keepdims=True)
    y = (xf - mu) * lax.rsqrt(var + LN_EPS)
    return (y * g.astype(jnp.float32) + b.astype(jnp.float32)).astype(x.dtype)


def _t5_bucket(dist):
    max_exact = NUM_BUCKETS // 2
    n = dist.astype(jnp.float32)
    large = max_exact + (jnp.log(jnp.maximum(n, 1.0) / max_exact)
                         / math.log(REL_MAX_DISTANCE / max_exact)
                         * (NUM_BUCKETS - max_exact)).astype(jnp.int32)
    large = jnp.minimum(large, NUM_BUCKETS - 1)
    return jnp.where(dist < max_exact, dist, large)


def _grouped_layout(ids, n_groups, chunk):
    n = ids.shape[0]
    n_rows = n + n_groups * chunk
    counts = jax.ops.segment_sum(jnp.ones_like(ids), ids, num_segments=n_groups + 1)[:n_groups]
    padded = (counts + chunk - 1) // chunk * chunk
    pad_end = jnp.cumsum(padded)
    pad_start = pad_end - padded
    raw_start = jnp.cumsum(counts) - counts
    order = jnp.argsort(ids)
    sorted_ids = ids[order]
    grp = jnp.minimum(sorted_ids, n_groups - 1)
    rank = jnp.arange(n, dtype=jnp.int32) - raw_start[grp]
    dest_sorted = jnp.where(sorted_ids < n_groups, pad_start[grp] + rank, n_rows).astype(jnp.int32)
    dest = jnp.zeros_like(ids).at[order].set(dest_sorted)
    starts = jnp.arange(n_rows // chunk, dtype=jnp.int32) * chunk
    chunk_group = jnp.sum((pad_end[None, :] <= starts[:, None]).astype(jnp.int32), axis=1)
    chunk_group = jnp.minimum(chunk_group, n_groups - 1)
    return dest, chunk_group, n_rows


def _moba_head(q, k, v, bias_by_dist):
    tp, dh = q.shape
    nblk = tp // MOBA_BLOCK
    k_sel = min(MOBA_TOPK, nblk)
    q = q.astype(jnp.float32)
    k = k.astype(jnp.float32)
    v = v.astype(jnp.float32)
    q_blk = jnp.arange(tp, dtype=jnp.int32) // MOBA_BLOCK
    kb = k.reshape(nblk, MOBA_BLOCK, dh)
    vb = v.reshape(nblk, MOBA_BLOCK, dh)

    qb = q.reshape(nblk, MOBA_BLOCK, dh)
    rel = jnp.arange(MOBA_BLOCK)[:, None] - jnp.arange(MOBA_BLOCK)[None, :]
    s_self = jnp.einsum('nqd,nkd->nqk', qb, kb) + bias_by_dist[jnp.maximum(rel, 0)]
    s_self = jnp.where(rel >= 0, s_self, -jnp.inf)
    m_self = jnp.max(s_self, axis=-1, keepdims=True)
    p_self = jnp.exp(s_self - m_self)
    l_self = jnp.sum(p_self, axis=-1, keepdims=True)
    o_self = (jnp.einsum('nqk,nkd->nqd', p_self, vb) / l_self).reshape(tp, dh)
    lse_self = (m_self + jnp.log(l_self)).reshape(tp)

    k_mean = jnp.mean(kb, axis=1)
    gate = q @ k_mean.T
    past = jnp.arange(nblk)[None, :] < q_blk[:, None]
    _, sel = lax.top_k(jnp.where(past, gate, -jnp.inf), k_sel)
    valid = jnp.arange(k_sel)[None, :] < q_blk[:, None]
    ids = jnp.where(valid, sel, nblk).reshape(-1).astype(jnp.int32)
    n_assign = tp * k_sel

    dest, chunk_blk, n_rows = _grouped_layout(ids, nblk, MOBA_QCHUNK)
    n_chunks = n_rows // MOBA_QCHUNK
    src = jnp.full((n_rows,), n_assign, jnp.int32).at[dest].set(
        jnp.arange(n_assign, dtype=jnp.int32), mode='drop')
    tq = (src // k_sel).reshape(n_chunks, MOBA_QCHUNK)
    q_ext = jnp.concatenate([q, jnp.zeros((1, dh), q.dtype)], axis=0)
    qg = q_ext[tq]
    kg = kb[chunk_blk]
    vg = vb[chunk_blk]
    k_pos = chunk_blk[:, None] * MOBA_BLOCK + jnp.arange(MOBA_BLOCK)[None, :]
    dist = jnp.clip(tq[:, :, None] - k_pos[:, None, :], 0, tp)
    s = jnp.einsum('cqd,ckd->cqk', qg, kg) + bias_by_dist[dist]
    m = jnp.max(s, axis=-1, keepdims=True)
    p = jnp.exp(s - m)
    l = jnp.sum(p, axis=-1, keepdims=True)
    o_g = (jnp.einsum('cqk,ckd->cqd', p, vg) / l).reshape(n_rows, dh)
    lse_g = (m + jnp.log(l)).reshape(n_rows)

    row = jnp.minimum(dest, n_rows - 1)
    o_sel = o_g[row].reshape(tp, k_sel, dh)
    lse_sel = jnp.where(valid, lse_g[row].reshape(tp, k_sel), -jnp.inf)
    w = jax.nn.softmax(jnp.concatenate([lse_self[:, None], lse_sel], axis=1), axis=-1)
    return w[:, :1] * o_self + jnp.einsum('tk,tkd->td', w[:, 1:], o_sel)


def _moba_mixer(x, w_qkv, w_o, rel_bias_table):
    b, t, d = x.shape
    tp = -(-t // MOBA_BLOCK) * MOBA_BLOCK
    qkv = x @ w_qkv
    q, k, v = jnp.split(qkv, 3, axis=-1)
    def heads(z):
        z = z.reshape(b, t, N_HEADS, HEAD_DIM).transpose(0, 2, 1, 3)
        return jnp.pad(z, ((0, 0), (0, 0), (0, tp - t), (0, 0)))
    q = heads(q) * (HEAD_DIM ** -0.5)
    k = heads(k)
    v = heads(v)
    bias_by_dist = rel_bias_table.astype(jnp.float32)[_t5_bucket(jnp.arange(tp + 1, dtype=jnp.int32))].T
    head_fn = jax.vmap(_moba_head, in_axes=(0, 0, 0, 0))
    o = lax.map(lambda a: head_fn(a[0], a[1], a[2], bias_by_dist), (q, k, v))
    o = o[:, :, :t].transpose(0, 2, 1, 3).reshape(b, t, d).astype(x.dtype)
    return o @ w_o


def _rglru_mixer(x, w_in, conv_w, conv_b, w_gx, b_gx, w_ga, b_ga, a_param, w_out):
    b, t, d = x.shape
    yz = x @ w_in
    y_br, r = jnp.split(yz, 2, axis=-1)
    y_br = jax.nn.gelu(y_br, approximate=True)
    r = lax.conv_general_dilated(r, conv_w[:, None, :], window_strides=(1,),
                                 padding=[(CONV_WIDTH - 1, 0)],
                                 dimension_numbers=('NWC', 'WIO', 'NWC'),
                                 feature_group_count=LRU_WIDTH) + conv_b
    rb = r.reshape(b, t, LRU_BLOCKS, LRU_BLOCK_WIDTH)
    gate_x = jax.nn.sigmoid(jnp.einsum('btnd,nde->btne', rb, w_gx).reshape(b, t, LRU_WIDTH) + b_gx)
    gate_a = jax.nn.sigmoid(jnp.einsum('btnd,nde->btne', rb, w_ga).reshape(b, t, LRU_WIDTH) + b_ga)
    log_a = -LRU_C * gate_a.astype(jnp.float32) * jax.nn.softplus(-a_param.astype(jnp.float32))
    a = jnp.exp(log_a)
    u = jnp.sqrt(-jnp.expm1(2.0 * log_a)) * (gate_x * r).astype(jnp.float32)
    def combine(e1, e2):
        a1, b1 = e1
        a2, b2 = e2
        return a1 * a2, a2 * b1 + b2
    _, h = lax.associative_scan(combine, (a, u), axis=1)
    return (h.astype(x.dtype) * y_br) @ w_out


def _clamped_swiglu(g, u):
    g = jnp.minimum(g, SWIGLU_LIMIT)
    u = jnp.clip(u, -SWIGLU_LIMIT, SWIGLU_LIMIT)
    return g * jax.nn.sigmoid(SWIGLU_ALPHA * g) * (u + 1.0)


def _moe_ffn(x, w_router, b_router, w_gate, b_gate, w_up, b_up, w_down, b_down):
    b, t, d = x.shape
    n_tok = b * t
    xf = x.reshape(n_tok, d)
    logits = (xf @ w_router + b_router).astype(jnp.float32)
    top_logit, top_idx = lax.top_k(logits, EXPERT_TOPK)
    gates = jax.nn.softmax(top_logit, axis=-1).astype(x.dtype)
    n_assign = n_tok * EXPERT_TOPK
    ids = top_idx.reshape(n_assign).astype(jnp.int32)
    dest, chunk_expert, n_rows = _grouped_layout(ids, N_EXPERTS, EXPERT_CHUNK)
    src = jnp.full((n_rows,), n_assign, jnp.int32).at[dest].set(
        jnp.arange(n_assign, dtype=jnp.int32), mode='drop')
    x_ext = jnp.concatenate([xf, jnp.zeros((1, d), x.dtype)], axis=0)
    x_rows = x_ext[src // EXPERT_TOPK].reshape(n_rows // EXPERT_CHUNK, EXPERT_CHUNK, d)
    def expert_chunk(args):
        xc, e = args
        g = xc @ w_gate[e] + b_gate[e]
        u = xc @ w_up[e] + b_up[e]
        return _clamped_swiglu(g, u) @ w_down[e] + b_down[e]
    y_rows = lax.map(expert_chunk, (x_rows, chunk_expert)).reshape(n_rows, d)
    y_sel = y_rows[dest].reshape(n_tok, EXPERT_TOPK, d)
    return jnp.einsum('nk,nkd->nd', gates, y_sel).reshape(b, t, d)


def setup_inputs(seed: int = 0) -> dict:
    key = jax.random.key(seed)
    ks = jax.random.split(key, 25)
    f32 = jnp.float32
    nrm = lambda k, s, sc: jax.random.normal(k, s, f32) * sc
    a_u = jax.random.uniform(ks[11], (N_LRU_LAYERS, LRU_WIDTH), f32, minval=0.9, maxval=0.999)
    return {
        'x': jax.random.normal(ks[0], (BATCH, SEQ, D_MODEL), f32),
        'rel_bias_table': nrm(ks[1], (NUM_BUCKETS, N_HEADS), 0.5),
        'w_qkv': nrm(ks[2], (N_MOBA_LAYERS, D_MODEL, 3 * D_MODEL), D_MODEL ** -0.5),
        'w_attn_out': nrm(ks[3], (N_MOBA_LAYERS, D_MODEL, D_MODEL), D_MODEL ** -0.5 * DEEPNORM_BETA),
        'w_lru_in': nrm(ks[4], (N_LRU_LAYERS, D_MODEL, 2 * LRU_WIDTH), D_MODEL ** -0.5),
        'lru_conv_w': nrm(ks[5], (N_LRU_LAYERS, CONV_WIDTH, LRU_WIDTH), CONV_WIDTH ** -0.5),
        'lru_conv_b': nrm(ks[6], (N_LRU_LAYERS, LRU_WIDTH), 0.01),
        'w_lru_gate_x': nrm(ks[7], (N_LRU_LAYERS, LRU_BLOCKS, LRU_BLOCK_WIDTH, LRU_BLOCK_WIDTH), LRU_BLOCK_WIDTH ** -0.5),
        'b_lru_gate_x': nrm(ks[8], (N_LRU_LAYERS, LRU_WIDTH), 0.01),
        'w_lru_gate_a': nrm(ks[9], (N_LRU_LAYERS, LRU_BLOCKS, LRU_BLOCK_WIDTH, LRU_BLOCK_WIDTH), LRU_BLOCK_WIDTH ** -0.5),
        'b_lru_gate_a': nrm(ks[10], (N_LRU_LAYERS, LRU_WIDTH), 0.01),
        'lru_a_param': jnp.log(a_u) - jnp.log1p(-a_u),
        'w_lru_out': nrm(ks[12], (N_LRU_LAYERS, LRU_WIDTH, D_MODEL), LRU_WIDTH ** -0.5 * DEEPNORM_BETA),
        'w_router': nrm(ks[13], (DEPTH, D_MODEL, N_EXPERTS), D_MODEL ** -0.5),
        'b_router': nrm(ks[14], (DEPTH, N_EXPERTS), 0.01),
        'w_exp_gate': nrm(ks[15], (DEPTH, N_EXPERTS, D_MODEL, D_FF), D_MODEL ** -0.5),
        'b_exp_gate': nrm(ks[16], (DEPTH, N_EXPERTS, D_FF), 0.01),
        'w_exp_up': nrm(ks[17], (DEPTH, N_EXPERTS, D_MODEL, D_FF), D_MODEL ** -0.5),
        'b_exp_up': nrm(ks[18], (DEPTH, N_EXPERTS, D_FF), 0.01),
        'w_exp_down': nrm(ks[19], (DEPTH, N_EXPERTS, D_FF, D_MODEL), D_FF ** -0.5 * DEEPNORM_BETA),
        'b_exp_down': nrm(ks[20], (DEPTH, N_EXPERTS, D_MODEL), 0.01),
        'ln_mix_g': 1.0 + nrm(ks[21], (DEPTH, D_MODEL), 0.01),
        'ln_mix_b': nrm(ks[22], (DEPTH, D_MODEL), 0.01),
        'ln_ffn_g': 1.0 + nrm(ks[23], (DEPTH, D_MODEL), 0.01),
        'ln_ffn_b': nrm(ks[24], (DEPTH, D_MODEL), 0.01),
    }


def reference(x, rel_bias_table, w_qkv, w_attn_out, w_lru_in, lru_conv_w, lru_conv_b,
              w_lru_gate_x, b_lru_gate_x, w_lru_gate_a, b_lru_gate_a, lru_a_param, w_lru_out,
              w_router, b_router, w_exp_gate, b_exp_gate, w_exp_up, b_exp_up,
              w_exp_down, b_exp_down, ln_mix_g, ln_mix_b, ln_ffn_g, ln_ffn_b):
    for i in range(DEPTH):
        j = i // N_MIXERS
        if i % N_MIXERS == 0:
            mix = _moba_mixer(x, w_qkv[j], w_attn_out[j], rel_bias_table)
        else:
            mix = _rglru_mixer(x, w_lru_in[j], lru_conv_w[j], lru_conv_b[j],
                               w_lru_gate_x[j], b_lru_gate_x[j], w_lru_gate_a[j], b_lru_gate_a[j],
                               lru_a_param[j], w_lru_out[j])
        x = _layer_norm(DEEPNORM_ALPHA * x + mix, ln_mix_g[i], ln_mix_b[i])
        ffn = _moe_ffn(x, w_router[i], b_router[i], w_exp_gate[i], b_exp_gate[i],
                       w_exp_up[i], b_exp_up[i], w_exp_down[i], b_exp_down[i])
        x = _layer_norm(DEEPNORM_ALPHA * x + ffn, ln_ffn_g[i], ln_ffn_b[i])
    return x
```

```cpp
#include <hip/hip_runtime.h>
#include <cstdio>
#include <cstdint>

#ifndef MK_PER_PHASE
#define MK_PER_PHASE 0
#endif
#ifndef NAIVE_GEMM
#define NAIVE_GEMM 1
#endif
#ifndef NAIVE_ATTN
#define NAIVE_ATTN 1
#endif

#define GAS __attribute__((address_space(1)))
#define LAS __attribute__((address_space(3)))
typedef unsigned short bf16_t;
typedef short bf16x8 __attribute__((ext_vector_type(8)));
typedef float f32x4 __attribute__((ext_vector_type(4)));
typedef float f32x2 __attribute__((ext_vector_type(2)));
typedef unsigned u32x4 __attribute__((ext_vector_type(4)));
typedef unsigned u32x2 __attribute__((ext_vector_type(2)));

constexpr int NB = 4, T = 4096, D = 1024, NTOK = NB * T, NH = 8, HD = 128, MBLK = 256, NBLK = T / MBLK, NE = 32, TOPK = 4, DEPTH = 4;
constexpr float ALPHA = 1.6817928305074290f;
constexpr float LOG2E = 1.4426950408889634f;
constexpr float QSCALE = 0.08838834764831845f * LOG2E;
constexpr float LN_EPS = 1e-5f;
constexpr int MAXMT = NTOK * TOPK / 256 + NE;
constexpr int BIAS_W = 704;

constexpr size_t MiB = 1u << 20;
constexpr size_t WS_CTL = 0, CTL_BYTES = 1 * MiB;
constexpr size_t WS_BIAS = 1 * MiB;
constexpr size_t WS_SPT = 1 * MiB + 64 * 1024;
constexpr size_t WS_KMEAN = 1 * MiB + 256 * 1024;
constexpr size_t WS_SEL = 2 * MiB;
constexpr size_t WS_TOPE = 3 * MiB, WS_TOPS = 3 * MiB + 256 * 1024, WS_TOPG = 3 * MiB + 512 * 1024;
constexpr size_t WS_LIST = 4 * MiB;
constexpr size_t WS_WQKV = 16 * MiB, WS_WO = 28 * MiB, WS_WIN = 32 * MiB, WS_WG = 40 * MiB, WS_WOUT = 42 * MiB;
constexpr size_t WS_XB = 48 * MiB, WS_XF = 80 * MiB, WS_Z = 144 * MiB, WS_Q = 208 * MiB, WS_K = 240 * MiB, WS_V = 272 * MiB, WS_O = 304 * MiB;
constexpr size_t WS_YBR = 336 * MiB, WS_R = 368 * MiB, WS_RC = 400 * MiB, WS_AA = 432 * MiB, WS_UU = 496 * MiB, WS_G = 560 * MiB;
constexpr size_t WS_HB = 592 * MiB, WS_YB = 736 * MiB, WS_WGU = 880 * MiB, WS_WD = 1392 * MiB, WS_END = 1648 * MiB;
constexpr int CW_TMO = 0, CW_BAR = 4096, CW_CNT = 8192;

constexpr int LDS_BYTES = 153600;
constexpr int RING_BYTES = 131072;
constexpr int MOE_OFF = RING_BYTES;
constexpr int LNR_OFF = 147456;
constexpr int MISC_OFF = LDS_BYTES - 256;

#define RLX_AGENT __ATOMIC_RELAXED, __HIP_MEMORY_SCOPE_AGENT
__device__ __forceinline__ unsigned cvt_pk_bf16(float lo, float hi) { unsigned r; asm volatile("v_cvt_pk_bf16_f32 %0, %1, %2" : "=v"(r) : "v"(lo), "v"(hi)); return r; }
__device__ __forceinline__ float bf_lo(unsigned w) { return __uint_as_float(w << 16); }
__device__ __forceinline__ float bf_hi(unsigned w) { return __uint_as_float(w & 0xffff0000u); }
__device__ __forceinline__ float wave_sum(float v) {
#pragma unroll
    for (int o = 1; o < 64; o <<= 1) v += __shfl_xor(v, o);
    return v;
}
__device__ __forceinline__ float wave_max(float v) {
#pragma unroll
    for (int o = 1; o < 64; o <<= 1) v = fmaxf(v, __shfl_xor(v, o));
    return v;
}
__device__ __forceinline__ float sigmoidf_(float x) { return 1.0f / (1.0f + __expf(-x)); }

#define XB_TMO      128
#define XB_XCNT(j)  (256  + 64 * (j))
#define XB_XSUB(j)  (1280 + 64 * (j))
#define XB_XGEN(j)  (2304 + 64 * (j))
#define XB_TOP      3328
#define XB_TOPGEN   3392
#define XCD_BAR_WORDS 3456
#define XB_SPIN_CAP (1u << 22)
__device__ __forceinline__ unsigned xb_ld(unsigned* p)              { return __hip_atomic_load(p, __ATOMIC_RELAXED, __HIP_MEMORY_SCOPE_AGENT); }
__device__ __forceinline__ unsigned xb_add(unsigned* p, unsigned v) { return __hip_atomic_fetch_add(p, v, __ATOMIC_RELAXED, __HIP_MEMORY_SCOPE_AGENT); }
__device__ __forceinline__ unsigned xb_xcc_id() { return (unsigned)__builtin_amdgcn_s_getreg((3 << 11) | 20) & 0xFu; }
#define XB_SPIN(cond, bar) do { unsigned _sp = 0; while (cond) { __builtin_amdgcn_s_sleep(1); \
    if ((++_sp & 255u) == 0u) { if (xb_ld(&(bar)[XB_TMO])) break; if (_sp > XB_SPIN_CAP) { atomicAdd(&(bar)[XB_TMO], 1u); break; } } } } while (0)
struct XcdBarrier { unsigned* bar; unsigned x; volatile LAS unsigned* st; };
__device__ __forceinline__ XcdBarrier xcd_barrier_post(unsigned* bar, volatile LAS unsigned* st) {
    XcdBarrier b; b.bar = bar; b.x = xb_xcc_id(); b.st = st;
    if (threadIdx.x == 0) (void)xb_add(&bar[XB_XCNT(b.x)], 1u);
    return b;
}
__device__ __forceinline__ void xcd_barrier_complete(unsigned* bar, unsigned x, unsigned& nloc, unsigned& nx) {
    const unsigned G = gridDim.x * gridDim.y * gridDim.z;
    unsigned sum, cnt, mine, sp = 0u;
    for (;;) {
        sum = 0u; cnt = 0u; mine = 0u;
#pragma unroll
        for (unsigned j = 0; j < 16; ++j) { const unsigned c = xb_ld(&bar[XB_XCNT(j)]); sum += c; cnt += (c > 0u) ? 1u : 0u; mine = (j == x) ? c : mine; }
        if (sum == G) break;
        __builtin_amdgcn_s_sleep(1);
        if ((++sp & 255u) == 0u) { if (xb_ld(&bar[XB_TMO])) break; if (sp > XB_SPIN_CAP) { atomicAdd(&bar[XB_TMO], 1u); break; } }
    }
    nloc = mine > 0u ? mine : 1u; nx = cnt > 0u ? cnt : 1u;
}
__device__ __forceinline__ void xcd_barrier(const XcdBarrier& b) {
    asm volatile("s_waitcnt vmcnt(0)" ::: "memory");
    __syncthreads();
    if (threadIdx.x == 0) {
        unsigned* bar = b.bar;
        __builtin_amdgcn_s_waitcnt(0);
        unsigned nloc = b.st[0], nx = b.st[1];
        if (nloc == 0u) { xcd_barrier_complete(bar, b.x, nloc, nx); b.st[0] = nloc; b.st[1] = nx; }
        const unsigned old = xb_add(&bar[XB_XSUB(b.x)], 1u);
        const unsigned gen = old / nloc;
        if (old + 1u == (gen + 1u) * nloc) {
            __builtin_amdgcn_fence(__ATOMIC_RELEASE, "agent");
            asm volatile("s_waitcnt vmcnt(0)" ::: "memory");
            const unsigned og = xb_add(&bar[XB_TOP], 1u);
            const unsigned tg = og / nx;
            if (og + 1u == (tg + 1u) * nx) xb_add(&bar[XB_TOPGEN], 1u);
            else XB_SPIN(xb_ld(&bar[XB_TOPGEN]) == tg, bar);
            __builtin_amdgcn_fence(__ATOMIC_ACQUIRE, "agent");
            xb_add(&bar[XB_XGEN(b.x)], 1u);
            asm volatile("s_waitcnt vmcnt(0)" ::: "memory");
        } else {
            XB_SPIN(xb_ld(&bar[XB_XGEN(b.x)]) == gen, bar);
            __builtin_amdgcn_fence(__ATOMIC_ACQUIRE, "agent");
            asm volatile("s_waitcnt vmcnt(0)" ::: "memory");
        }
    }
    __syncthreads();
}

namespace pg8 {
constexpr int BM = 256, BK = 64, HALF = 128, HTB = HALF * BK * 2, STAGE_BYTES = 8 * HTB, NXCD = 8, WGM = 8;
__host__ __device__ __forceinline__ int lds_byte(int r, int c) { const int st = (r >> 4) * 2 + (c >> 5), rr = r & 15, cc = c & 31, ob = rr * 64 + cc * 2; return st * 1024 + (ob ^ (((ob >> 9) & 1) << 5)); }
__host__ __device__ __forceinline__ void stage_rc(int b, int& R, int& C) { const int st = b / 1024, sb = b % 1024, swz = sb ^ (((sb >> 9) & 1) << 5); R = (st >> 1) * 16 + swz / 64; C = (st & 1) * 32 + (swz % 64) / 2; }
__host__ __device__ __forceinline__ int perm32(int rho) { const int n = rho >> 4, i = rho & 15; return 8 * (i >> 2) + 4 * n + (i & 3); }

struct Unit { unsigned a, b; int rl; int pm, pn, e, valid; };
struct Gemm { const char* A; const char* B; const int* list; int lda; int K; };

struct DenseOrder {
    int nM, nN, nwg, G, c;
    __device__ void init(int M, int N, int G_, int c_) { nM = M / BM; nN = N / BM; nwg = nM * nN; G = G_; c = c_; }
    __device__ bool tile(int i, int& pm, int& pn) const {
        const long L = (long)i * G + c; if (L >= nwg) return false;
        int wgid = (int)L; { const int q = nwg / NXCD, r = nwg % NXCD, xcd = wgid % NXCD, off = wgid / NXCD; wgid = (xcd < r ? xcd * (q + 1) : r * (q + 1) + (xcd - r) * q) + off; }
        const int nig = WGM * nN, gid = wgid / nig, fm = gid * WGM, gsz = (nM - fm) < WGM ? (nM - fm) : WGM;
        pm = fm + ((wgid % nig) % gsz); pn = (wgid % nig) / gsz; return true;
    }
};

#if NAIVE_GEMM
template <class Epi, class Sched, bool GATHER>
__device__ __forceinline__ void gemm_phase(LAS unsigned char* lds, const Gemm g, const Sched& S, const Epi& E, const int tid) {
    (void)lds;
    const int wid = __builtin_amdgcn_readfirstlane(tid >> 6), lane = tid & 63, wr = wid >> 2, wc = wid & 3, fr = lane & 15, fq = lane >> 4;
    Unit u;
    for (int i = 0; S.next(i, u); ++i) {
        f32x4 acc[2][2][4][2];
#pragma unroll
        for (int a = 0; a < 2; ++a)
#pragma unroll
            for (int b = 0; b < 2; ++b)
#pragma unroll
                for (int m = 0; m < 4; ++m)
#pragma unroll
                    for (int n = 0; n < 2; ++n) { f32x4 z_; asm volatile("v_mov_b32 %0, 0\n\tv_mov_b32 %1, 0\n\tv_mov_b32 %2, 0\n\tv_mov_b32 %3, 0" : "=v"(z_[0]), "=v"(z_[1]), "=v"(z_[2]), "=v"(z_[3])); acc[a][b][m][n] = z_; }
        unsigned ao[2][4], bo[2][2];
#pragma unroll
        for (int ai = 0; ai < 2; ++ai)
#pragma unroll
            for (int m = 0; m < 4; ++m) { const int r = 128 * ai + 64 * wr + 16 * m + fr;
                if (GATHER) { const int idx = g.list[u.rl + (r < u.valid ? r : 0)]; ao[ai][m] = (unsigned)idx * (unsigned)g.lda + fq * 16; }
                else ao[ai][m] = u.a + (unsigned)r * (unsigned)g.lda + fq * 16; }
#pragma unroll
        for (int bj = 0; bj < 2; ++bj)
#pragma unroll
            for (int n = 0; n < 2; ++n) { const int r = 128 * bj + 32 * wc + perm32(16 * n + fr); bo[bj][n] = u.b + (unsigned)r * (unsigned)g.K * 2u + fq * 16; }
#pragma unroll 1
        for (int k0 = 0; k0 < g.K; k0 += 32) {
            bf16x8 B[2][2];
#pragma unroll
            for (int bj = 0; bj < 2; ++bj)
#pragma unroll
                for (int n = 0; n < 2; ++n) B[bj][n] = *(const bf16x8*)(g.B + bo[bj][n] + k0 * 2);
#pragma unroll
            for (int ai = 0; ai < 2; ++ai) {
                bf16x8 A[4];
#pragma unroll
                for (int m = 0; m < 4; ++m) A[m] = *(const bf16x8*)(g.A + ao[ai][m] + k0 * 2);
#pragma unroll
                for (int bj = 0; bj < 2; ++bj)
#pragma unroll
                    for (int m = 0; m < 4; ++m)
#pragma unroll
                        for (int n = 0; n < 2; ++n) acc[ai][bj][m][n] = __builtin_amdgcn_mfma_f32_16x16x32_bf16(B[bj][n], A[m], acc[ai][bj][m][n], 0, 0, 0);
            }
        }
        E(acc, u, wr, wc, fr, fq);
    }
}
#else
template <class Epi, class Sched, bool GATHER>
__device__ __forceinline__ void gemm_phase(LAS unsigned char* lds, const Gemm g, const Sched& S, const Epi& E, const int tid) {
    const int wid = __builtin_amdgcn_readfirstlane(tid >> 6), lane = tid & 63, wr = wid >> 2, wc = wid & 3, fr = lane & 15, fq = lane >> 4;
    const int K = g.K, nt = K / BK;
    unsigned voffB[2], vA0[2], vA1[2], vN0[2], vN1[2]; int sR[2], sC[2];
#pragma unroll
    for (int i = 0; i < 2; ++i) { int R, C; stage_rc(tid * 16 + i * 8192, R, C); const int Rb = (R & ~31) + perm32(R & 31);
        sR[i] = R; sC[i] = C * 2; voffB[i] = (unsigned)(Rb * K + C) * 2u; vA0[i] = (unsigned)(R * g.lda + C * 2); vA1[i] = vA0[i] + (unsigned)(HALF * g.lda); vN0[i] = vA0[i]; vN1[i] = vA1[i]; }
    const size_t kstep = (size_t)(BK * 2);
    const size_t hstepB = (size_t)HALF * K * 2;
    const unsigned ldsw = (unsigned)wid * 1024u;
    const int aoff = lds_byte(wr * 64 + fr, fq * 8), boff = lds_byte(wc * 32 + fr, fq * 8);
#define PG8_SA(b, h) (((b) * 2 + (h)) * HTB)
#define PG8_SB(b, h) ((4 + (b) * 2 + (h)) * HTB)
#define PG8_STAGE(bufoff, gbase, voff) do { _Pragma("unroll") for (int _i = 0; _i < 2; ++_i) \
        __builtin_amdgcn_global_load_lds((const unsigned*)((const char*)(gbase) + (voff)[_i]), (LAS unsigned*)(lds + (bufoff) + ldsw + _i * 8192), 16, 0, 0); } while (0)
#define PG8_LDA(dst, b, h) do { _Pragma("unroll") for (int m = 0; m < 4; ++m) _Pragma("unroll") for (int k = 0; k < 2; ++k) dst[m][k] = *(const LAS bf16x8*)(lds + PG8_SA(b, h) + aoff + m * 2048 + k * 1024); } while (0)
#define PG8_LDB(dst, b, h) do { _Pragma("unroll") for (int n = 0; n < 2; ++n) _Pragma("unroll") for (int k = 0; k < 2; ++k) dst[n][k] = *(const LAS bf16x8*)(lds + PG8_SB(b, h) + boff + n * 2048 + k * 1024); } while (0)
#define PG8_MMA(ai, bj, At, Bt) do { __builtin_amdgcn_s_setprio(1); _Pragma("unroll") for (int m = 0; m < 4; ++m) _Pragma("unroll") for (int n = 0; n < 2; ++n) _Pragma("unroll") for (int k = 0; k < 2; ++k) \
        acc[ai][bj][m][n] = __builtin_amdgcn_mfma_f32_16x16x32_bf16(Bt[n][k], At[m][k], acc[ai][bj][m][n], 0, 0, 0); __builtin_amdgcn_s_setprio(0); } while (0)
#define PG8_WAIT_V(n) asm volatile("s_waitcnt vmcnt(" #n ")" ::: "memory")
#define PG8_WAIT_L(n) asm volatile("s_waitcnt lgkmcnt(" #n ")" ::: "memory")
#define PG8_BAR __builtin_amdgcn_s_barrier()
#define PG8_SCHED __builtin_amdgcn_sched_barrier(0)
#define PG8_GATHER_OFFS(u_, o0, o1) do { if constexpr (GATHER) { _Pragma("unroll") for (int _i = 0; _i < 2; ++_i) { \
        const int r0_ = sR[_i], r1_ = sR[_i] + HALF; const int i0_ = g.list[(u_).rl + (r0_ < (u_).valid ? r0_ : 0)], i1_ = g.list[(u_).rl + (r1_ < (u_).valid ? r1_ : 0)]; \
        o0[_i] = (unsigned)i0_ * (unsigned)g.lda + (unsigned)sC[_i]; o1[_i] = (unsigned)i1_ * (unsigned)g.lda + (unsigned)sC[_i]; } } } while (0)
    Unit cur, nxt; int ui = 0;
    if (!S.next(0, cur)) return;
    f32x4 acc[2][2][4][2];
#pragma unroll
    for (int a = 0; a < 2; ++a)
#pragma unroll
        for (int b = 0; b < 2; ++b)
#pragma unroll
            for (int m = 0; m < 4; ++m)
#pragma unroll
                for (int n = 0; n < 2; ++n) { f32x4 z_; asm volatile("v_mov_b32 %0, 0\n\tv_mov_b32 %1, 0\n\tv_mov_b32 %2, 0\n\tv_mov_b32 %3, 0" : "=v"(z_[0]), "=v"(z_[1]), "=v"(z_[2]), "=v"(z_[3])); acc[a][b][m][n] = z_; }
    bf16x8 At[4][2], B0[2][2], B1[2][2];
    const char* cA = g.A + cur.a; const char* cB = g.B + cur.b;
    PG8_GATHER_OFFS(cur, vA0, vA1);
    PG8_STAGE(PG8_SB(0, 0), cB, voffB); PG8_STAGE(PG8_SB(0, 1), cB + hstepB, voffB); PG8_STAGE(PG8_SA(0, 0), cA, vA0); PG8_STAGE(PG8_SA(0, 1), cA, vA1);
    if (wr == 1) PG8_BAR;
    PG8_WAIT_V(2); PG8_BAR;
    PG8_STAGE(PG8_SB(1, 0), cB + kstep, voffB); PG8_STAGE(PG8_SA(1, 0), cA + kstep, vA0); PG8_STAGE(PG8_SB(1, 1), cB + hstepB + kstep, voffB);
    PG8_WAIT_V(6); PG8_BAR;
    for (;;) {
        const bool has_next = S.next(ui + 1, nxt);
        const char* nA = has_next ? g.A + nxt.a : cA; const char* nB = has_next ? g.B + nxt.b : cB;
        if constexpr (GATHER) { if (has_next) { PG8_GATHER_OFFS(nxt, vN0, vN1); } else {
#pragma unroll
            for (int i = 0; i < 2; ++i) { vN0[i] = vA0[i]; vN1[i] = vA1[i]; } } }
        for (int t = 0; t < nt; t += 2) {
            const bool last = (t == nt - 2);
            const char* a1 = cA + (size_t)(t + 1) * kstep;
            const char* a2 = last ? nA : cA + (size_t)(t + 2) * kstep; const char* b2 = last ? nB : cB + (size_t)(t + 2) * kstep;
            const char* a3 = a2 + kstep; const char* b3 = b2 + kstep;
            unsigned x0[2], x1[2];
#pragma unroll
            for (int i = 0; i < 2; ++i) { x0[i] = (GATHER && last) ? vN0[i] : vA0[i]; x1[i] = (GATHER && last) ? vN1[i] : vA1[i]; }
            PG8_LDB(B0, 0, 0); PG8_LDB(B1, 0, 1); PG8_SCHED; PG8_LDA(At, 0, 0); PG8_STAGE(PG8_SA(1, 1), a1, vA1);
            PG8_WAIT_V(8); PG8_WAIT_L(0); PG8_BAR; PG8_MMA(0, 0, At, B0); PG8_MMA(0, 1, At, B1); PG8_BAR; PG8_SCHED;
            PG8_LDA(At, 0, 1); PG8_STAGE(PG8_SB(0, 0), b2, voffB); PG8_STAGE(PG8_SB(0, 1), b2 + hstepB, voffB); PG8_STAGE(PG8_SA(0, 0), a2, x0);
            PG8_WAIT_V(8); PG8_WAIT_L(0); PG8_BAR; PG8_MMA(1, 0, At, B0); PG8_MMA(1, 1, At, B1); PG8_BAR; PG8_SCHED;
            PG8_LDB(B0, 1, 0); PG8_LDB(B1, 1, 1); PG8_SCHED; PG8_LDA(At, 1, 0); PG8_STAGE(PG8_SA(0, 1), a2, x1);
            PG8_WAIT_V(8); PG8_WAIT_L(0); PG8_BAR; PG8_MMA(0, 0, At, B0); PG8_MMA(0, 1, At, B1); PG8_BAR; PG8_SCHED;
            PG8_LDA(At, 1, 1); PG8_STAGE(PG8_SB(1, 0), b3, voffB); PG8_STAGE(PG8_SB(1, 1), b3 + hstepB, voffB); PG8_STAGE(PG8_SA(1, 0), a3, x0);
            PG8_WAIT_V(8); PG8_WAIT_L(0); PG8_BAR; PG8_MMA(1, 0, At, B0); PG8_MMA(1, 1, At, B1); PG8_BAR; PG8_SCHED;
        }
        if (wr == 0) PG8_BAR;
        E(acc, cur, wr, wc, fr, fq);
        if (!has_next) break;
#pragma unroll
        for (int a = 0; a < 2; ++a)
#pragma unroll
            for (int b = 0; b < 2; ++b)
#pragma unroll
                for (int m = 0; m < 4; ++m)
#pragma unroll
                    for (int n = 0; n < 2; ++n) { f32x4 z_; asm volatile("v_mov_b32 %0, 0\n\tv_mov_b32 %1, 0\n\tv_mov_b32 %2, 0\n\tv_mov_b32 %3, 0" : "=v"(z_[0]), "=v"(z_[1]), "=v"(z_[2]), "=v"(z_[3])); acc[a][b][m][n] = z_; }
        cur = nxt; cA = nA; cB = nB; ++ui;
        if constexpr (GATHER) {
#pragma unroll
            for (int i = 0; i < 2; ++i) { vA0[i] = vN0[i]; vA1[i] = vN1[i]; } }
        if (wr == 1) PG8_BAR;
    }
    PG8_WAIT_V(0);
    PG8_BAR;
#undef PG8_SA
#undef PG8_SB
#undef PG8_STAGE
#undef PG8_LDA
#undef PG8_LDB
#undef PG8_MMA
#undef PG8_WAIT_V
#undef PG8_WAIT_L
#undef PG8_BAR
#undef PG8_SCHED
#undef PG8_GATHER_OFFS
}
#endif
}
using pg8::Unit;

struct SchedDense {
    pg8::DenseOrder o; int lda, K;
    __device__ __forceinline__ bool next(int i, Unit& u) const { int pm, pn; if (!o.tile(i, pm, pn)) return false;
        u.pm = pm; u.pn = pn; u.e = 0; u.valid = 256; u.rl = 0; u.a = (unsigned)pm * 256u * (unsigned)lda; u.b = (unsigned)pn * 256u * (unsigned)K * 2u; return true; }
};
struct SchedGates {
    pg8::DenseOrder o;
    __device__ __forceinline__ bool next(int i, Unit& u) const { int pm, pn; if (!o.tile(i, pm, pn)) return false;
        const int gi = pn >> 1, hf = pn & 1; u.pm = pm; u.pn = hf; u.e = gi; u.valid = 256; u.rl = 0;
        u.a = (unsigned)pm * 256u * (D * 2) + gi * 256 * 2; u.b = (unsigned)gi * (512 * 256 * 2) + (unsigned)hf * 256 * 256 * 2; return true; }
};
#define MOE_CNT(lds)    ((LAS int*)((lds) + MOE_OFF))
#define MOE_MTBASE(lds) ((LAS int*)((lds) + MOE_OFF + 128))
#define MOE_MTE(lds)    ((LAS int*)((lds) + MOE_OFF + 288))
struct SchedMoe {
    LAS unsigned char* lds; int total, NT, G, c; unsigned bstride; bool gather;
    __device__ __forceinline__ bool next(int i, Unit& u) const {
        const int L = i * G + c; if (L >= total * NT) return false;
        const int mt = L / NT, nt = L - mt * NT;
        const int e = __builtin_amdgcn_readfirstlane(MOE_MTE(lds)[mt]); const int ml = mt - __builtin_amdgcn_readfirstlane(MOE_MTBASE(lds)[e]);
        const int left = __builtin_amdgcn_readfirstlane(MOE_CNT(lds)[e]) - ml * 256;
        u.pm = mt; u.pn = nt; u.e = e; u.valid = left < 256 ? left : 256; u.rl = e * NTOK + ml * 256;
        u.a = gather ? 0u : (unsigned)mt * 256u * (D * 2); u.b = (unsigned)e * bstride + (unsigned)nt * 256u * D * 2; return true; }
};
__device__ __forceinline__ int moe_tables(LAS unsigned char* lds, const unsigned* cntw, const int tid) {
    LAS int* cnt = MOE_CNT(lds); LAS int* mtbase = MOE_MTBASE(lds); LAS int* mte = MOE_MTE(lds);
    __syncthreads();
    if (tid < 32) cnt[tid] = (int)__hip_atomic_load(cntw + tid, RLX_AGENT);
    __syncthreads();
    if (tid == 0) { int s = 0; for (int e = 0; e < NE; ++e) { mtbase[e] = s; const int n = (cnt[e] + 255) >> 8; for (int j = 0; j < n; ++j) mte[s + j] = e; s += n; } mtbase[NE] = s; }
    __syncthreads();
    return __builtin_amdgcn_readfirstlane(mtbase[NE]);
}

typedef f32x4 Acc[2][2][4][2];
struct EpiQKV {
    bf16_t* q;
    __device__ __forceinline__ void operator()(const Acc& acc, const Unit& u, int wr, int wc, int fr, int fq) const {
        const int which = u.pn >> 2; bf16_t* base = q + (size_t)which * ((WS_K - WS_Q) / 2); const float sc = which == 0 ? QSCALE : 1.0f;
#pragma unroll
        for (int ai = 0; ai < 2; ++ai)
#pragma unroll
            for (int m = 0; m < 4; ++m) { const int ntok = u.pm * 256 + 128 * ai + 64 * wr + 16 * m + fr, b = ntok >> 12, t = ntok & 4095;
#pragma unroll
                for (int bj = 0; bj < 2; ++bj) { const int head = (u.pn & 3) * 2 + bj, d = 32 * wc + 8 * fq;
                    const f32x4 v0 = acc[ai][bj][m][0] * sc, v1 = acc[ai][bj][m][1] * sc;
                    u32x4 w; w.x = cvt_pk_bf16(v0[0], v0[1]); w.y = cvt_pk_bf16(v0[2], v0[3]); w.z = cvt_pk_bf16(v1[0], v1[1]); w.w = cvt_pk_bf16(v1[2], v1[3]);
                    *(u32x4*)(base + ((size_t)((b * NH + head) * T + t)) * HD + d) = w; } }
    }
};
struct EpiResid {
    const float* X; float* Z;
    __device__ __forceinline__ void operator()(const Acc& acc, const Unit& u, int wr, int wc, int fr, int fq) const {
#pragma unroll
        for (int ai = 0; ai < 2; ++ai)
#pragma unroll
            for (int m = 0; m < 4; ++m) { const size_t row = (size_t)(u.pm * 256 + 128 * ai + 64 * wr + 16 * m + fr);
#pragma unroll
                for (int bj = 0; bj < 2; ++bj) { const size_t off = row * D + u.pn * 256 + 128 * bj + 32 * wc + 8 * fq;
                    const f32x4 x0 = *(const f32x4*)(X + off), x1 = *(const f32x4*)(X + off + 4);
                    *(f32x4*)(Z + off) = x0 * ALPHA + acc[ai][bj][m][0]; *(f32x4*)(Z + off + 4) = x1 * ALPHA + acc[ai][bj][m][1]; }
                asm volatile("" ::: "memory"); }
    }
};
__device__ __forceinline__ float gelu_tanh(float x) { const float y = 0.7978845608028654f * (x + 0.044715f * x * x * x); return x / (1.0f + __expf(-2.0f * y)); }
struct EpiLin {
    bf16_t* ybr; bf16_t* r;
    __device__ __forceinline__ void operator()(const Acc& acc, const Unit& u, int wr, int wc, int fr, int fq) const {
        const bool isy = u.pn < 4; bf16_t* base = isy ? ybr : r; const int ct = isy ? u.pn : u.pn - 4;
#pragma unroll
        for (int ai = 0; ai < 2; ++ai)
#pragma unroll
            for (int m = 0; m < 4; ++m) { const size_t row = (size_t)(u.pm * 256 + 128 * ai + 64 * wr + 16 * m + fr);
#pragma unroll
                for (int bj = 0; bj < 2; ++bj) { f32x4 v0 = acc[ai][bj][m][0], v1 = acc[ai][bj][m][1];
                    if (isy) {
#pragma unroll
                        for (int j = 0; j < 4; ++j) { v0[j] = gelu_tanh(v0[j]); v1[j] = gelu_tanh(v1[j]); } }
                    u32x4 w; w.x = cvt_pk_bf16(v0[0], v0[1]); w.y = cvt_pk_bf16(v0[2], v0[3]); w.z = cvt_pk_bf16(v1[0], v1[1]); w.w = cvt_pk_bf16(v1[2], v1[3]);
                    *(u32x4*)(base + row * D + ct * 256 + 128 * bj + 32 * wc + 8 * fq) = w; } }
    }
};
struct EpiGates {
    const bf16_t* rc; const float* bgx; const float* bga; const float* spt; float* Aa; float* Uu;
    __device__ __forceinline__ void operator()(const Acc& acc, const Unit& u, int wr, int wc, int fr, int fq) const {
        const int ch = u.e * 256 + u.pn * 128 + 32 * wc + 8 * fq;
        const f32x4 bx0 = *(const f32x4*)(bgx + ch), bx1 = *(const f32x4*)(bgx + ch + 4), ba0 = *(const f32x4*)(bga + ch), ba1 = *(const f32x4*)(bga + ch + 4), sp0 = *(const f32x4*)(spt + ch), sp1 = *(const f32x4*)(spt + ch + 4);
#pragma unroll
        for (int ai = 0; ai < 2; ++ai)
#pragma unroll
            for (int m = 0; m < 4; ++m) { const size_t row = (size_t)(u.pm * 256 + 128 * ai + 64 * wr + 16 * m + fr);
                const u32x4 rw = *(const u32x4*)(rc + row * D + ch);
                const f32x4 r0 = {bf_lo(rw.x), bf_hi(rw.x), bf_lo(rw.y), bf_hi(rw.y)}, r1 = {bf_lo(rw.z), bf_hi(rw.z), bf_lo(rw.w), bf_hi(rw.w)};
                f32x4 a0, a1, u0, u1;
#pragma unroll
                for (int j = 0; j < 4; ++j) {
                    { const float gx = sigmoidf_(acc[ai][0][m][0][j] + bx0[j]), ga = sigmoidf_(acc[ai][1][m][0][j] + ba0[j]); const float la = ga * sp0[j], x = 2.0f * la;
                      a0[j] = __expf(la); const float om = (x > -0.02f) ? -x * (1.0f + x * (0.5f + x * (1.0f / 6.0f))) : 1.0f - __expf(x); u0[j] = sqrtf(om) * gx * r0[j]; }
                    { const float gx = sigmoidf_(acc[ai][0][m][1][j] + bx1[j]), ga = sigmoidf_(acc[ai][1][m][1][j] + ba1[j]); const float la = ga * sp1[j], x = 2.0f * la;
                      a1[j] = __expf(la); const float om = (x > -0.02f) ? -x * (1.0f + x * (0.5f + x * (1.0f / 6.0f))) : 1.0f - __expf(x); u1[j] = sqrtf(om) * gx * r1[j]; } }
                *(f32x4*)(Aa + row * D + ch) = a0; *(f32x4*)(Aa + row * D + ch + 4) = a1;
                *(f32x4*)(Uu + row * D + ch) = u0; *(f32x4*)(Uu + row * D + ch + 4) = u1;
                asm volatile("" ::: "memory"); }
    }
};
struct EpiSwiglu {
    const float* bg; const float* bu; bf16_t* hb;
    __device__ __forceinline__ void operator()(const Acc& acc, const Unit& u, int wr, int wc, int fr, int fq) const {
        const int col = u.pn * 128 + 32 * wc + 8 * fq;
        const f32x4 gA = *(const f32x4*)(bg + u.e * D + col), gB = *(const f32x4*)(bg + u.e * D + col + 4), uA = *(const f32x4*)(bu + u.e * D + col), uB = *(const f32x4*)(bu + u.e * D + col + 4);
        const float g0[8] = {gA[0], gA[1], gA[2], gA[3], gB[0], gB[1], gB[2], gB[3]}, u0[8] = {uA[0], uA[1], uA[2], uA[3], uB[0], uB[1], uB[2], uB[3]};
#pragma unroll
        for (int ai = 0; ai < 2; ++ai)
#pragma unroll
            for (int m = 0; m < 4; ++m) { const size_t row = (size_t)(u.pm * 256 + 128 * ai + 64 * wr + 16 * m + fr);
                float h[8];
#pragma unroll
                for (int j = 0; j < 8; ++j) { float gv = acc[ai][0][m][j >> 2][j & 3] + g0[j], uv = acc[ai][1][m][j >> 2][j & 3] + u0[j];
                    gv = fminf(gv, 7.0f); uv = fminf(fmaxf(uv, -7.0f), 7.0f); h[j] = gv * sigmoidf_(1.702f * gv) * (uv + 1.0f); }
                u32x4 w; w.x = cvt_pk_bf16(h[0], h[1]); w.y = cvt_pk_bf16(h[2], h[3]); w.z = cvt_pk_bf16(h[4], h[5]); w.w = cvt_pk_bf16(h[6], h[7]);
                *(u32x4*)(hb + row * D + col) = w;
                asm volatile("" ::: "memory"); }
    }
};
struct EpiPlain {
    bf16_t* yb;
    __device__ __forceinline__ void operator()(const Acc& acc, const Unit& u, int wr, int wc, int fr, int fq) const {
#pragma unroll
        for (int ai = 0; ai < 2; ++ai)
#pragma unroll
            for (int m = 0; m < 4; ++m) { const size_t row = (size_t)(u.pm * 256 + 128 * ai + 64 * wr + 16 * m + fr);
#pragma unroll
                for (int bj = 0; bj < 2; ++bj) { const f32x4 v0 = acc[ai][bj][m][0], v1 = acc[ai][bj][m][1];
                    u32x4 w; w.x = cvt_pk_bf16(v0[0], v0[1]); w.y = cvt_pk_bf16(v0[2], v0[3]); w.z = cvt_pk_bf16(v1[0], v1[1]); w.w = cvt_pk_bf16(v1[2], v1[3]);
                    *(u32x4*)(yb + row * D + u.pn * 256 + 128 * bj + 32 * wc + 8 * fq) = w; } }
    }
};

__device__ __forceinline__ void xpose_item(const float* W, int K, int N, bf16_t* WT, int mode, LAS float* scr, int item, int lane) {
    const int nblk = N / 32, kb = item / nblk, nb = item % nblk, k0 = 64 * kb, n0 = 32 * nb;
    const int row0 = mode < 0 ? n0 : ((n0 >> 7) * 256 + mode * 128 + (n0 & 127));
#pragma unroll 8
    for (int i = 0; i < 32; ++i) { const int kk = 2 * i + (lane >> 5); scr[kk * 33 + (lane & 31)] = W[(size_t)(k0 + kk) * N + n0 + (lane & 31)]; }
    asm volatile("s_waitcnt lgkmcnt(0)" ::: "memory");
    const int c = lane & 7;
#pragma unroll
    for (int j = 0; j < 4; ++j) { const int n = (lane >> 3) + 8 * j; const LAS float* s = scr + (8 * c) * 33 + n;
        u32x4 o; o.x = cvt_pk_bf16(s[0 * 33], s[1 * 33]); o.y = cvt_pk_bf16(s[2 * 33], s[3 * 33]); o.z = cvt_pk_bf16(s[4 * 33], s[5 * 33]); o.w = cvt_pk_bf16(s[6 * 33], s[7 * 33]);
        *(u32x4*)(WT + (size_t)(row0 + n) * K + k0 + 8 * c) = o; }
    asm volatile("s_waitcnt lgkmcnt(0)" ::: "memory");
}
__device__ __forceinline__ void xpose_class(const float* src, int nmat, int K, int N, bf16_t* dst, size_t dstride, int mode, LAS float* scr, int gw, int NGW, int lane) {
    const int ipm = (K / 64) * (N / 32);
    for (int it = gw; it < nmat * ipm; it += NGW) { const int mat = it / ipm, r = it - mat * ipm;
        xpose_item(src + (size_t)mat * K * N, K, N, dst + (size_t)mat * dstride, mode, scr, r, lane); }
}

__device__ __forceinline__ int opaque_i(int v) { asm volatile("" : "+s"(v)); return v; }
__device__ __forceinline__ int opaque_v(int v) { asm volatile("" : "+v"(v)); return v; }
template <class P> __device__ __forceinline__ P* opaque_p(P* p) { asm volatile("" : "+s"(p)); return p; }
struct Ctx {
    unsigned char* ws; LAS unsigned char* lds;
    int tid, lane, wave, G, vcu, bx;
};
struct Args { const float* in[25]; float* out; unsigned char* ws; int ph_lo, ph_hi; };

__device__ __forceinline__ void ph_prologue(const Ctx& c, const Args& A) {
    LAS float* scr = (LAS float*)(c.lds + c.wave * 16384);
    const int gw = c.vcu * 8 + c.wave, NGW = c.G * 8;
    unsigned char* ws = c.ws;
    xpose_class(A.in[2], 2, D, 3 * D, (bf16_t*)(ws + WS_WQKV), (size_t)3 * D * D, -1, scr, gw, NGW, c.lane);
    xpose_class(A.in[3], 2, D, D, (bf16_t*)(ws + WS_WO), (size_t)D * D, -1, scr, gw, NGW, c.lane);
    xpose_class(A.in[4], 2, D, 2 * D, (bf16_t*)(ws + WS_WIN), (size_t)2 * D * D, -1, scr, gw, NGW, c.lane);
    xpose_class(A.in[7], 8, 256, 256, (bf16_t*)(ws + WS_WG), (size_t)512 * 256, 0, scr, gw, NGW, c.lane);
    xpose_class(A.in[9], 8, 256, 256, (bf16_t*)(ws + WS_WG), (size_t)512 * 256, 1, scr, gw, NGW, c.lane);
    xpose_class(A.in[12], 2, D, D, (bf16_t*)(ws + WS_WOUT), (size_t)D * D, -1, scr, gw, NGW, c.lane);
    xpose_class(A.in[15], DEPTH * NE, D, D, (bf16_t*)(ws + WS_WGU), (size_t)2 * D * D, 0, scr, gw, NGW, c.lane);
    xpose_class(A.in[17], DEPTH * NE, D, D, (bf16_t*)(ws + WS_WGU), (size_t)2 * D * D, 1, scr, gw, NGW, c.lane);
    xpose_class(A.in[19], DEPTH * NE, D, D, (bf16_t*)(ws + WS_WD), (size_t)D * D, -1, scr, gw, NGW, c.lane);
    for (int m = gw; m < NTOK; m += NGW) { const f32x4* xr = (const f32x4*)(A.in[0] + (size_t)m * D) + c.lane; u32x2* o = (u32x2*)((bf16_t*)(ws + WS_XB) + (size_t)m * D) + c.lane;
#pragma unroll
        for (int j = 0; j < 4; ++j) { const f32x4 v = xr[64 * j]; u32x2 w; w.x = cvt_pk_bf16(v[0], v[1]); w.y = cvt_pk_bf16(v[2], v[3]); o[64 * j] = w; } }
    if (c.bx == 0) { float* bt = (float*)(ws + WS_BIAS);
        for (int i = c.tid; i < NH * BIAS_W; i += 512) { const int h = i / BIAS_W; int dist = i % BIAS_W - 64; if (dist < 0) dist = 0;
            int bucket;
            if (dist < 16) bucket = dist; else { const float n = (float)dist; int lg = 16 + (int)(logf(n / 16.0f) / 2.0794415416798357f * 16.0f); bucket = lg < 31 ? lg : 31; }
            bt[i] = A.in[1][bucket * NH + h] * LOG2E; }
        float* spt = (float*)(ws + WS_SPT);
        for (int i = c.tid; i < 2 * D; i += 512) { const float ap = -A.in[11][i]; spt[i] = -8.0f * (ap > 15.f ? ap : log1pf(expf(ap))); } }
}

__device__ __forceinline__ void ph_kmean(const Ctx& c) {
    const bf16_t* Kb = (const bf16_t*)(c.ws + WS_K); float* km = (float*)(c.ws + WS_KMEAN); LAS float* red = (LAS float*)c.lds;
    for (int u = c.vcu; u < NB * NH * NBLK; u += c.G) {
        const int bh = u / NBLK, j = u % NBLK; const bf16_t* Kp = Kb + ((size_t)bh * T + j * MBLK) * HD;
        const int c8 = c.tid & 15, rg = c.tid >> 4; float a[8] = {0, 0, 0, 0, 0, 0, 0, 0};
#pragma unroll
        for (int r = 0; r < 8; ++r) { const u32x4 w = *(const u32x4*)(Kp + (size_t)(rg * 8 + r) * HD + c8 * 8);
            a[0] += bf_lo(w.x); a[1] += bf_hi(w.x); a[2] += bf_lo(w.y); a[3] += bf_hi(w.y); a[4] += bf_lo(w.z); a[5] += bf_hi(w.z); a[6] += bf_lo(w.w); a[7] += bf_hi(w.w); }
#pragma unroll
        for (int i = 0; i < 8; ++i) red[rg * 128 + c8 * 8 + i] = a[i];
        __syncthreads();
        if (c.tid < 128) { float s = 0.f; for (int g = 0; g < 32; ++g) s += red[g * 128 + c.tid]; km[(size_t)u * HD + c.tid] = s * (1.0f / MBLK); }
        __syncthreads();
    }
}
__device__ __forceinline__ void ph_select(const Ctx& c) {
    const bf16_t* Qb = (const bf16_t*)(c.ws + WS_Q); const float* km = (const float*)(c.ws + WS_KMEAN); unsigned* sel = (unsigned*)(c.ws + WS_SEL); LAS float* kl = (LAS float*)c.lds;
    for (int u = c.vcu; u < NB * NH * (T / 512); u += c.G) {
        const int bh = u / (T / 512), ch = u % (T / 512);
        __syncthreads();
        for (int i = c.tid; i < NBLK * HD; i += 512) kl[i] = km[(size_t)bh * NBLK * HD + i];
        __syncthreads();
        const int t = ch * 512 + c.tid, qb = t >> 8;
        float q[HD];
        const u32x4* qp = (const u32x4*)(Qb + ((size_t)bh * T + t) * HD);
#pragma unroll
        for (int i = 0; i < 16; ++i) { const u32x4 w = qp[i]; q[8 * i] = bf_lo(w.x); q[8 * i + 1] = bf_hi(w.x); q[8 * i + 2] = bf_lo(w.y); q[8 * i + 3] = bf_hi(w.y); q[8 * i + 4] = bf_lo(w.z); q[8 * i + 5] = bf_hi(w.z); q[8 * i + 6] = bf_lo(w.w); q[8 * i + 7] = bf_hi(w.w); }
        float v0 = -__builtin_inff(), v1 = v0, v2 = v0; int i0 = -1, i1 = -1, i2 = -1;
        for (int j = 0; j < qb; ++j) {
            float s = 0.f; const LAS f32x4* kp = (const LAS f32x4*)(kl + j * HD);
#pragma unroll
            for (int i = 0; i < 32; ++i) { const f32x4 kv = kp[i]; s += q[4 * i] * kv[0] + q[4 * i + 1] * kv[1] + q[4 * i + 2] * kv[2] + q[4 * i + 3] * kv[3]; }
            if (s > v0) { v2 = v1; i2 = i1; v1 = v0; i1 = i0; v0 = s; i0 = j; }
            else if (s > v1) { v2 = v1; i2 = i1; v1 = s; i1 = j; }
            else if (s > v2) { v2 = s; i2 = j; }
        }
        unsigned m = 0; if (i0 >= 0) m |= 1u << i0; if (i1 >= 0) m |= 1u << i1; if (i2 >= 0) m |= 1u << i2;
        sel[(size_t)bh * T + t] = m;
    }
}

#if NAIVE_ATTN
__device__ __forceinline__ void ph_attn(const Ctx& c) {
    const bf16_t* Qb = (const bf16_t*)(c.ws + WS_Q); const bf16_t* Kb = (const bf16_t*)(c.ws + WS_K); const bf16_t* Vb = (const bf16_t*)(c.ws + WS_V);
    const unsigned* sel = (const unsigned*)(c.ws + WS_SEL); const float* bt = (const float*)(c.ws + WS_BIAS); bf16_t* O = (bf16_t*)(c.ws + WS_O);
    LAS float* ql = (LAS float*)(c.lds + c.wave * 1024); LAS float* pl = ql + 128;
    const int gw = c.vcu * 8 + c.wave, NGW = c.G * 8, lane = c.lane;
    for (int r = gw; r < NB * NH * T; r += NGW) {
        const int bh = r / T, t = r % T, qb = t >> 8, h = bh % NH, b = bh / NH;
        const unsigned w = *(const unsigned*)(Qb + ((size_t)bh * T + t) * HD + 2 * lane);
        ql[2 * lane] = bf_lo(w); ql[2 * lane + 1] = bf_hi(w);
        asm volatile("s_waitcnt lgkmcnt(0)" ::: "memory");
        const unsigned mask = sel[(size_t)bh * T + t] | (1u << qb);
        float mrun = -1e30f, lrun = 0.f, o0 = 0.f, o1 = 0.f;
        for (int jb = 0; jb <= qb; ++jb) {
            if (!((mask >> jb) & 1u)) continue;
            for (int kc = 0; kc < 4; ++kc) {
                const int key = jb * MBLK + kc * 64 + lane;
                const u32x4* kp = (const u32x4*)(Kb + ((size_t)bh * T + key) * HD);
                float s = 0.f;
#pragma unroll
                for (int i = 0; i < 16; ++i) { const u32x4 kw = kp[i]; const LAS float* qq = ql + 8 * i;
                    s += qq[0] * bf_lo(kw.x) + qq[1] * bf_hi(kw.x) + qq[2] * bf_lo(kw.y) + qq[3] * bf_hi(kw.y) + qq[4] * bf_lo(kw.z) + qq[5] * bf_hi(kw.z) + qq[6] * bf_lo(kw.w) + qq[7] * bf_hi(kw.w); }
                const int dist = t - key;
                if (dist < 0) s = -__builtin_inff(); else s += bt[h * BIAS_W + 64 + (dist > 600 ? 600 : dist)];
                const float cm = wave_max(s), mn = fmaxf(mrun, cm), al = exp2f(mrun - mn), p = exp2f(s - mn);
                lrun = lrun * al + wave_sum(p); o0 *= al; o1 *= al; mrun = mn;
                pl[lane] = p;
                asm volatile("s_waitcnt lgkmcnt(0)" ::: "memory");
                const bf16_t* vp = Vb + ((size_t)bh * T + jb * MBLK + kc * 64) * HD + 2 * lane;
                for (int kk = 0; kk < 64; ++kk) { const unsigned vw = *(const unsigned*)(vp + (size_t)kk * HD); const float pk = pl[kk]; o0 += pk * bf_lo(vw); o1 += pk * bf_hi(vw); }
                asm volatile("s_waitcnt lgkmcnt(0)" ::: "memory");
            }
        }
        const float inv = 1.0f / lrun;
        *(unsigned*)(O + ((size_t)(b * T + t)) * D + h * HD + 2 * lane) = cvt_pk_bf16(o0 * inv, o1 * inv);
    }
}
#endif

__device__ __forceinline__ void ph_conv(const Ctx& c, const float* cw, const float* cb) {
    const bf16_t* R = (const bf16_t*)(c.ws + WS_R); bf16_t* RC = (bf16_t*)(c.ws + WS_RC);
    for (int i = c.vcu * 512 + c.tid; i < NTOK * (D / 8); i += c.G * 512) {
        const int n = i >> 7, c8 = (i & 127) * 8, t = n & (T - 1);
        float a[8];
#pragma unroll
        for (int j = 0; j < 8; ++j) a[j] = cb[c8 + j];
#pragma unroll
        for (int k = 0; k < 4; ++k) { const int tt = t - 3 + k; if (tt < 0) continue;
            const u32x4 w = *(const u32x4*)(R + (size_t)(n - 3 + k) * D + c8); const f32x4 w0 = *(const f32x4*)(cw + k * D + c8), w1 = *(const f32x4*)(cw + k * D + c8 + 4);
            a[0] += w0[0] * bf_lo(w.x); a[1] += w0[1] * bf_hi(w.x); a[2] += w0[2] * bf_lo(w.y); a[3] += w0[3] * bf_hi(w.y);
            a[4] += w1[0] * bf_lo(w.z); a[5] += w1[1] * bf_hi(w.z); a[6] += w1[2] * bf_lo(w.w); a[7] += w1[3] * bf_hi(w.w); }
        u32x4 o; o.x = cvt_pk_bf16(a[0], a[1]); o.y = cvt_pk_bf16(a[2], a[3]); o.z = cvt_pk_bf16(a[4], a[5]); o.w = cvt_pk_bf16(a[6], a[7]);
        *(u32x4*)(RC + (size_t)n * D + c8) = o;
    }
}
__device__ __forceinline__ void ph_scan(const Ctx& c) {
    const float* Aa = (const float*)(c.ws + WS_AA); const float* Uu = (const float*)(c.ws + WS_UU); const bf16_t* Y = (const bf16_t*)(c.ws + WS_YBR); bf16_t* Gq = (bf16_t*)(c.ws + WS_G);
    LAS float* cA = (LAS float*)c.lds; LAS float* cH = cA + 512;
    for (int u = c.vcu; u < NB * (D / 16); u += c.G) {
        const int b = u / (D / 16), cg = u % (D / 16), ch = c.wave * 4 + (c.lane >> 4), col = cg * 16 + (c.lane & 15);
        const size_t base = ((size_t)b * T + ch * 128) * D + col;
        float A = 1.f, H = 0.f;
#pragma unroll 8
        for (int s = 0; s < 128; ++s) { const float a = Aa[base + (size_t)s * D], x = Uu[base + (size_t)s * D]; A *= a; H = a * H + x; }
        __syncthreads();
        cA[ch * 16 + (c.lane & 15)] = A; cH[ch * 16 + (c.lane & 15)] = H;
        __syncthreads();
        float h = 0.f;
        for (int p = 0; p < ch; ++p) h = cA[p * 16 + (c.lane & 15)] * h + cH[p * 16 + (c.lane & 15)];
#pragma unroll 8
        for (int s = 0; s < 128; ++s) { const float a = Aa[base + (size_t)s * D], x = Uu[base + (size_t)s * D]; h = a * h + x;
            const float y = __uint_as_float(((unsigned)Y[base + (size_t)s * D]) << 16); const float gv = h * y;
            unsigned r = __float_as_uint(gv); r += 0x7fffu + ((r >> 16) & 1u); Gq[base + (size_t)s * D] = (bf16_t)(r >> 16); }
    }
}

__device__ __forceinline__ void ln_affine(f32x4 (&v)[4], const float* g, const float* bta, int lane) {
    float s = 0.f;
#pragma unroll
    for (int j = 0; j < 4; ++j) s += (v[j][0] + v[j][1]) + (v[j][2] + v[j][3]);
    const float mean = wave_sum(s) * (1.0f / D); float s2 = 0.f;
#pragma unroll
    for (int j = 0; j < 4; ++j) { v[j] = v[j] - mean; s2 += (v[j][0] * v[j][0] + v[j][1] * v[j][1]) + (v[j][2] * v[j][2] + v[j][3] * v[j][3]); }
    const float rstd = 1.0f / sqrtf(wave_sum(s2) * (1.0f / D) + LN_EPS);
#pragma unroll
    for (int j = 0; j < 4; ++j) { const f32x4 gg = *(const f32x4*)(g + 4 * lane + 256 * j), bb = *(const f32x4*)(bta + 4 * lane + 256 * j); v[j] = v[j] * rstd * gg + bb; }
}
__device__ __forceinline__ void store_row(const f32x4 (&v)[4], float* xf, bf16_t* xb, int lane) {
#pragma unroll
    for (int j = 0; j < 4; ++j) { *(f32x4*)(xf + 4 * lane + 256 * j) = v[j]; u32x2 w; w.x = cvt_pk_bf16(v[j][0], v[j][1]); w.y = cvt_pk_bf16(v[j][2], v[j][3]); *(u32x2*)(xb + 4 * lane + 256 * j) = w; }
}

__device__ __forceinline__ void ph_lnr(const Ctx& c, int layer, const float* g, const float* bta, const float* wr, const float* br) {
    const float* Z = (const float*)(c.ws + WS_Z); float* XF = (float*)(c.ws + WS_XF); bf16_t* XB = (bf16_t*)(c.ws + WS_XB);
    int* tope = (int*)(c.ws + WS_TOPE); int* tops = (int*)(c.ws + WS_TOPS); float* topg = (float*)(c.ws + WS_TOPG);
    int* list = (int*)(c.ws + WS_LIST) + (size_t)layer * NE * NTOK; unsigned* cntw = (unsigned*)(c.ws + WS_CTL) + CW_CNT + layer * 64;
    LAS float* wl = (LAS float*)c.lds;
    LAS int* be = (LAS int*)(c.lds + LNR_OFF); LAS int* brk = be + 256; LAS int* bbase = brk + 256; LAS int* bcnt = bbase + 32;
    const int lane = c.lane;
    __syncthreads();
    for (int idx = c.tid; idx < D * 8; idx += 512) { const int d = idx >> 3, e4 = idx & 7; const int slot = ((d & 255) >> 2) + 64 * ((d >> 8) * 4 + (d & 3));
        *(LAS f32x4*)(wl + slot * 36 + e4 * 4) = *(const f32x4*)(wr + d * NE + e4 * 4); }
    __syncthreads();
    for (int tile = c.vcu; tile < NTOK / 64; tile += c.G) {
        for (int i = 0; i < 8; ++i) {
            const int rit = c.wave * 8 + i, n = tile * 64 + rit;
            f32x4 v[4];
#pragma unroll
            for (int j = 0; j < 4; ++j) v[j] = *(const f32x4*)(Z + (size_t)n * D + 4 * lane + 256 * j);
            ln_affine(v, g, bta, lane);
            store_row(v, XF + (size_t)n * D, XB + (size_t)n * D, lane);
            float acc[32];
#pragma unroll
            for (int e = 0; e < 32; ++e) acc[e] = 0.f;
#pragma unroll
            for (int j = 0; j < 4; ++j)
#pragma unroll
                for (int q = 0; q < 4; ++q) { const float xv = v[j][q]; const LAS f32x4* wp = (const LAS f32x4*)(wl + (lane + 64 * (4 * j + q)) * 36);
#pragma unroll
                    for (int e4 = 0; e4 < 8; ++e4) { const f32x4 w = wp[e4]; acc[4 * e4] += xv * w[0]; acc[4 * e4 + 1] += xv * w[1]; acc[4 * e4 + 2] += xv * w[2]; acc[4 * e4 + 3] += xv * w[3]; } }
            float a1[16], a2[8], a3[4], a4[2], a5;
#pragma unroll
            for (int k = 0; k < 16; ++k) { const bool hi = lane & 1; const float keep = hi ? acc[2 * k + 1] : acc[2 * k], send = hi ? acc[2 * k] : acc[2 * k + 1]; a1[k] = keep + __shfl_xor(send, 1); }
#pragma unroll
            for (int k = 0; k < 8; ++k) { const bool hi = lane & 2; const float keep = hi ? a1[2 * k + 1] : a1[2 * k], send = hi ? a1[2 * k] : a1[2 * k + 1]; a2[k] = keep + __shfl_xor(send, 2); }
#pragma unroll
            for (int k = 0; k < 4; ++k) { const bool hi = lane & 4; const float keep = hi ? a2[2 * k + 1] : a2[2 * k], send = hi ? a2[2 * k] : a2[2 * k + 1]; a3[k] = keep + __shfl_xor(send, 4); }
#pragma unroll
            for (int k = 0; k < 2; ++k) { const bool hi = lane & 8; const float keep = hi ? a3[2 * k + 1] : a3[2 * k], send = hi ? a3[2 * k] : a3[2 * k + 1]; a4[k] = keep + __shfl_xor(send, 8); }
            { const bool hi = lane & 16; const float keep = hi ? a4[1] : a4[0], send = hi ? a4[0] : a4[1]; a5 = keep + __shfl_xor(send, 16); }
            float val = a5 + __shfl_xor(a5, 32) + br[lane & 31];
            float tv[4]; int te[4];
#pragma unroll
            for (int k = 0; k < 4; ++k) { const float m = wave_max(val); const unsigned long long bal = __ballot(val == m); const int idx = __ffsll((long long)bal) - 1; tv[k] = m; te[k] = idx & 31; if ((lane & 31) == (idx & 31)) val = -__builtin_inff(); }
            const float e1 = __expf(tv[1] - tv[0]), e2 = __expf(tv[2] - tv[0]), e3 = __expf(tv[3] - tv[0]), inv = 1.0f / (1.0f + e1 + e2 + e3);
            if (lane == 0) { be[rit * 4 + 0] = te[0]; be[rit * 4 + 1] = te[1]; be[rit * 4 + 2] = te[2]; be[rit * 4 + 3] = te[3];
                *(f32x4*)(topg + (size_t)n * 4) = (f32x4){inv, e1 * inv, e2 * inv, e3 * inv}; }
        }
        __syncthreads();
        if (c.tid < NE) { int cnt = 0; for (int i = 0; i < 256; ++i) { if (be[i] == c.tid) { brk[i] = cnt; ++cnt; } }
            bcnt[c.tid] = cnt; bbase[c.tid] = cnt ? (int)__hip_atomic_fetch_add(cntw + c.tid, (unsigned)cnt, RLX_AGENT) : 0; }
        __syncthreads();
        if (c.tid < 256) { const int e = be[c.tid], slot = bbase[e] + brk[c.tid], n = tile * 64 + (c.tid >> 2);
            list[(size_t)e * NTOK + slot] = n; tope[(size_t)n * 4 + (c.tid & 3)] = e; tops[(size_t)n * 4 + (c.tid & 3)] = slot; }
        __syncthreads();
    }
}

__device__ __forceinline__ void ph_comb(const Ctx& c, int layer, float* xout, const float* g, const float* bta, const float* bd) {
    const float* XF = (const float*)(c.ws + WS_XF); bf16_t* XB = (bf16_t*)(c.ws + WS_XB); const bf16_t* YB = (const bf16_t*)(c.ws + WS_YB);
    const int* tope = (const int*)(c.ws + WS_TOPE); const int* tops = (const int*)(c.ws + WS_TOPS); const float* topg = (const float*)(c.ws + WS_TOPG);
    (void)moe_tables(c.lds, (const unsigned*)(c.ws + WS_CTL) + CW_CNT + layer * 64, c.tid);
    const int gw = c.vcu * 8 + c.wave, NGW = c.G * 8, lane = c.lane;
    for (int n = gw; n < NTOK; n += NGW) {
        f32x4 v[4];
#pragma unroll
        for (int j = 0; j < 4; ++j) v[j] = *(const f32x4*)(XF + (size_t)n * D + 4 * lane + 256 * j) * ALPHA;
#pragma unroll
        for (int k = 0; k < 4; ++k) { const int e = tope[(size_t)n * 4 + k], slot = tops[(size_t)n * 4 + k]; const float gt = topg[(size_t)n * 4 + k];
            const size_t row = ((size_t)MOE_MTBASE(c.lds)[e] << 8) + slot;
#pragma unroll
            for (int j = 0; j < 4; ++j) { const u32x2 w = *(const u32x2*)(YB + row * D + 4 * lane + 256 * j); const f32x4 bb = *(const f32x4*)(bd + (size_t)e * D + 4 * lane + 256 * j);
                v[j][0] += gt * (bf_lo(w.x) + bb[0]); v[j][1] += gt * (bf_hi(w.x) + bb[1]); v[j][2] += gt * (bf_lo(w.y) + bb[2]); v[j][3] += gt * (bf_hi(w.y) + bb[3]); } }
        ln_affine(v, g, bta, lane);
        store_row(v, xout + (size_t)n * D, XB + (size_t)n * D, lane);
    }
}

constexpr int PH_PER_LAYER = 9, N_PHASES = 1 + DEPTH * PH_PER_LAYER;

__global__ void __launch_bounds__(512, 2) mk_fwd(Args args) {
    extern __shared__ __attribute__((aligned(16))) unsigned char lds_raw[];
    Ctx c0;
    c0.ws = args.ws; c0.lds = (LAS unsigned char*)lds_raw;
    c0.tid = threadIdx.x; c0.lane = c0.tid & 63; c0.wave = __builtin_amdgcn_readfirstlane(c0.tid >> 6);
    c0.G = gridDim.x; c0.bx = blockIdx.x; { const int bx = blockIdx.x; c0.vcu = (c0.G % 8 == 0) ? (bx % 8) * (c0.G / 8) + bx / 8 : bx; }
    volatile LAS unsigned* MISC = (volatile LAS unsigned*)(c0.lds + MISC_OFF);
    if (c0.tid < 64) MISC[c0.tid] = 0u;
    __syncthreads();
    unsigned* ctl = (unsigned*)(c0.ws + WS_CTL);
#if MK_PER_PHASE
#define GRID_BAR() do { } while (0)
#else
    XcdBarrier bar = xcd_barrier_post(ctl + CW_BAR, MISC + 8);
#define GRID_BAR() xcd_barrier(bar)
#endif
    const int lo = args.ph_lo, hi = args.ph_hi;
#ifndef PMASK
#define PMASK 0xFFFF
#endif
#define EN(b) ((PMASK >> (b)) & 1)
#define IN(k) (lo <= (k) && (k) < hi)
#define SEAM(k) do { if (IN(k) && IN((k) + 1)) GRID_BAR(); } while (0)
#define INP(i) (args.in[opaque_i(i)] + (size_t)(unsigned)opaque_i(0))
#define WSP() Ctx c = c0; c.ws = c0.ws + (size_t)(unsigned)opaque_i(0); c.tid = opaque_v(c0.tid); c.lane = c.tid & 63; c.wave = __builtin_amdgcn_readfirstlane(c.tid >> 6); c.G = opaque_i(c0.G); c.vcu = opaque_i(c0.vcu); c.bx = opaque_i(c0.bx); unsigned char* ws = c.ws

    if (EN(15) && IN(0)) { WSP(); (void)ws; ph_prologue(c, args); } SEAM(0);

#define LAYER(L_) do { \
        constexpr int L = L_; constexpr int p0 = 1 + L * PH_PER_LAYER, jm = L >> 1; \
        if constexpr ((L & 1) == 0) { \
            if (EN(0) && IN(p0 + 0)) { WSP(); SchedDense S; S.o.init(NTOK, 3 * D, c.G, c.bx); S.lda = D * 2; S.K = D; \
                const pg8::Gemm g{(const char*)(ws + WS_XB), (const char*)(ws + WS_WQKV) + (size_t)jm * 3 * D * D * 2, nullptr, D * 2, D}; \
                EpiQKV E{(bf16_t*)(ws + WS_Q)}; \
                pg8::gemm_phase<EpiQKV, SchedDense, false>(c.lds, g, S, E, c.tid); } SEAM(p0 + 0); \
            if (EN(1) && IN(p0 + 1)) { WSP(); (void)ws; ph_kmean(c); } SEAM(p0 + 1); \
            if (EN(2) && IN(p0 + 2)) { WSP(); (void)ws; ph_select(c); } SEAM(p0 + 2); \
            if (EN(3) && IN(p0 + 3)) { WSP(); (void)ws; ph_attn(c); } SEAM(p0 + 3); \
            if (EN(4) && IN(p0 + 4)) { WSP(); SchedDense S; S.o.init(NTOK, D, c.G, c.bx); S.lda = D * 2; S.K = D; \
                const pg8::Gemm g{(const char*)(ws + WS_O), (const char*)(ws + WS_WO) + (size_t)jm * D * D * 2, nullptr, D * 2, D}; \
                EpiResid E{(L == 0) ? INP(0) : (const float*)(ws + WS_XF), (float*)(ws + WS_Z)}; \
                pg8::gemm_phase<EpiResid, SchedDense, false>(c.lds, g, S, E, c.tid); } SEAM(p0 + 4); \
        } else { \
            if (EN(5) && IN(p0 + 0)) { WSP(); SchedDense S; S.o.init(NTOK, 2 * D, c.G, c.bx); S.lda = D * 2; S.K = D; \
                const pg8::Gemm g{(const char*)(ws + WS_XB), (const char*)(ws + WS_WIN) + (size_t)jm * 2 * D * D * 2, nullptr, D * 2, D}; \
                EpiLin E{(bf16_t*)(ws + WS_YBR), (bf16_t*)(ws + WS_R)}; \
                pg8::gemm_phase<EpiLin, SchedDense, false>(c.lds, g, S, E, c.tid); } SEAM(p0 + 0); \
            if (EN(6) && IN(p0 + 1)) { WSP(); (void)ws; ph_conv(c, INP(5) + (size_t)jm * 4 * D, INP(6) + (size_t)jm * D); } SEAM(p0 + 1); \
            if (EN(7) && IN(p0 + 2)) { WSP(); SchedGates S; S.o.init(NTOK, 2 * D, c.G, c.bx); \
                const pg8::Gemm g{(const char*)(ws + WS_RC), (const char*)(ws + WS_WG) + (size_t)jm * 4 * 512 * 256 * 2, nullptr, D * 2, 256}; \
                EpiGates E{(const bf16_t*)(ws + WS_RC), INP(8) + (size_t)jm * D, INP(10) + (size_t)jm * D, (const float*)(ws + WS_SPT) + (size_t)jm * D, (float*)(ws + WS_AA), (float*)(ws + WS_UU)}; \
                pg8::gemm_phase<EpiGates, SchedGates, false>(c.lds, g, S, E, c.tid); } SEAM(p0 + 2); \
            if (EN(8) && IN(p0 + 3)) { WSP(); (void)ws; ph_scan(c); } SEAM(p0 + 3); \
            if (EN(9) && IN(p0 + 4)) { WSP(); SchedDense S; S.o.init(NTOK, D, c.G, c.bx); S.lda = D * 2; S.K = D; \
                const pg8::Gemm g{(const char*)(ws + WS_G), (const char*)(ws + WS_WOUT) + (size_t)jm * D * D * 2, nullptr, D * 2, D}; \
                EpiResid E{(L == 0) ? INP(0) : (const float*)(ws + WS_XF), (float*)(ws + WS_Z)}; \
                pg8::gemm_phase<EpiResid, SchedDense, false>(c.lds, g, S, E, c.tid); } SEAM(p0 + 4); \
        } \
        if (EN(10) && IN(p0 + 5)) { WSP(); (void)ws; ph_lnr(c, L, INP(21) + L * D, INP(22) + L * D, INP(13) + (size_t)L * D * NE, INP(14) + L * NE); } SEAM(p0 + 5); \
        if (EN(11) && IN(p0 + 6)) { WSP(); const int total = moe_tables(c.lds, (unsigned*)(ws + WS_CTL) + CW_CNT + L * 64, c.tid); \
            SchedMoe S{c.lds, total, 8, c.G, c.vcu, (unsigned)(2 * D * D * 2), true}; \
            const pg8::Gemm g{(const char*)(ws + WS_XB), (const char*)(ws + WS_WGU) + (size_t)L * NE * 2 * D * D * 2, (const int*)(ws + WS_LIST) + (size_t)L * NE * NTOK, D * 2, D}; \
            EpiSwiglu E{INP(16) + (size_t)L * NE * D, INP(18) + (size_t)L * NE * D, (bf16_t*)(ws + WS_HB)}; \
            pg8::gemm_phase<EpiSwiglu, SchedMoe, true>(c.lds, g, S, E, c.tid); } SEAM(p0 + 6); \
        if (EN(12) && IN(p0 + 7)) { WSP(); const int total = moe_tables(c.lds, (unsigned*)(ws + WS_CTL) + CW_CNT + L * 64, c.tid); \
            SchedMoe S{c.lds, total, 4, c.G, c.vcu, (unsigned)(D * D * 2), false}; \
            const pg8::Gemm g{(const char*)(ws + WS_HB), (const char*)(ws + WS_WD) + (size_t)L * NE * D * D * 2, nullptr, D * 2, D}; \
            EpiPlain E{(bf16_t*)(ws + WS_YB)}; \
            pg8::gemm_phase<EpiPlain, SchedMoe, false>(c.lds, g, S, E, c.tid); } SEAM(p0 + 7); \
        if (EN(13) && IN(p0 + 8)) { WSP(); ph_comb(c, L, (L == DEPTH - 1) ? args.out : (float*)(ws + WS_XF), INP(23) + L * D, INP(24) + L * D, INP(20) + (size_t)L * NE * D); } SEAM(p0 + 8); \
    } while (0)
    LAYER(0); LAYER(1); LAYER(2); LAYER(3);
#undef IN
#undef SEAM
}

extern "C" void kernel_launch(void* const* d_in, const int* in_sizes, int n_in, void* d_out, int out_size, void* d_ws, size_t ws_size, hipStream_t stream) {
    static int grid = 0;
    if (grid == 0) {
        if (n_in != 25 || out_size != NTOK * D || ws_size < WS_END) { fprintf(stderr, "kernel_launch: unexpected shapes (n_in %d out %d ws %zu)\n", n_in, out_size, ws_size); grid = -1; return; }
        int dev = 0, cus = 0;
        if (hipGetDevice(&dev) != hipSuccess || hipDeviceGetAttribute(&cus, hipDeviceAttributeMultiprocessorCount, dev) != hipSuccess) { grid = -1; return; }
        if (hipFuncSetAttribute((const void*)mk_fwd, hipFuncAttributeMaxDynamicSharedMemorySize, LDS_BYTES) != hipSuccess) { fprintf(stderr, "kernel_launch: hipFuncSetAttribute failed\n"); grid = -1; return; }
        int per_cu = 0;
        if (hipOccupancyMaxActiveBlocksPerMultiprocessor(&per_cu, (const void*)mk_fwd, 512, LDS_BYTES) != hipSuccess || per_cu < 1) fprintf(stderr, "kernel_launch: occupancy query says %d\n", per_cu);
        (void)hipGetLastError();
        grid = cus;
    }
    if (grid < 0) return;
    (void)hipMemsetAsync((char*)d_ws + WS_CTL, 0, CTL_BYTES, stream);
    Args a{};
    for (int i = 0; i < 25; ++i) a.in[i] = (const float*)d_in[i];
    a.out = (float*)d_out; a.ws = (unsigned char*)d_ws;
#if MK_PER_PHASE
    for (int p = 0; p < N_PHASES; ++p) {
        const int L = (p - 1) / PH_PER_LAYER, k = (p - 1) % PH_PER_LAYER; (void)L; (void)k;
        a.ph_lo = p; a.ph_hi = p + 1;
        hipLaunchKernelGGL(mk_fwd, dim3(grid), dim3(512), LDS_BYTES, stream, a);
    }
#else
    a.ph_lo = 0; a.ph_hi = N_PHASES;
    hipLaunchKernelGGL(mk_fwd, dim3(grid), dim3(512), LDS_BYTES, stream, a);
#endif
}
```

```cpp
#include <hip/hip_runtime.h>
#include <cstdio>
#include <cstdint>

#ifndef MK_PER_PHASE
#define MK_PER_PHASE 0
#endif
#ifndef NAIVE_GEMM
#define NAIVE_GEMM 0
#endif
#ifndef NAIVE_ATTN
#define NAIVE_ATTN 0
#endif

#define GAS __attribute__((address_space(1)))
#define LAS __attribute__((address_space(3)))
typedef unsigned short bf16_t;
typedef short bf16x8 __attribute__((ext_vector_type(8)));
typedef float f32x4 __attribute__((ext_vector_type(4)));
typedef float f32x2 __attribute__((ext_vector_type(2)));
typedef unsigned u32x4 __attribute__((ext_vector_type(4)));
typedef unsigned u32x2 __attribute__((ext_vector_type(2)));

constexpr int NB = 4, T = 4096, D = 1024, NTOK = NB * T, NH = 8, HD = 128, MBLK = 256, NBLK = T / MBLK, NE = 32, TOPK = 4, DEPTH = 4;
constexpr float ALPHA = 1.6817928305074290f;
constexpr float LOG2E = 1.4426950408889634f;
constexpr float QSCALE = 0.08838834764831845f * LOG2E;
constexpr float LN_EPS = 1e-5f;
constexpr int MAXMT = NTOK * TOPK / 256 + NE;
constexpr int BIAS_W = 704;

constexpr size_t MiB = 1u << 20;
constexpr size_t WS_CTL = 0, CTL_BYTES = 1 * MiB;
constexpr size_t WS_BIAS = 1 * MiB;
constexpr size_t WS_SPT = 1 * MiB + 64 * 1024;
constexpr size_t WS_KMEAN = 1 * MiB + 256 * 1024;
constexpr size_t WS_SEL = 2 * MiB;
constexpr size_t WS_TOPE = 3 * MiB, WS_TOPS = 3 * MiB + 256 * 1024, WS_TOPG = 3 * MiB + 512 * 1024;
constexpr size_t WS_LIST = 4 * MiB;
constexpr size_t WS_WQKV = 16 * MiB, WS_WO = 28 * MiB, WS_WIN = 32 * MiB, WS_WG = 40 * MiB, WS_WOUT = 42 * MiB;
constexpr size_t WS_XB = 48 * MiB, WS_XF = 80 * MiB, WS_Z = 144 * MiB, WS_Q = 208 * MiB, WS_K = 240 * MiB, WS_V = 272 * MiB, WS_O = 304 * MiB;
constexpr size_t WS_YBR = 336 * MiB, WS_R = 368 * MiB, WS_RC = 400 * MiB, WS_AA = 432 * MiB, WS_UU = 496 * MiB, WS_G = 560 * MiB;
constexpr size_t WS_HB = 592 * MiB, WS_YB = 736 * MiB, WS_WGU = 880 * MiB, WS_WD = 1392 * MiB, WS_END = 1648 * MiB;
constexpr int CW_TMO = 0, CW_BAR = 4096, CW_CNT = 8192;

constexpr int LDS_BYTES = 153600;
constexpr int RING_BYTES = 131072;
constexpr int MOE_OFF = RING_BYTES;
constexpr int LNR_OFF = 147456;
constexpr int MISC_OFF = LDS_BYTES - 256;

#define RLX_AGENT __ATOMIC_RELAXED, __HIP_MEMORY_SCOPE_AGENT
__device__ __forceinline__ unsigned cvt_pk_bf16(float lo, float hi) { unsigned r; asm volatile("v_cvt_pk_bf16_f32 %0, %1, %2" : "=v"(r) : "v"(lo), "v"(hi)); return r; }
__device__ __forceinline__ float bf_lo(unsigned w) { return __uint_as_float(w << 16); }
__device__ __forceinline__ float bf_hi(unsigned w) { return __uint_as_float(w & 0xffff0000u); }
__device__ __forceinline__ float wave_sum(float v) {
#pragma unroll
    for (int o = 1; o < 64; o <<= 1) v += __shfl_xor(v, o);
    return v;
}
__device__ __forceinline__ float wave_max(float v) {
#pragma unroll
    for (int o = 1; o < 64; o <<= 1) v = fmaxf(v, __shfl_xor(v, o));
    return v;
}
__device__ __forceinline__ float sigmoidf_(float x) { return __builtin_amdgcn_rcpf(1.0f + __builtin_amdgcn_exp2f(-1.4426950408889634f * x)); }

#define XB_TMO      128
#define XB_XCNT(j)  (256  + 64 * (j))
#define XB_XSUB(j)  (1280 + 64 * (j))
#define XB_XGEN(j)  (2304 + 64 * (j))
#define XB_TOP      3328
#define XB_TOPGEN   3392
#define XCD_BAR_WORDS 3456
#define XB_SPIN_CAP (1u << 22)
__device__ __forceinline__ unsigned xb_ld(unsigned* p)              { return __hip_atomic_load(p, __ATOMIC_RELAXED, __HIP_MEMORY_SCOPE_AGENT); }
__device__ __forceinline__ unsigned xb_add(unsigned* p, unsigned v) { return __hip_atomic_fetch_add(p, v, __ATOMIC_RELAXED, __HIP_MEMORY_SCOPE_AGENT); }
__device__ __forceinline__ unsigned xb_xcc_id() { return (unsigned)__builtin_amdgcn_s_getreg((3 << 11) | 20) & 0xFu; }
#define XB_SPIN(cond, bar) do { unsigned _sp = 0; while (cond) { __builtin_amdgcn_s_sleep(1); \
    if ((++_sp & 255u) == 0u) { if (xb_ld(&(bar)[XB_TMO])) break; if (_sp > XB_SPIN_CAP) { atomicAdd(&(bar)[XB_TMO], 1u); break; } } } } while (0)
struct XcdBarrier { unsigned* bar; unsigned x; volatile LAS unsigned* st; };
__device__ __forceinline__ XcdBarrier xcd_barrier_post(unsigned* bar, volatile LAS unsigned* st) {
    XcdBarrier b; b.bar = bar; b.x = xb_xcc_id(); b.st = st;
    if (threadIdx.x == 0) (void)xb_add(&bar[XB_XCNT(b.x)], 1u);
    return b;
}
__device__ __forceinline__ void xcd_barrier_complete(unsigned* bar, unsigned x, unsigned& nloc, unsigned& nx) {
    const unsigned G = gridDim.x * gridDim.y * gridDim.z;
    unsigned sum, cnt, mine, sp = 0u;
    for (;;) {
        sum = 0u; cnt = 0u; mine = 0u;
#pragma unroll
        for (unsigned j = 0; j < 16; ++j) { const unsigned c = xb_ld(&bar[XB_XCNT(j)]); sum += c; cnt += (c > 0u) ? 1u : 0u; mine = (j == x) ? c : mine; }
        if (sum == G) break;
        __builtin_amdgcn_s_sleep(1);
        if ((++sp & 255u) == 0u) { if (xb_ld(&bar[XB_TMO])) break; if (sp > XB_SPIN_CAP) { atomicAdd(&bar[XB_TMO], 1u); break; } }
    }
    nloc = mine > 0u ? mine : 1u; nx = cnt > 0u ? cnt : 1u;
}
__device__ __forceinline__ void xcd_barrier(const XcdBarrier& b) {
    asm volatile("s_waitcnt vmcnt(0)" ::: "memory");
    __syncthreads();
    if (threadIdx.x == 0) {
        unsigned* bar = b.bar;
        __builtin_amdgcn_s_waitcnt(0);
        unsigned nloc = b.st[0], nx = b.st[1];
        if (nloc == 0u) { xcd_barrier_complete(bar, b.x, nloc, nx); b.st[0] = nloc; b.st[1] = nx; }
        const unsigned old = xb_add(&bar[XB_XSUB(b.x)], 1u);
        const unsigned gen = old / nloc;
        if (old + 1u == (gen + 1u) * nloc) {
            __builtin_amdgcn_fence(__ATOMIC_RELEASE, "agent");
            asm volatile("s_waitcnt vmcnt(0)" ::: "memory");
            const unsigned og = xb_add(&bar[XB_TOP], 1u);
            const unsigned tg = og / nx;
            if (og + 1u == (tg + 1u) * nx) xb_add(&bar[XB_TOPGEN], 1u);
            else XB_SPIN(xb_ld(&bar[XB_TOPGEN]) == tg, bar);
            __builtin_amdgcn_fence(__ATOMIC_ACQUIRE, "agent");
            xb_add(&bar[XB_XGEN(b.x)], 1u);
            asm volatile("s_waitcnt vmcnt(0)" ::: "memory");
        } else {
            XB_SPIN(xb_ld(&bar[XB_XGEN(b.x)]) == gen, bar);
            __builtin_amdgcn_fence(__ATOMIC_ACQUIRE, "agent");
            asm volatile("s_waitcnt vmcnt(0)" ::: "memory");
        }
    }
    __syncthreads();
}

namespace pg8 {
constexpr int BM = 256, BK = 64, HALF = 128, HTB = HALF * BK * 2, STAGE_BYTES = 8 * HTB, NXCD = 8, WGM = 8;
__host__ __device__ __forceinline__ int lds_byte(int r, int c) { const int st = (r >> 4) * 2 + (c >> 5), rr = r & 15, cc = c & 31, ob = rr * 64 + cc * 2; return st * 1024 + (ob ^ (((ob >> 9) & 1) << 5)); }
__host__ __device__ __forceinline__ void stage_rc(int b, int& R, int& C) { const int st = b / 1024, sb = b % 1024, swz = sb ^ (((sb >> 9) & 1) << 5); R = (st >> 1) * 16 + swz / 64; C = (st & 1) * 32 + (swz % 64) / 2; }
__host__ __device__ __forceinline__ int perm32(int rho) { const int n = rho >> 4, i = rho & 15; return 8 * (i >> 2) + 4 * n + (i & 3); }

struct Unit { unsigned a, b; int rl; int pm, pn, e, valid; };
struct Gemm { const char* A; const char* B; const int* list; int lda; int K; };

struct DenseOrder {
    int nM, nN, nwg, G, c;
    __device__ void init(int M, int N, int G_, int c_) { nM = M / BM; nN = N / BM; nwg = nM * nN; G = G_; c = c_; }
    __device__ bool tile(int i, int& pm, int& pn) const {
        const long L = (long)i * G + c; if (L >= nwg) return false;
        int wgid = (int)L; { const int q = nwg / NXCD, r = nwg % NXCD, xcd = wgid % NXCD, off = wgid / NXCD; wgid = (xcd < r ? xcd * (q + 1) : r * (q + 1) + (xcd - r) * q) + off; }
        const int nig = WGM * nN, gid = wgid / nig, fm = gid * WGM, gsz = (nM - fm) < WGM ? (nM - fm) : WGM;
        pm = fm + ((wgid % nig) % gsz); pn = (wgid % nig) / gsz; return true;
    }
};

#if NAIVE_GEMM
template <class Epi, class Sched, bool GATHER>
__device__ __forceinline__ void gemm_phase(LAS unsigned char* lds, const Gemm g, const Sched& S, const Epi& E, const int tid) {
    (void)lds;
    const int wid = __builtin_amdgcn_readfirstlane(tid >> 6), lane = tid & 63, wr = wid >> 2, wc = wid & 3, fr = lane & 15, fq = lane >> 4;
    Unit u;
    for (int i = 0; S.next(i, u); ++i) {
        f32x4 acc[2][2][4][2];
#pragma unroll
        for (int a = 0; a < 2; ++a)
#pragma unroll
            for (int b = 0; b < 2; ++b)
#pragma unroll
                for (int m = 0; m < 4; ++m)
#pragma unroll
                    for (int n = 0; n < 2; ++n) { f32x4 z_; asm volatile("v_mov_b32 %0, 0\n\tv_mov_b32 %1, 0\n\tv_mov_b32 %2, 0\n\tv_mov_b32 %3, 0" : "=v"(z_[0]), "=v"(z_[1]), "=v"(z_[2]), "=v"(z_[3])); acc[a][b][m][n] = z_; }
        unsigned ao[2][4], bo[2][2];
#pragma unroll
        for (int ai = 0; ai < 2; ++ai)
#pragma unroll
            for (int m = 0; m < 4; ++m) { const int r = 128 * ai + 64 * wr + 16 * m + fr;
                if (GATHER) { const int idx = g.list[u.rl + (r < u.valid ? r : 0)]; ao[ai][m] = (unsigned)idx * (unsigned)g.lda + fq * 16; }
                else ao[ai][m] = u.a + (unsigned)r * (unsigned)g.lda + fq * 16; }
#pragma unroll
        for (int bj = 0; bj < 2; ++bj)
#pragma unroll
            for (int n = 0; n < 2; ++n) { const int r = 128 * bj + 32 * wc + perm32(16 * n + fr); bo[bj][n] = u.b + (unsigned)r * (unsigned)g.K * 2u + fq * 16; }
#pragma unroll 1
        for (int k0 = 0; k0 < g.K; k0 += 32) {
            bf16x8 B[2][2];
#pragma unroll
            for (int bj = 0; bj < 2; ++bj)
#pragma unroll
                for (int n = 0; n < 2; ++n) B[bj][n] = *(const bf16x8*)(g.B + bo[bj][n] + k0 * 2);
#pragma unroll
            for (int ai = 0; ai < 2; ++ai) {
                bf16x8 A[4];
#pragma unroll
                for (int m = 0; m < 4; ++m) A[m] = *(const bf16x8*)(g.A + ao[ai][m] + k0 * 2);
#pragma unroll
                for (int bj = 0; bj < 2; ++bj)
#pragma unroll
                    for (int m = 0; m < 4; ++m)
#pragma unroll
                        for (int n = 0; n < 2; ++n) acc[ai][bj][m][n] = __builtin_amdgcn_mfma_f32_16x16x32_bf16(B[bj][n], A[m], acc[ai][bj][m][n], 0, 0, 0);
            }
        }
        E(acc, u, wr, wc, fr, fq);
    }
}
#else
template <class Epi, class Sched, bool GATHER>
__device__ __forceinline__ void gemm_phase(LAS unsigned char* lds, const Gemm g, const Sched& S, const Epi& E, const int tid) {
    const int wid = __builtin_amdgcn_readfirstlane(tid >> 6), lane = tid & 63, wr = wid >> 2, wc = wid & 3, fr = lane & 15, fq = lane >> 4;
    const int K = g.K, nt = K / BK;
    unsigned voffB[2], vA0[2], vA1[2], vN0[2], vN1[2]; int sR[2], sC[2];
#pragma unroll
    for (int i = 0; i < 2; ++i) { int R, C; stage_rc(tid * 16 + i * 8192, R, C); const int Rb = (R & ~31) + perm32(R & 31);
        sR[i] = R; sC[i] = C * 2; voffB[i] = (unsigned)(Rb * K + C) * 2u; vA0[i] = (unsigned)(R * g.lda + C * 2); vA1[i] = vA0[i] + (unsigned)(HALF * g.lda); vN0[i] = vA0[i]; vN1[i] = vA1[i]; }
    const size_t kstep = (size_t)(BK * 2);
    const size_t hstepB = (size_t)HALF * K * 2;
    const unsigned ldsw = (unsigned)wid * 1024u;
    const int aoff = lds_byte(wr * 64 + fr, fq * 8), boff = lds_byte(wc * 32 + fr, fq * 8);
#define PG8_SA(b, h) (((b) * 2 + (h)) * HTB)
#define PG8_SB(b, h) ((4 + (b) * 2 + (h)) * HTB)
#define PG8_STAGE(bufoff, gbase, voff) do { _Pragma("unroll") for (int _i = 0; _i < 2; ++_i) \
        __builtin_amdgcn_global_load_lds((const unsigned*)((const char*)(gbase) + (voff)[_i]), (LAS unsigned*)(lds + (bufoff) + ldsw + _i * 8192), 16, 0, 0); } while (0)
#define PG8_LDA(dst, b, h) do { _Pragma("unroll") for (int m = 0; m < 4; ++m) _Pragma("unroll") for (int k = 0; k < 2; ++k) dst[m][k] = *(const LAS bf16x8*)(lds + PG8_SA(b, h) + aoff + m * 2048 + k * 1024); } while (0)
#define PG8_LDB(dst, b, h) do { _Pragma("unroll") for (int n = 0; n < 2; ++n) _Pragma("unroll") for (int k = 0; k < 2; ++k) dst[n][k] = *(const LAS bf16x8*)(lds + PG8_SB(b, h) + boff + n * 2048 + k * 1024); } while (0)
#define PG8_MMA(ai, bj, At, Bt) do { __builtin_amdgcn_s_setprio(1); _Pragma("unroll") for (int m = 0; m < 4; ++m) _Pragma("unroll") for (int n = 0; n < 2; ++n) _Pragma("unroll") for (int k = 0; k < 2; ++k) \
        acc[ai][bj][m][n] = __builtin_amdgcn_mfma_f32_16x16x32_bf16(Bt[n][k], At[m][k], acc[ai][bj][m][n], 0, 0, 0); __builtin_amdgcn_s_setprio(0); } while (0)
#define PG8_WAIT_V(n) asm volatile("s_waitcnt vmcnt(" #n ")" ::: "memory")
#define PG8_WAIT_L(n) asm volatile("s_waitcnt lgkmcnt(" #n ")" ::: "memory")
#define PG8_BAR __builtin_amdgcn_s_barrier()
#define PG8_SCHED __builtin_amdgcn_sched_barrier(0)
#define PG8_GATHER_OFFS(u_, o0, o1) do { if constexpr (GATHER) { _Pragma("unroll") for (int _i = 0; _i < 2; ++_i) { \
        const int r0_ = sR[_i], r1_ = sR[_i] + HALF; const int i0_ = g.list[(u_).rl + (r0_ < (u_).valid ? r0_ : 0)], i1_ = g.list[(u_).rl + (r1_ < (u_).valid ? r1_ : 0)]; \
        o0[_i] = (unsigned)i0_ * (unsigned)g.lda + (unsigned)sC[_i]; o1[_i] = (unsigned)i1_ * (unsigned)g.lda + (unsigned)sC[_i]; } } } while (0)
    Unit cur, nxt; int ui = 0;
    if (!S.next(0, cur)) return;
    f32x4 acc[2][2][4][2];
#pragma unroll
    for (int a = 0; a < 2; ++a)
#pragma unroll
        for (int b = 0; b < 2; ++b)
#pragma unroll
            for (int m = 0; m < 4; ++m)
#pragma unroll
                for (int n = 0; n < 2; ++n) { f32x4 z_; asm volatile("v_mov_b32 %0, 0\n\tv_mov_b32 %1, 0\n\tv_mov_b32 %2, 0\n\tv_mov_b32 %3, 0" : "=v"(z_[0]), "=v"(z_[1]), "=v"(z_[2]), "=v"(z_[3])); acc[a][b][m][n] = z_; }
    bf16x8 At[4][2], B0[2][2], B1[2][2];
    const char* cA = g.A + cur.a; const char* cB = g.B + cur.b;
    PG8_GATHER_OFFS(cur, vA0, vA1);
    PG8_STAGE(PG8_SB(0, 0), cB, voffB); PG8_STAGE(PG8_SB(0, 1), cB + hstepB, voffB); PG8_STAGE(PG8_SA(0, 0), cA, vA0); PG8_STAGE(PG8_SA(0, 1), cA, vA1);
    if (wr == 1) PG8_BAR;
    PG8_WAIT_V(2); PG8_BAR;
    PG8_STAGE(PG8_SB(1, 0), cB + kstep, voffB); PG8_STAGE(PG8_SA(1, 0), cA + kstep, vA0); PG8_STAGE(PG8_SB(1, 1), cB + hstepB + kstep, voffB);
    PG8_WAIT_V(6); PG8_BAR;
    for (;;) {
        const bool has_next = S.next(ui + 1, nxt);
        const char* nA = has_next ? g.A + nxt.a : cA; const char* nB = has_next ? g.B + nxt.b : cB;
        if constexpr (GATHER) { if (has_next) { PG8_GATHER_OFFS(nxt, vN0, vN1); } else {
#pragma unroll
            for (int i = 0; i < 2; ++i) { vN0[i] = vA0[i]; vN1[i] = vA1[i]; } } }
        for (int t = 0; t < nt; t += 2) {
            const bool last = (t == nt - 2);
            const char* a1 = cA + (size_t)(t + 1) * kstep;
            const char* a2 = last ? nA : cA + (size_t)(t + 2) * kstep; const char* b2 = last ? nB : cB + (size_t)(t + 2) * kstep;
            const char* a3 = a2 + kstep; const char* b3 = b2 + kstep;
            unsigned x0[2], x1[2];
#pragma unroll
            for (int i = 0; i < 2; ++i) { x0[i] = (GATHER && last) ? vN0[i] : vA0[i]; x1[i] = (GATHER && last) ? vN1[i] : vA1[i]; }
            PG8_LDB(B0, 0, 0); PG8_LDB(B1, 0, 1); PG8_SCHED; PG8_LDA(At, 0, 0); PG8_STAGE(PG8_SA(1, 1), a1, vA1);
            PG8_WAIT_V(8); PG8_WAIT_L(0); PG8_BAR; PG8_MMA(0, 0, At, B0); PG8_MMA(0, 1, At, B1); PG8_BAR; PG8_SCHED;
            PG8_LDA(At, 0, 1); PG8_STAGE(PG8_SB(0, 0), b2, voffB); PG8_STAGE(PG8_SB(0, 1), b2 + hstepB, voffB); PG8_STAGE(PG8_SA(0, 0), a2, x0);
            PG8_WAIT_V(8); PG8_WAIT_L(0); PG8_BAR; PG8_MMA(1, 0, At, B0); PG8_MMA(1, 1, At, B1); PG8_BAR; PG8_SCHED;
            PG8_LDB(B0, 1, 0); PG8_LDB(B1, 1, 1); PG8_SCHED; PG8_LDA(At, 1, 0); PG8_STAGE(PG8_SA(0, 1), a2, x1);
            PG8_WAIT_V(8); PG8_WAIT_L(0); PG8_BAR; PG8_MMA(0, 0, At, B0); PG8_MMA(0, 1, At, B1); PG8_BAR; PG8_SCHED;
            PG8_LDA(At, 1, 1); PG8_STAGE(PG8_SB(1, 0), b3, voffB); PG8_STAGE(PG8_SB(1, 1), b3 + hstepB, voffB); PG8_STAGE(PG8_SA(1, 0), a3, x0);
            PG8_WAIT_V(8); PG8_WAIT_L(0); PG8_BAR; PG8_MMA(1, 0, At, B0); PG8_MMA(1, 1, At, B1); PG8_BAR; PG8_SCHED;
        }
        if (wr == 0) PG8_BAR;
        E(acc, cur, wr, wc, fr, fq);
        if (!has_next) break;
#pragma unroll
        for (int a = 0; a < 2; ++a)
#pragma unroll
            for (int b = 0; b < 2; ++b)
#pragma unroll
                for (int m = 0; m < 4; ++m)
#pragma unroll
                    for (int n = 0; n < 2; ++n) { f32x4 z_; asm volatile("v_mov_b32 %0, 0\n\tv_mov_b32 %1, 0\n\tv_mov_b32 %2, 0\n\tv_mov_b32 %3, 0" : "=v"(z_[0]), "=v"(z_[1]), "=v"(z_[2]), "=v"(z_[3])); acc[a][b][m][n] = z_; }
        cur = nxt; cA = nA; cB = nB; ++ui;
        if constexpr (GATHER) {
#pragma unroll
            for (int i = 0; i < 2; ++i) { vA0[i] = vN0[i]; vA1[i] = vN1[i]; } }
        if (wr == 1) PG8_BAR;
    }
    PG8_WAIT_V(0);
    PG8_BAR;
#undef PG8_SA
#undef PG8_SB
#undef PG8_STAGE
#undef PG8_LDA
#undef PG8_LDB
#undef PG8_MMA
#undef PG8_WAIT_V
#undef PG8_WAIT_L
#undef PG8_BAR
#undef PG8_SCHED
#undef PG8_GATHER_OFFS
}
#endif
}
using pg8::Unit;

struct SchedDense {
    pg8::DenseOrder o; int lda, K;
    __device__ __forceinline__ bool next(int i, Unit& u) const { int pm, pn; if (!o.tile(i, pm, pn)) return false;
        u.pm = pm; u.pn = pn; u.e = 0; u.valid = 256; u.rl = 0; u.a = (unsigned)pm * 256u * (unsigned)lda; u.b = (unsigned)pn * 256u * (unsigned)K * 2u; return true; }
};
struct SchedGates {
    pg8::DenseOrder o;
    __device__ __forceinline__ bool next(int i, Unit& u) const { int pm, pn; if (!o.tile(i, pm, pn)) return false;
        const int gi = pn >> 1, hf = pn & 1; u.pm = pm; u.pn = hf; u.e = gi; u.valid = 256; u.rl = 0;
        u.a = (unsigned)pm * 256u * (D * 2) + gi * 256 * 2; u.b = (unsigned)gi * (512 * 256 * 2) + (unsigned)hf * 256 * 256 * 2; return true; }
};
#define MOE_CNT(lds)    ((LAS int*)((lds) + MOE_OFF))
#define MOE_MTBASE(lds) ((LAS int*)((lds) + MOE_OFF + 128))
#define MOE_MTE(lds)    ((LAS int*)((lds) + MOE_OFF + 288))
struct SchedMoe {
    LAS unsigned char* lds; int total, NT, G, c; unsigned bstride; bool gather;
    __device__ __forceinline__ bool next(int i, Unit& u) const {
        const int L = i * G + c; if (L >= total * NT) return false;
        const int mt = L / NT, nt = L - mt * NT;
        const int e = __builtin_amdgcn_readfirstlane(MOE_MTE(lds)[mt]); const int ml = mt - __builtin_amdgcn_readfirstlane(MOE_MTBASE(lds)[e]);
        const int left = __builtin_amdgcn_readfirstlane(MOE_CNT(lds)[e]) - ml * 256;
        u.pm = mt; u.pn = nt; u.e = e; u.valid = left < 256 ? left : 256; u.rl = e * NTOK + ml * 256;
        u.a = gather ? 0u : (unsigned)mt * 256u * (D * 2); u.b = (unsigned)e * bstride + (unsigned)nt * 256u * D * 2; return true; }
};
__device__ __forceinline__ int moe_tables(LAS unsigned char* lds, const unsigned* cntw, const int tid) {
    LAS int* cnt = MOE_CNT(lds); LAS int* mtbase = MOE_MTBASE(lds); LAS int* mte = MOE_MTE(lds);
    __syncthreads();
    if (tid < 32) cnt[tid] = (int)__hip_atomic_load(cntw + tid, RLX_AGENT);
    __syncthreads();
    if (tid == 0) { int s = 0; for (int e = 0; e < NE; ++e) { mtbase[e] = s; const int n = (cnt[e] + 255) >> 8; for (int j = 0; j < n; ++j) mte[s + j] = e; s += n; } mtbase[NE] = s; }
    __syncthreads();
    return __builtin_amdgcn_readfirstlane(mtbase[NE]);
}

typedef f32x4 Acc[2][2][4][2];
struct EpiQKV {
    bf16_t* q;
    __device__ __forceinline__ void operator()(const Acc& acc, const Unit& u, int wr, int wc, int fr, int fq) const {
        const int which = u.pn >> 2; bf16_t* base = q + (size_t)which * ((WS_K - WS_Q) / 2); const float sc = which == 0 ? QSCALE : 1.0f;
#pragma unroll
        for (int ai = 0; ai < 2; ++ai)
#pragma unroll
            for (int m = 0; m < 4; ++m) { const int ntok = u.pm * 256 + 128 * ai + 64 * wr + 16 * m + fr, b = ntok >> 12, t = ntok & 4095;
#pragma unroll
                for (int bj = 0; bj < 2; ++bj) { const int head = (u.pn & 3) * 2 + bj, d = 32 * wc + 8 * fq;
                    const f32x4 v0 = acc[ai][bj][m][0] * sc, v1 = acc[ai][bj][m][1] * sc;
                    u32x4 w; w.x = cvt_pk_bf16(v0[0], v0[1]); w.y = cvt_pk_bf16(v0[2], v0[3]); w.z = cvt_pk_bf16(v1[0], v1[1]); w.w = cvt_pk_bf16(v1[2], v1[3]);
                    *(u32x4*)(base + ((size_t)((b * NH + head) * T + t)) * HD + d) = w; } }
    }
};
struct EpiResid {
    const float* X; float* Z;
    __device__ __forceinline__ void operator()(const Acc& acc, const Unit& u, int wr, int wc, int fr, int fq) const {
#pragma unroll
        for (int ai = 0; ai < 2; ++ai)
#pragma unroll
            for (int m = 0; m < 4; ++m) { const size_t row = (size_t)(u.pm * 256 + 128 * ai + 64 * wr + 16 * m + fr);
#pragma unroll
                for (int bj = 0; bj < 2; ++bj) { const size_t off = row * D + u.pn * 256 + 128 * bj + 32 * wc + 8 * fq;
                    const f32x4 x0 = *(const f32x4*)(X + off), x1 = *(const f32x4*)(X + off + 4);
                    *(f32x4*)(Z + off) = x0 * ALPHA + acc[ai][bj][m][0]; *(f32x4*)(Z + off + 4) = x1 * ALPHA + acc[ai][bj][m][1]; }
                asm volatile("" ::: "memory"); }
    }
};
__device__ __forceinline__ float gelu_tanh(float x) { const float y = 0.7978845608028654f * (x + 0.044715f * x * x * x); return x * __builtin_amdgcn_rcpf(1.0f + __builtin_amdgcn_exp2f(-2.0f * LOG2E * y)); }
struct EpiLin {
    bf16_t* ybr; bf16_t* r;
    __device__ __forceinline__ void operator()(const Acc& acc, const Unit& u, int wr, int wc, int fr, int fq) const {
        const bool isy = u.pn < 4; bf16_t* base = isy ? ybr : r; const int ct = isy ? u.pn : u.pn - 4;
#pragma unroll
        for (int ai = 0; ai < 2; ++ai)
#pragma unroll
            for (int m = 0; m < 4; ++m) { const size_t row = (size_t)(u.pm * 256 + 128 * ai + 64 * wr + 16 * m + fr);
#pragma unroll
                for (int bj = 0; bj < 2; ++bj) { f32x4 v0 = acc[ai][bj][m][0], v1 = acc[ai][bj][m][1];
                    if (isy) {
#pragma unroll
                        for (int j = 0; j < 4; ++j) { v0[j] = gelu_tanh(v0[j]); v1[j] = gelu_tanh(v1[j]); } }
                    u32x4 w; w.x = cvt_pk_bf16(v0[0], v0[1]); w.y = cvt_pk_bf16(v0[2], v0[3]); w.z = cvt_pk_bf16(v1[0], v1[1]); w.w = cvt_pk_bf16(v1[2], v1[3]);
                    *(u32x4*)(base + row * D + ct * 256 + 128 * bj + 32 * wc + 8 * fq) = w; } }
    }
};
struct EpiGates {
    const bf16_t* rc; const float* bgx; const float* bga; const float* spt; float* Aa; float* Uu;
    __device__ __forceinline__ void operator()(const Acc& acc, const Unit& u, int wr, int wc, int fr, int fq) const {
        const int ch = u.e * 256 + u.pn * 128 + 32 * wc + 8 * fq;
        const f32x4 bx0 = *(const f32x4*)(bgx + ch), bx1 = *(const f32x4*)(bgx + ch + 4), ba0 = *(const f32x4*)(bga + ch), ba1 = *(const f32x4*)(bga + ch + 4), sp0 = *(const f32x4*)(spt + ch), sp1 = *(const f32x4*)(spt + ch + 4);
#pragma unroll
        for (int ai = 0; ai < 2; ++ai)
#pragma unroll
            for (int m = 0; m < 4; ++m) { const size_t row = (size_t)(u.pm * 256 + 128 * ai + 64 * wr + 16 * m + fr);
                const u32x4 rw = *(const u32x4*)(rc + row * D + ch);
                const f32x4 r0 = {bf_lo(rw.x), bf_hi(rw.x), bf_lo(rw.y), bf_hi(rw.y)}, r1 = {bf_lo(rw.z), bf_hi(rw.z), bf_lo(rw.w), bf_hi(rw.w)};
                f32x4 a0, a1, u0, u1;
#pragma unroll
                for (int j = 0; j < 4; ++j) {
                    { const float gx = sigmoidf_(acc[ai][0][m][0][j] + bx0[j]), ga = sigmoidf_(acc[ai][1][m][0][j] + ba0[j]); const float la = ga * sp0[j], x = 2.0f * la;
                      a0[j] = __builtin_amdgcn_exp2f(la * LOG2E); const float om = (x > -0.02f) ? -x * (1.0f + x * (0.5f + x * (1.0f / 6.0f))) : 1.0f - __builtin_amdgcn_exp2f(x * LOG2E); u0[j] = __builtin_amdgcn_sqrtf(om) * gx * r0[j]; }
                    { const float gx = sigmoidf_(acc[ai][0][m][1][j] + bx1[j]), ga = sigmoidf_(acc[ai][1][m][1][j] + ba1[j]); const float la = ga * sp1[j], x = 2.0f * la;
                      a1[j] = __builtin_amdgcn_exp2f(la * LOG2E); const float om = (x > -0.02f) ? -x * (1.0f + x * (0.5f + x * (1.0f / 6.0f))) : 1.0f - __builtin_amdgcn_exp2f(x * LOG2E); u1[j] = __builtin_amdgcn_sqrtf(om) * gx * r1[j]; } }
                *(f32x4*)(Aa + row * D + ch) = a0; *(f32x4*)(Aa + row * D + ch + 4) = a1;
                *(f32x4*)(Uu + row * D + ch) = u0; *(f32x4*)(Uu + row * D + ch + 4) = u1;
                asm volatile("" ::: "memory"); }
    }
};
struct EpiSwiglu {
    const float* bg; const float* bu; bf16_t* hb;
    __device__ __forceinline__ void operator()(const Acc& acc, const Unit& u, int wr, int wc, int fr, int fq) const {
        const int col = u.pn * 128 + 32 * wc + 8 * fq;
        const f32x4 gA = *(const f32x4*)(bg + u.e * D + col), gB = *(const f32x4*)(bg + u.e * D + col + 4), uA = *(const f32x4*)(bu + u.e * D + col), uB = *(const f32x4*)(bu + u.e * D + col + 4);
        const float g0[8] = {gA[0], gA[1], gA[2], gA[3], gB[0], gB[1], gB[2], gB[3]}, u0[8] = {uA[0], uA[1], uA[2], uA[3], uB[0], uB[1], uB[2], uB[3]};
#pragma unroll
        for (int ai = 0; ai < 2; ++ai)
#pragma unroll
            for (int m = 0; m < 4; ++m) { const size_t row = (size_t)(u.pm * 256 + 128 * ai + 64 * wr + 16 * m + fr);
                float h[8];
#pragma unroll
                for (int j = 0; j < 8; ++j) { float gv = acc[ai][0][m][j >> 2][j & 3] + g0[j], uv = acc[ai][1][m][j >> 2][j & 3] + u0[j];
                    gv = fminf(gv, 7.0f); uv = fminf(fmaxf(uv, -7.0f), 7.0f); h[j] = gv * sigmoidf_(1.702f * gv) * (uv + 1.0f); }
                u32x4 w; w.x = cvt_pk_bf16(h[0], h[1]); w.y = cvt_pk_bf16(h[2], h[3]); w.z = cvt_pk_bf16(h[4], h[5]); w.w = cvt_pk_bf16(h[6], h[7]);
                *(u32x4*)(hb + row * D + col) = w;
                asm volatile("" ::: "memory"); }
    }
};
struct EpiPlain {
    bf16_t* yb;
    __device__ __forceinline__ void operator()(const Acc& acc, const Unit& u, int wr, int wc, int fr, int fq) const {
#pragma unroll
        for (int ai = 0; ai < 2; ++ai)
#pragma unroll
            for (int m = 0; m < 4; ++m) { const size_t row = (size_t)(u.pm * 256 + 128 * ai + 64 * wr + 16 * m + fr);
#pragma unroll
                for (int bj = 0; bj < 2; ++bj) { const f32x4 v0 = acc[ai][bj][m][0], v1 = acc[ai][bj][m][1];
                    u32x4 w; w.x = cvt_pk_bf16(v0[0], v0[1]); w.y = cvt_pk_bf16(v0[2], v0[3]); w.z = cvt_pk_bf16(v1[0], v1[1]); w.w = cvt_pk_bf16(v1[2], v1[3]);
                    *(u32x4*)(yb + row * D + u.pn * 256 + 128 * bj + 32 * wc + 8 * fq) = w; } }
    }
};

__device__ __forceinline__ void xpose_item(const float* W, int K, int N, bf16_t* WT, int mode, LAS float* scr, int item, int lane) {
    const int nblk = N / 32, kb = item / nblk, nb = item % nblk, k0 = 64 * kb, n0 = 32 * nb;
    const int row0 = mode < 0 ? n0 : ((n0 >> 7) * 256 + mode * 128 + (n0 & 127));
#pragma unroll 8
    for (int i = 0; i < 32; ++i) { const int kk = 2 * i + (lane >> 5); scr[kk * 33 + (lane & 31)] = W[(size_t)(k0 + kk) * N + n0 + (lane & 31)]; }
    asm volatile("s_waitcnt lgkmcnt(0)" ::: "memory");
    const int c = lane & 7;
#pragma unroll
    for (int j = 0; j < 4; ++j) { const int n = (lane >> 3) + 8 * j; const LAS float* s = scr + (8 * c) * 33 + n;
        u32x4 o; o.x = cvt_pk_bf16(s[0 * 33], s[1 * 33]); o.y = cvt_pk_bf16(s[2 * 33], s[3 * 33]); o.z = cvt_pk_bf16(s[4 * 33], s[5 * 33]); o.w = cvt_pk_bf16(s[6 * 33], s[7 * 33]);
        *(u32x4*)(WT + (size_t)(row0 + n) * K + k0 + 8 * c) = o; }
    asm volatile("s_waitcnt lgkmcnt(0)" ::: "memory");
}
__device__ __forceinline__ void xpose_class(const float* src, int nmat, int K, int N, bf16_t* dst, size_t dstride, int mode, LAS float* scr, int gw, int NGW, int lane) {
    const int ipm = (K / 64) * (N / 32);
    for (int it = gw; it < nmat * ipm; it += NGW) { const int mat = it / ipm, r = it - mat * ipm;
        xpose_item(src + (size_t)mat * K * N, K, N, dst + (size_t)mat * dstride, mode, scr, r, lane); }
}

__device__ __forceinline__ int opaque_i(int v) { asm volatile("" : "+s"(v)); return v; }
__device__ __forceinline__ int opaque_v(int v) { asm volatile("" : "+v"(v)); return v; }
template <class P> __device__ __forceinline__ P* opaque_p(P* p) { asm volatile("" : "+s"(p)); return p; }
struct Ctx {
    unsigned char* ws; LAS unsigned char* lds;
    int tid, lane, wave, G, vcu, bx;
};
struct Args { const float* in[25]; float* out; unsigned char* ws; int ph_lo, ph_hi; };

__device__ __forceinline__ void ph_prologue(const Ctx& c, const Args& A) {
    LAS float* scr = (LAS float*)(c.lds + c.wave * 16384);
    const int gw = c.vcu * 8 + c.wave, NGW = c.G * 8;
    unsigned char* ws = c.ws;
    xpose_class(A.in[2], 2, D, 3 * D, (bf16_t*)(ws + WS_WQKV), (size_t)3 * D * D, -1, scr, gw, NGW, c.lane);
    xpose_class(A.in[3], 2, D, D, (bf16_t*)(ws + WS_WO), (size_t)D * D, -1, scr, gw, NGW, c.lane);
    xpose_class(A.in[4], 2, D, 2 * D, (bf16_t*)(ws + WS_WIN), (size_t)2 * D * D, -1, scr, gw, NGW, c.lane);
    xpose_class(A.in[7], 8, 256, 256, (bf16_t*)(ws + WS_WG), (size_t)512 * 256, 0, scr, gw, NGW, c.lane);
    xpose_class(A.in[9], 8, 256, 256, (bf16_t*)(ws + WS_WG), (size_t)512 * 256, 1, scr, gw, NGW, c.lane);
    xpose_class(A.in[12], 2, D, D, (bf16_t*)(ws + WS_WOUT), (size_t)D * D, -1, scr, gw, NGW, c.lane);
    xpose_class(A.in[15], DEPTH * NE, D, D, (bf16_t*)(ws + WS_WGU), (size_t)2 * D * D, 0, scr, gw, NGW, c.lane);
    xpose_class(A.in[17], DEPTH * NE, D, D, (bf16_t*)(ws + WS_WGU), (size_t)2 * D * D, 1, scr, gw, NGW, c.lane);
    xpose_class(A.in[19], DEPTH * NE, D, D, (bf16_t*)(ws + WS_WD), (size_t)D * D, -1, scr, gw, NGW, c.lane);
    for (int m = gw; m < NTOK; m += NGW) { const f32x4* xr = (const f32x4*)(A.in[0] + (size_t)m * D) + c.lane; u32x2* o = (u32x2*)((bf16_t*)(ws + WS_XB) + (size_t)m * D) + c.lane;
#pragma unroll
        for (int j = 0; j < 4; ++j) { const f32x4 v = xr[64 * j]; u32x2 w; w.x = cvt_pk_bf16(v[0], v[1]); w.y = cvt_pk_bf16(v[2], v[3]); o[64 * j] = w; } }
    if (c.bx == 0) { float* bt = (float*)(ws + WS_BIAS);
        for (int i = c.tid; i < NH * BIAS_W; i += 512) { const int h = i / BIAS_W; int dist = i % BIAS_W - 64; if (dist < 0) dist = 0;
            int bucket;
            if (dist < 16) bucket = dist; else { const float n = (float)dist; int lg = 16 + (int)(logf(n / 16.0f) / 2.0794415416798357f * 16.0f); bucket = lg < 31 ? lg : 31; }
            bt[i] = A.in[1][bucket * NH + h] * LOG2E; }
        float* spt = (float*)(ws + WS_SPT);
        for (int i = c.tid; i < 2 * D; i += 512) { const float ap = -A.in[11][i]; spt[i] = -8.0f * (ap > 15.f ? ap : log1pf(expf(ap))); } }
}

__device__ __forceinline__ void ph_kmean(const Ctx& c) {
    const bf16_t* Kb = (const bf16_t*)(c.ws + WS_K); float* km = (float*)(c.ws + WS_KMEAN); LAS float* red = (LAS float*)c.lds;
    for (int u = c.vcu; u < NB * NH * NBLK; u += c.G) {
        const int bh = u / NBLK, j = u % NBLK; const bf16_t* Kp = Kb + ((size_t)bh * T + j * MBLK) * HD;
        const int c8 = c.tid & 15, rg = c.tid >> 4; float a[8] = {0, 0, 0, 0, 0, 0, 0, 0};
#pragma unroll
        for (int r = 0; r < 8; ++r) { const u32x4 w = *(const u32x4*)(Kp + (size_t)(rg * 8 + r) * HD + c8 * 8);
            a[0] += bf_lo(w.x); a[1] += bf_hi(w.x); a[2] += bf_lo(w.y); a[3] += bf_hi(w.y); a[4] += bf_lo(w.z); a[5] += bf_hi(w.z); a[6] += bf_lo(w.w); a[7] += bf_hi(w.w); }
#pragma unroll
        for (int i = 0; i < 8; ++i) red[rg * 128 + c8 * 8 + i] = a[i];
        __syncthreads();
        if (c.tid < 128) { float s = 0.f; for (int g = 0; g < 32; ++g) s += red[g * 128 + c.tid]; km[(size_t)u * HD + c.tid] = s * (1.0f / MBLK); }
        __syncthreads();
    }
}
__device__ __forceinline__ void ph_select(const Ctx& c) {
    const bf16_t* Qb = (const bf16_t*)(c.ws + WS_Q); const float* km = (const float*)(c.ws + WS_KMEAN); unsigned* sel = (unsigned*)(c.ws + WS_SEL); LAS float* kl = (LAS float*)c.lds;
    for (int u = c.vcu; u < NB * NH * (T / 512); u += c.G) {
        const int bh = u / (T / 512), ch = u % (T / 512);
        __syncthreads();
        for (int i = c.tid; i < NBLK * HD; i += 512) kl[i] = km[(size_t)bh * NBLK * HD + i];
        __syncthreads();
        const int t = ch * 512 + c.tid, qb = t >> 8;
        float q[HD];
        const u32x4* qp = (const u32x4*)(Qb + ((size_t)bh * T + t) * HD);
#pragma unroll
        for (int i = 0; i < 16; ++i) { const u32x4 w = qp[i]; q[8 * i] = bf_lo(w.x); q[8 * i + 1] = bf_hi(w.x); q[8 * i + 2] = bf_lo(w.y); q[8 * i + 3] = bf_hi(w.y); q[8 * i + 4] = bf_lo(w.z); q[8 * i + 5] = bf_hi(w.z); q[8 * i + 6] = bf_lo(w.w); q[8 * i + 7] = bf_hi(w.w); }
        float v0 = -__builtin_inff(), v1 = v0, v2 = v0; int i0 = -1, i1 = -1, i2 = -1;
        for (int j = 0; j < qb; ++j) {
            float s = 0.f; const LAS f32x4* kp = (const LAS f32x4*)(kl + j * HD);
#pragma unroll
            for (int i = 0; i < 32; ++i) { const f32x4 kv = kp[i]; s += q[4 * i] * kv[0] + q[4 * i + 1] * kv[1] + q[4 * i + 2] * kv[2] + q[4 * i + 3] * kv[3]; }
            if (s > v0) { v2 = v1; i2 = i1; v1 = v0; i1 = i0; v0 = s; i0 = j; }
            else if (s > v1) { v2 = v1; i2 = i1; v1 = s; i1 = j; }
            else if (s > v2) { v2 = s; i2 = j; }
        }
        unsigned m = 0; if (i0 >= 0) m |= 1u << i0; if (i1 >= 0) m |= 1u << i1; if (i2 >= 0) m |= 1u << i2;
        sel[(size_t)bh * T + t] = m;
    }
}

#if NAIVE_ATTN
__device__ __forceinline__ void ph_attn(const Ctx& c) {
    const bf16_t* Qb = (const bf16_t*)(c.ws + WS_Q); const bf16_t* Kb = (const bf16_t*)(c.ws + WS_K); const bf16_t* Vb = (const bf16_t*)(c.ws + WS_V);
    const unsigned* sel = (const unsigned*)(c.ws + WS_SEL); const float* bt = (const float*)(c.ws + WS_BIAS); bf16_t* O = (bf16_t*)(c.ws + WS_O);
    LAS float* ql = (LAS float*)(c.lds + c.wave * 1024); LAS float* pl = ql + 128;
    const int gw = c.vcu * 8 + c.wave, NGW = c.G * 8, lane = c.lane;
    for (int r = gw; r < NB * NH * T; r += NGW) {
        const int bh = r / T, t = r % T, qb = t >> 8, h = bh % NH, b = bh / NH;
        const unsigned w = *(const unsigned*)(Qb + ((size_t)bh * T + t) * HD + 2 * lane);
        ql[2 * lane] = bf_lo(w); ql[2 * lane + 1] = bf_hi(w);
        asm volatile("s_waitcnt lgkmcnt(0)" ::: "memory");
        const unsigned mask = sel[(size_t)bh * T + t] | (1u << qb);
        float mrun = -1e30f, lrun = 0.f, o0 = 0.f, o1 = 0.f;
        for (int jb = 0; jb <= qb; ++jb) {
            if (!((mask >> jb) & 1u)) continue;
            for (int kc = 0; kc < 4; ++kc) {
                const int key = jb * MBLK + kc * 64 + lane;
                const u32x4* kp = (const u32x4*)(Kb + ((size_t)bh * T + key) * HD);
                float s = 0.f;
#pragma unroll
                for (int i = 0; i < 16; ++i) { const u32x4 kw = kp[i]; const LAS float* qq = ql + 8 * i;
                    s += qq[0] * bf_lo(kw.x) + qq[1] * bf_hi(kw.x) + qq[2] * bf_lo(kw.y) + qq[3] * bf_hi(kw.y) + qq[4] * bf_lo(kw.z) + qq[5] * bf_hi(kw.z) + qq[6] * bf_lo(kw.w) + qq[7] * bf_hi(kw.w); }
                const int dist = t - key;
                if (dist < 0) s = -__builtin_inff(); else s += bt[h * BIAS_W + 64 + (dist > 600 ? 600 : dist)];
                const float cm = wave_max(s), mn = fmaxf(mrun, cm), al = exp2f(mrun - mn), p = exp2f(s - mn);
                lrun = lrun * al + wave_sum(p); o0 *= al; o1 *= al; mrun = mn;
                pl[lane] = p;
                asm volatile("s_waitcnt lgkmcnt(0)" ::: "memory");
                const bf16_t* vp = Vb + ((size_t)bh * T + jb * MBLK + kc * 64) * HD + 2 * lane;
                for (int kk = 0; kk < 64; ++kk) { const unsigned vw = *(const unsigned*)(vp + (size_t)kk * HD); const float pk = pl[kk]; o0 += pk * bf_lo(vw); o1 += pk * bf_hi(vw); }
                asm volatile("s_waitcnt lgkmcnt(0)" ::: "memory");
            }
        }
        const float inv = 1.0f / lrun;
        *(unsigned*)(O + ((size_t)(b * T + t)) * D + h * HD + 2 * lane) = cvt_pk_bf16(o0 * inv, o1 * inv);
    }
}
#endif


#if !NAIVE_ATTN
namespace att {
typedef short s16x4 __attribute__((ext_vector_type(4)));
typedef float f32x16 __attribute__((ext_vector_type(16)));
constexpr int SHM_K = 64 * 128 * 2, SHM_V = SHM_K;
constexpr int OFF_V = 0, OFF_K = 2 * SHM_V, OFF_WS = 2 * SHM_V + 2 * SHM_K, OFF_TB = OFF_WS + 8 * 256;
constexpr float THR_L2 = 11.5f;
#define KSWZ(row, colB) ((row) * 256 + ((colB) ^ (((row) & 7) << 4)))
__device__ __forceinline__ int v_st(int k, int c) { const int kk = (k & ~0xC) | ((k & 4) << 1) | ((k & 8) >> 1); return ((kk >> 3) * 4 + (c >> 5)) * 512 + ((kk & 7) * 32 + (c & 31)) * 2; }
__device__ __forceinline__ int v_rd_base(int lane) { return ((lane & 3) << 3) | (((lane >> 2) & 3) << 6) | (((lane >> 4) & 1) << 5) | (((lane >> 5) & 1) << 8); }
constexpr int v_rd_off(int d0, int ks, int half) { return d0 * 512 + ks * 4096 + half * 2048; }
__device__ __forceinline__ int crow(int r, int hi) { return (r & 3) + 8 * (r >> 2) + 4 * hi; }
template <int KB>
__device__ __forceinline__ void qkt(f32x16& p0, f32x16& p1, LAS const char* K_lds, int r32, int hi, const bf16x8* qr) {
#pragma unroll
    for (int r = 0; r < 16; ++r) { p0[r] = 0.f; p1[r] = 0.f; }
    LAS const char* kb[4];
#pragma unroll
    for (int dd = 0; dd < 4; ++dd) kb[dd] = K_lds + KB * SHM_K + KSWZ(r32, (dd * 16 + hi * 8) * 2);
#pragma unroll
    for (int d0 = 0; d0 < 8; ++d0) { LAS const char* a = kb[d0 & 3] + (d0 >> 2) * 128;
        const bf16x8 b0 = *(LAS const bf16x8*)a, b1 = *(LAS const bf16x8*)(a + 32 * 256);
        p0 = __builtin_amdgcn_mfma_f32_32x32x16_bf16(b0, qr[d0], p0, 0, 0, 0);
        p1 = __builtin_amdgcn_mfma_f32_32x32x16_bf16(b1, qr[d0], p1, 0, 0, 0); }
}
template <int VB>
__device__ __forceinline__ void pv_tile(f32x16* o, int vb0, bf16x8 pa0, bf16x8 pa1, bf16x8 pa2, bf16x8 pa3) {
#define TRRD(dst, off) asm volatile("ds_read_b64_tr_b16 %0, %1 offset:%2" : "=&v"(dst) : "v"(vb0), "i"(off) : "memory")
#define PV_D0(d0) do { s16x4 l0, l1, l2, l3, h0, h1, h2, h3; constexpr int b_ = VB * SHM_V + v_rd_off(d0, 0, 0); \
        TRRD(l0, b_); TRRD(h0, b_ + 2048); TRRD(l1, b_ + 4096); TRRD(h1, b_ + 6144); TRRD(l2, b_ + 8192); TRRD(h2, b_ + 10240); TRRD(l3, b_ + 12288); TRRD(h3, b_ + 14336); \
        asm volatile("s_waitcnt lgkmcnt(0)" ::: "memory"); __builtin_amdgcn_sched_barrier(0); \
        o[d0] = __builtin_amdgcn_mfma_f32_32x32x16_bf16(pa0, (bf16x8){l0[0], l0[1], l0[2], l0[3], h0[0], h0[1], h0[2], h0[3]}, o[d0], 0, 0, 0); \
        o[d0] = __builtin_amdgcn_mfma_f32_32x32x16_bf16(pa1, (bf16x8){l1[0], l1[1], l1[2], l1[3], h1[0], h1[1], h1[2], h1[3]}, o[d0], 0, 0, 0); \
        o[d0] = __builtin_amdgcn_mfma_f32_32x32x16_bf16(pa2, (bf16x8){l2[0], l2[1], l2[2], l2[3], h2[0], h2[1], h2[2], h2[3]}, o[d0], 0, 0, 0); \
        o[d0] = __builtin_amdgcn_mfma_f32_32x32x16_bf16(pa3, (bf16x8){l3[0], l3[1], l3[2], l3[3], h3[0], h3[1], h3[2], h3[3]}, o[d0], 0, 0, 0); } while (0)
    PV_D0(0); PV_D0(1); PV_D0(2); PV_D0(3);
#undef PV_D0
#undef TRRD
}
__device__ __forceinline__ void unit(LAS char* lds, const bf16_t* __restrict__ Qh, const bf16_t* __restrict__ Kh, const bf16_t* __restrict__ Vh, const unsigned* __restrict__ selh,
                                     const float* __restrict__ bth, bf16_t* Oq, int qb, int tid) {
    const int wid = __builtin_amdgcn_readfirstlane(tid >> 6), lane = tid & 63, r32 = lane & 31, hi = lane >> 5;
    LAS char* V_lds = lds + OFF_V; LAS char* K_lds = lds + OFF_K;
    LAS float* wsl = (LAS float*)(lds + OFF_WS) + wid * 64; LAS float* li_l = wsl; LAS float* al_l = wsl + 32;
    LAS float* tb = (LAS float*)(lds + OFF_TB);
    const int NT = 4 * (qb + 1);
    const int qlo = qb * 256 + wid * 32, qpos = qlo + r32;
    const int sr = tid >> 4, sc = (tid & 15) * 8, vst0 = v_st(sr, sc), vst1 = v_st(32 + sr, sc), kws = KSWZ(sr, sc * 2);
    const int vb0 = (int)(unsigned)(size_t)V_lds + v_rd_base(lane);
    for (int i = tid; i < BIAS_W; i += 512) tb[i] = bth[i];
    bf16x8 qr[8];
#pragma unroll
    for (int d0 = 0; d0 < 8; ++d0) qr[d0] = *(const bf16x8*)(Qh + (size_t)qpos * HD + d0 * 16 + hi * 8);
    const unsigned selm = selh[qpos];
    const float cfar = bth[BIAS_W - 1];
    bf16x8 st_v0, st_v1, st_k0, st_k1;
#define SLOAD(k0) do { st_v0 = *(const bf16x8*)(Vh + (size_t)((k0) + sr) * HD + sc); st_v1 = *(const bf16x8*)(Vh + (size_t)((k0) + 32 + sr) * HD + sc); \
                       st_k0 = *(const bf16x8*)(Kh + (size_t)((k0) + sr) * HD + sc); st_k1 = *(const bf16x8*)(Kh + (size_t)((k0) + 32 + sr) * HD + sc); } while (0)
#define SWRITE(bf) do { *(LAS bf16x8*)(V_lds + (bf) * SHM_V + vst0) = st_v0; *(LAS bf16x8*)(V_lds + (bf) * SHM_V + vst1) = st_v1; \
                        *(LAS bf16x8*)(K_lds + (bf) * SHM_K + kws) = st_k0; *(LAS bf16x8*)(K_lds + (bf) * SHM_K + kws + 32 * 256) = st_k1; } while (0)
    SLOAD(0); SWRITE(0);
    __syncthreads();
    float m_reg = -1e30f, l_reg = 0.f; f32x16 o[4];
#pragma unroll
    for (int d = 0; d < 4; ++d)
#pragma unroll
        for (int r = 0; r < 16; ++r) o[d][r] = 0.f;
    const float NEG = -__builtin_inff();
#define TILE(t, BUF) do { \
        const int kbase = (t) * 64, jb = (t) >> 2; \
        if ((t) + 1 < NT) SLOAD(kbase + 64); \
        const bool own = (jb == qb); \
        if (!own || kbase <= qlo + 31) { \
            f32x16 p0, p1; \
            qkt<BUF>(p0, p1, K_lds, r32, hi, qr); \
            float addc; \
            if (jb + 1 >= qb) { \
                int bi = qpos - kbase + 1; bi = bi < 0 ? 0 : bi; \
                LAS const float* tp = tb + bi - 4 * hi; \
                _Pragma("unroll") for (int r = 0; r < 16; ++r) { const int c0 = (r & 3) + 8 * (r >> 2); p0[r] += tp[63 - c0]; p1[r] += tp[31 - c0]; } \
                if (own) { addc = 0.f; \
                    if (kbase + 63 > qlo) { const int dq = qpos - kbase - 4 * hi; \
                        _Pragma("unroll") for (int r = 0; r < 16; ++r) { const int c0 = (r & 3) + 8 * (r >> 2); if (dq - c0 < 0) p0[r] = NEG; if (dq - c0 - 32 < 0) p1[r] = NEG; } } } \
                else addc = ((selm >> jb) & 1u) ? 0.f : NEG; \
            } else addc = ((selm >> jb) & 1u) ? cfar : NEG; \
            float pmax = p0[0]; \
            _Pragma("unroll") for (int r = 1; r < 16; ++r) pmax = fmaxf(pmax, p0[r]); \
            _Pragma("unroll") for (int r = 0; r < 16; ++r) pmax = fmaxf(pmax, p1[r]); \
            { auto rr = __builtin_amdgcn_permlane32_swap(__float_as_uint(pmax), __float_as_uint(pmax), false, false); pmax = fmaxf(__uint_as_float(rr[0]), __uint_as_float(rr[1])); } \
            pmax += addc; \
            float mn, alpha; \
            if (__all(pmax - m_reg <= THR_L2)) { mn = m_reg; alpha = 1.f; } \
            else { mn = fmaxf(m_reg, pmax); alpha = __builtin_amdgcn_exp2f(m_reg - mn); m_reg = mn; } \
            const float offc = addc - mn; \
            _Pragma("unroll") for (int r = 0; r < 16; ++r) { p0[r] = __builtin_amdgcn_exp2f(p0[r] + offc); p1[r] = __builtin_amdgcn_exp2f(p1[r] + offc); } \
            float ps = 0.f; \
            _Pragma("unroll") for (int r = 0; r < 16; ++r) ps += p0[r]; \
            _Pragma("unroll") for (int r = 0; r < 16; ++r) ps += p1[r]; \
            { auto rr = __builtin_amdgcn_permlane32_swap(__float_as_uint(ps), __float_as_uint(ps), false, false); ps = __uint_as_float(rr[0]) + __uint_as_float(rr[1]); } \
            l_reg = l_reg * alpha + ps; \
            bf16x8 pa0, pa1, pa2, pa3; \
            PK4(p0, 0, pa0); PK4(p0, 8, pa1); PK4(p1, 0, pa2); PK4(p1, 8, pa3); \
            if (__any(alpha < 1.f)) { if (hi == 0) al_l[r32] = alpha; asm volatile("s_waitcnt lgkmcnt(0)" ::: "memory"); \
                _Pragma("unroll") for (int d_ = 0; d_ < 4; ++d_) _Pragma("unroll") for (int r = 0; r < 16; ++r) o[d_][r] *= al_l[crow(r, hi)]; } \
            pv_tile<BUF>(o, vb0, pa0, pa1, pa2, pa3); \
        } \
        if ((t) + 1 < NT) { asm volatile("s_waitcnt vmcnt(0)" ::: "memory"); SWRITE((BUF) ^ 1); } \
        __syncthreads(); } while (0)
#define PK4(P, B_, OUT) do { const unsigned a0 = cvt_pk_bf16(P[B_ + 0], P[B_ + 1]), a1 = cvt_pk_bf16(P[B_ + 2], P[B_ + 3]), b0 = cvt_pk_bf16(P[B_ + 4], P[B_ + 5]), b1 = cvt_pk_bf16(P[B_ + 6], P[B_ + 7]); \
        auto r0 = __builtin_amdgcn_permlane32_swap(a0, b0, false, false); auto r1 = __builtin_amdgcn_permlane32_swap(a1, b1, false, false); \
        u32x4 w_ = {r0[0], r1[0], r0[1], r1[1]}; OUT = *reinterpret_cast<bf16x8*>(&w_); } while (0)
    for (int t = 0; t < NT; t += 2) { TILE(t, 0); TILE(t + 1, 1); }
#undef TILE
#undef PK4
#undef SLOAD
#undef SWRITE
    if (hi == 0) li_l[r32] = l_reg;
    asm volatile("s_waitcnt lgkmcnt(0)" ::: "memory");
    bf16_t* Ow = Oq + (size_t)(wid * 32) * D;
#pragma unroll
    for (int r = 0; r < 16; ++r) { const int orow = crow(r, hi); const float rl = __builtin_amdgcn_rcpf(li_l[orow]);
#pragma unroll
        for (int d0 = 0; d0 < 4; ++d0) { const float v = o[d0][r] * rl; const float vn = __shfl_xor(v, 1);
            if ((r32 & 1) == 0) *(unsigned*)(Ow + (size_t)orow * D + d0 * 32 + r32) = cvt_pk_bf16(v, vn); } }
    __syncthreads();
}
#undef KSWZ
}
__device__ __forceinline__ void ph_attn(const Ctx& c) {
    const bf16_t* Qb = (const bf16_t*)(c.ws + WS_Q); const bf16_t* Kb = (const bf16_t*)(c.ws + WS_K); const bf16_t* Vb = (const bf16_t*)(c.ws + WS_V);
    const unsigned* sel = (const unsigned*)(c.ws + WS_SEL); const float* bt = (const float*)(c.ws + WS_BIAS); bf16_t* O = (bf16_t*)(c.ws + WS_O);
    for (int u = c.vcu; u < NB * NH * (NBLK / 2); u += c.G) {
        const int bh = u / (NBLK / 2), pi = u % (NBLK / 2), b = bh / NH, h = bh % NH;
#pragma unroll 1
        for (int pass = 0; pass < 2; ++pass) { const int qb = pass == 0 ? NBLK - 1 - pi : pi;
            att::unit((LAS char*)c.lds, Qb + (size_t)bh * T * HD, Kb + (size_t)bh * T * HD, Vb + (size_t)bh * T * HD, sel + (size_t)bh * T, bt + h * BIAS_W,
                      O + ((size_t)(b * T + qb * 256)) * D + h * HD, qb, c.tid); }
    }
}
#endif

__device__ __forceinline__ void ph_conv(const Ctx& c, const float* cw, const float* cb) {
    const bf16_t* R = (const bf16_t*)(c.ws + WS_R); bf16_t* RC = (bf16_t*)(c.ws + WS_RC);
    for (int i = c.vcu * 512 + c.tid; i < NTOK * (D / 8); i += c.G * 512) {
        const int n = i >> 7, c8 = (i & 127) * 8, t = n & (T - 1);
        float a[8];
#pragma unroll
        for (int j = 0; j < 8; ++j) a[j] = cb[c8 + j];
#pragma unroll
        for (int k = 0; k < 4; ++k) { const int tt = t - 3 + k; if (tt < 0) continue;
            const u32x4 w = *(const u32x4*)(R + (size_t)(n - 3 + k) * D + c8); const f32x4 w0 = *(const f32x4*)(cw + k * D + c8), w1 = *(const f32x4*)(cw + k * D + c8 + 4);
            a[0] += w0[0] * bf_lo(w.x); a[1] += w0[1] * bf_hi(w.x); a[2] += w0[2] * bf_lo(w.y); a[3] += w0[3] * bf_hi(w.y);
            a[4] += w1[0] * bf_lo(w.z); a[5] += w1[1] * bf_hi(w.z); a[6] += w1[2] * bf_lo(w.w); a[7] += w1[3] * bf_hi(w.w); }
        u32x4 o; o.x = cvt_pk_bf16(a[0], a[1]); o.y = cvt_pk_bf16(a[2], a[3]); o.z = cvt_pk_bf16(a[4], a[5]); o.w = cvt_pk_bf16(a[6], a[7]);
        *(u32x4*)(RC + (size_t)n * D + c8) = o;
    }
}
__device__ __forceinline__ void ph_scan(const Ctx& c) {
    const float* Aa = (const float*)(c.ws + WS_AA); const float* Uu = (const float*)(c.ws + WS_UU); const bf16_t* Y = (const bf16_t*)(c.ws + WS_YBR); bf16_t* Gq = (bf16_t*)(c.ws + WS_G);
    LAS float* cA = (LAS float*)c.lds; LAS float* cH = cA + 512;
    for (int u = c.vcu; u < NB * (D / 16); u += c.G) {
        const int b = u / (D / 16), cg = u % (D / 16), ch = c.wave * 4 + (c.lane >> 4), col = cg * 16 + (c.lane & 15);
        const size_t base = ((size_t)b * T + ch * 128) * D + col;
        float A = 1.f, H = 0.f;
#pragma unroll 8
        for (int s = 0; s < 128; ++s) { const float a = Aa[base + (size_t)s * D], x = Uu[base + (size_t)s * D]; A *= a; H = a * H + x; }
        __syncthreads();
        cA[ch * 16 + (c.lane & 15)] = A; cH[ch * 16 + (c.lane & 15)] = H;
        __syncthreads();
        float h = 0.f;
        for (int p = 0; p < ch; ++p) h = cA[p * 16 + (c.lane & 15)] * h + cH[p * 16 + (c.lane & 15)];
#pragma unroll 8
        for (int s = 0; s < 128; ++s) { const float a = Aa[base + (size_t)s * D], x = Uu[base + (size_t)s * D]; h = a * h + x;
            const float y = __uint_as_float(((unsigned)Y[base + (size_t)s * D]) << 16); const float gv = h * y;
            unsigned r = __float_as_uint(gv); r += 0x7fffu + ((r >> 16) & 1u); Gq[base + (size_t)s * D] = (bf16_t)(r >> 16); }
    }
}

__device__ __forceinline__ void ln_affine(f32x4 (&v)[4], const float* g, const float* bta, int lane) {
    float s = 0.f;
#pragma unroll
    for (int j = 0; j < 4; ++j) s += (v[j][0] + v[j][1]) + (v[j][2] + v[j][3]);
    const float mean = wave_sum(s) * (1.0f / D); float s2 = 0.f;
#pragma unroll
    for (int j = 0; j < 4; ++j) { v[j] = v[j] - mean; s2 += (v[j][0] * v[j][0] + v[j][1] * v[j][1]) + (v[j][2] * v[j][2] + v[j][3] * v[j][3]); }
    const float rstd = 1.0f / sqrtf(wave_sum(s2) * (1.0f / D) + LN_EPS);
#pragma unroll
    for (int j = 0; j < 4; ++j) { const f32x4 gg = *(const f32x4*)(g + 4 * lane + 256 * j), bb = *(const f32x4*)(bta + 4 * lane + 256 * j); v[j] = v[j] * rstd * gg + bb; }
}
__device__ __forceinline__ void store_row(const f32x4 (&v)[4], float* xf, bf16_t* xb, int lane) {
#pragma unroll
    for (int j = 0; j < 4; ++j) { *(f32x4*)(xf + 4 * lane + 256 * j) = v[j]; u32x2 w; w.x = cvt_pk_bf16(v[j][0], v[j][1]); w.y = cvt_pk_bf16(v[j][2], v[j][3]); *(u32x2*)(xb + 4 * lane + 256 * j) = w; }
}

__device__ __forceinline__ void ph_lnr(const Ctx& c, int layer, const float* g, const float* bta, const float* wr, const float* br) {
    const float* Z = (const float*)(c.ws + WS_Z); float* XF = (float*)(c.ws + WS_XF); bf16_t* XB = (bf16_t*)(c.ws + WS_XB);
    int* tope = (int*)(c.ws + WS_TOPE); int* tops = (int*)(c.ws + WS_TOPS); float* topg = (float*)(c.ws + WS_TOPG);
    int* list = (int*)(c.ws + WS_LIST) + (size_t)layer * NE * NTOK; unsigned* cntw = (unsigned*)(c.ws + WS_CTL) + CW_CNT + layer * 64;
    LAS float* wl = (LAS float*)c.lds;
    LAS int* be = (LAS int*)(c.lds + LNR_OFF); LAS int* brk = be + 256; LAS int* bbase = brk + 256; LAS int* bcnt = bbase + 32;
    const int lane = c.lane;
    __syncthreads();
    for (int idx = c.tid; idx < D * 8; idx += 512) { const int d = idx >> 3, e4 = idx & 7; const int slot = ((d & 255) >> 2) + 64 * ((d >> 8) * 4 + (d & 3));
        *(LAS f32x4*)(wl + slot * 36 + e4 * 4) = *(const f32x4*)(wr + d * NE + e4 * 4); }
    __syncthreads();
    for (int tile = c.vcu; tile < NTOK / 64; tile += c.G) {
        for (int i = 0; i < 8; ++i) {
            const int rit = c.wave * 8 + i, n = tile * 64 + rit;
            f32x4 v[4];
#pragma unroll
            for (int j = 0; j < 4; ++j) v[j] = *(const f32x4*)(Z + (size_t)n * D + 4 * lane + 256 * j);
            ln_affine(v, g, bta, lane);
            store_row(v, XF + (size_t)n * D, XB + (size_t)n * D, lane);
            float acc[32];
#pragma unroll
            for (int e = 0; e < 32; ++e) acc[e] = 0.f;
#pragma unroll
            for (int j = 0; j < 4; ++j)
#pragma unroll
                for (int q = 0; q < 4; ++q) { const float xv = v[j][q]; const LAS f32x4* wp = (const LAS f32x4*)(wl + (lane + 64 * (4 * j + q)) * 36);
#pragma unroll
                    for (int e4 = 0; e4 < 8; ++e4) { const f32x4 w = wp[e4]; acc[4 * e4] += xv * w[0]; acc[4 * e4 + 1] += xv * w[1]; acc[4 * e4 + 2] += xv * w[2]; acc[4 * e4 + 3] += xv * w[3]; } }
            float a1[16], a2[8], a3[4], a4[2], a5;
#pragma unroll
            for (int k = 0; k < 16; ++k) { const bool hi = lane & 1; const float keep = hi ? acc[2 * k + 1] : acc[2 * k], send = hi ? acc[2 * k] : acc[2 * k + 1]; a1[k] = keep + __shfl_xor(send, 1); }
#pragma unroll
            for (int k = 0; k < 8; ++k) { const bool hi = lane & 2; const float keep = hi ? a1[2 * k + 1] : a1[2 * k], send = hi ? a1[2 * k] : a1[2 * k + 1]; a2[k] = keep + __shfl_xor(send, 2); }
#pragma unroll
            for (int k = 0; k < 4; ++k) { const bool hi = lane & 4; const float keep = hi ? a2[2 * k + 1] : a2[2 * k], send = hi ? a2[2 * k] : a2[2 * k + 1]; a3[k] = keep + __shfl_xor(send, 4); }
#pragma unroll
            for (int k = 0; k < 2; ++k) { const bool hi = lane & 8; const float keep = hi ? a3[2 * k + 1] : a3[2 * k], send = hi ? a3[2 * k] : a3[2 * k + 1]; a4[k] = keep + __shfl_xor(send, 8); }
            { const bool hi = lane & 16; const float keep = hi ? a4[1] : a4[0], send = hi ? a4[0] : a4[1]; a5 = keep + __shfl_xor(send, 16); }
            float val = a5 + __shfl_xor(a5, 32) + br[lane & 31];
            float tv[4]; int te[4];
#pragma unroll
            for (int k = 0; k < 4; ++k) { const float m = wave_max(val); const unsigned long long bal = __ballot(val == m); const int idx = __ffsll((long long)bal) - 1; tv[k] = m; te[k] = idx & 31; if ((lane & 31) == (idx & 31)) val = -__builtin_inff(); }
            const float e1 = __expf(tv[1] - tv[0]), e2 = __expf(tv[2] - tv[0]), e3 = __expf(tv[3] - tv[0]), inv = 1.0f / (1.0f + e1 + e2 + e3);
            if (lane == 0) { be[rit * 4 + 0] = te[0]; be[rit * 4 + 1] = te[1]; be[rit * 4 + 2] = te[2]; be[rit * 4 + 3] = te[3];
                *(f32x4*)(topg + (size_t)n * 4) = (f32x4){inv, e1 * inv, e2 * inv, e3 * inv}; }
        }
        __syncthreads();
        if (c.tid < NE) { int cnt = 0; for (int i = 0; i < 256; ++i) { if (be[i] == c.tid) { brk[i] = cnt; ++cnt; } }
            bcnt[c.tid] = cnt; bbase[c.tid] = cnt ? (int)__hip_atomic_fetch_add(cntw + c.tid, (unsigned)cnt, RLX_AGENT) : 0; }
        __syncthreads();
        if (c.tid < 256) { const int e = be[c.tid], slot = bbase[e] + brk[c.tid], n = tile * 64 + (c.tid >> 2);
            list[(size_t)e * NTOK + slot] = n; tope[(size_t)n * 4 + (c.tid & 3)] = e; tops[(size_t)n * 4 + (c.tid & 3)] = slot; }
        __syncthreads();
    }
}

__device__ __forceinline__ void ph_comb(const Ctx& c, int layer, float* xout, const float* g, const float* bta, const float* bd) {
    const float* XF = (const float*)(c.ws + WS_XF); bf16_t* XB = (bf16_t*)(c.ws + WS_XB); const bf16_t* YB = (const bf16_t*)(c.ws + WS_YB);
    const int* tope = (const int*)(c.ws + WS_TOPE); const int* tops = (const int*)(c.ws + WS_TOPS); const float* topg = (const float*)(c.ws + WS_TOPG);
    (void)moe_tables(c.lds, (const unsigned*)(c.ws + WS_CTL) + CW_CNT + layer * 64, c.tid);
    const int gw = c.vcu * 8 + c.wave, NGW = c.G * 8, lane = c.lane;
    for (int n = gw; n < NTOK; n += NGW) {
        f32x4 v[4];
#pragma unroll
        for (int j = 0; j < 4; ++j) v[j] = *(const f32x4*)(XF + (size_t)n * D + 4 * lane + 256 * j) * ALPHA;
#pragma unroll
        for (int k = 0; k < 4; ++k) { const int e = tope[(size_t)n * 4 + k], slot = tops[(size_t)n * 4 + k]; const float gt = topg[(size_t)n * 4 + k];
            const size_t row = ((size_t)MOE_MTBASE(c.lds)[e] << 8) + slot;
#pragma unroll
            for (int j = 0; j < 4; ++j) { const u32x2 w = *(const u32x2*)(YB + row * D + 4 * lane + 256 * j); const f32x4 bb = *(const f32x4*)(bd + (size_t)e * D + 4 * lane + 256 * j);
                v[j][0] += gt * (bf_lo(w.x) + bb[0]); v[j][1] += gt * (bf_hi(w.x) + bb[1]); v[j][2] += gt * (bf_lo(w.y) + bb[2]); v[j][3] += gt * (bf_hi(w.y) + bb[3]); } }
        ln_affine(v, g, bta, lane);
        store_row(v, xout + (size_t)n * D, XB + (size_t)n * D, lane);
    }
}

constexpr int PH_PER_LAYER = 9, N_PHASES = 1 + DEPTH * PH_PER_LAYER;

__global__ void __launch_bounds__(512, 2) mk_fwd(Args args) {
    extern __shared__ __attribute__((aligned(16))) unsigned char lds_raw[];
    Ctx c0;
    c0.ws = args.ws; c0.lds = (LAS unsigned char*)lds_raw;
    c0.tid = threadIdx.x; c0.lane = c0.tid & 63; c0.wave = __builtin_amdgcn_readfirstlane(c0.tid >> 6);
    c0.G = gridDim.x; c0.bx = blockIdx.x; { const int bx = blockIdx.x; c0.vcu = (c0.G % 8 == 0) ? (bx % 8) * (c0.G / 8) + bx / 8 : bx; }
    volatile LAS unsigned* MISC = (volatile LAS unsigned*)(c0.lds + MISC_OFF);
    if (c0.tid < 64) MISC[c0.tid] = 0u;
    __syncthreads();
    unsigned* ctl = (unsigned*)(c0.ws + WS_CTL);
#if MK_PER_PHASE
#define GRID_BAR() do { } while (0)
#else
    XcdBarrier bar = xcd_barrier_post(ctl + CW_BAR, MISC + 8);
#define GRID_BAR() xcd_barrier(bar)
#endif
    const int lo = args.ph_lo, hi = args.ph_hi;
#ifndef PMASK
#define PMASK 0xFFFF
#endif
#define EN(b) ((PMASK >> (b)) & 1)
#define IN(k) (lo <= (k) && (k) < hi)
#define SEAM(k) do { if (IN(k) && IN((k) + 1)) GRID_BAR(); } while (0)
#define INP(i) (args.in[opaque_i(i)] + (size_t)(unsigned)opaque_i(0))
#define WSP() Ctx c = c0; c.ws = c0.ws + (size_t)(unsigned)opaque_i(0); c.tid = opaque_v(c0.tid); c.lane = c.tid & 63; c.wave = __builtin_amdgcn_readfirstlane(c.tid >> 6); c.G = opaque_i(c0.G); c.vcu = opaque_i(c0.vcu); c.bx = opaque_i(c0.bx); unsigned char* ws = c.ws

    if (EN(15) && IN(0)) { WSP(); (void)ws; ph_prologue(c, args); } SEAM(0);

#define LAYER(L_) do { \
        constexpr int L = L_; constexpr int p0 = 1 + L * PH_PER_LAYER, jm = L >> 1; \
        if constexpr ((L & 1) == 0) { \
            if (EN(0) && IN(p0 + 0)) { WSP(); SchedDense S; S.o.init(NTOK, 3 * D, c.G, c.bx); S.lda = D * 2; S.K = D; \
                const pg8::Gemm g{(const char*)(ws + WS_XB), (const char*)(ws + WS_WQKV) + (size_t)jm * 3 * D * D * 2, nullptr, D * 2, D}; \
                EpiQKV E{(bf16_t*)(ws + WS_Q)}; \
                pg8::gemm_phase<EpiQKV, SchedDense, false>(c.lds, g, S, E, c.tid); } SEAM(p0 + 0); \
            if (EN(1) && IN(p0 + 1)) { WSP(); (void)ws; ph_kmean(c); } SEAM(p0 + 1); \
            if (EN(2) && IN(p0 + 2)) { WSP(); (void)ws; ph_select(c); } SEAM(p0 + 2); \
            if (EN(3) && IN(p0 + 3)) { WSP(); (void)ws; ph_attn(c); } SEAM(p0 + 3); \
            if (EN(4) && IN(p0 + 4)) { WSP(); SchedDense S; S.o.init(NTOK, D, c.G, c.bx); S.lda = D * 2; S.K = D; \
                const pg8::Gemm g{(const char*)(ws + WS_O), (const char*)(ws + WS_WO) + (size_t)jm * D * D * 2, nullptr, D * 2, D}; \
                EpiResid E{(L == 0) ? INP(0) : (const float*)(ws + WS_XF), (float*)(ws + WS_Z)}; \
                pg8::gemm_phase<EpiResid, SchedDense, false>(c.lds, g, S, E, c.tid); } SEAM(p0 + 4); \
        } else { \
            if (EN(5) && IN(p0 + 0)) { WSP(); SchedDense S; S.o.init(NTOK, 2 * D, c.G, c.bx); S.lda = D * 2; S.K = D; \
                const pg8::Gemm g{(const char*)(ws + WS_XB), (const char*)(ws + WS_WIN) + (size_t)jm * 2 * D * D * 2, nullptr, D * 2, D}; \
                EpiLin E{(bf16_t*)(ws + WS_YBR), (bf16_t*)(ws + WS_R)}; \
                pg8::gemm_phase<EpiLin, SchedDense, false>(c.lds, g, S, E, c.tid); } SEAM(p0 + 0); \
            if (EN(6) && IN(p0 + 1)) { WSP(); (void)ws; ph_conv(c, INP(5) + (size_t)jm * 4 * D, INP(6) + (size_t)jm * D); } SEAM(p0 + 1); \
            if (EN(7) && IN(p0 + 2)) { WSP(); SchedGates S; S.o.init(NTOK, 2 * D, c.G, c.bx); \
                const pg8::Gemm g{(const char*)(ws + WS_RC), (const char*)(ws + WS_WG) + (size_t)jm * 4 * 512 * 256 * 2, nullptr, D * 2, opaque_i(256)}; \
                EpiGates E{(const bf16_t*)(ws + WS_RC), INP(8) + (size_t)jm * D, INP(10) + (size_t)jm * D, (const float*)(ws + WS_SPT) + (size_t)jm * D, (float*)(ws + WS_AA), (float*)(ws + WS_UU)}; \
                pg8::gemm_phase<EpiGates, SchedGates, false>(c.lds, g, S, E, c.tid); } SEAM(p0 + 2); \
            if (EN(8) && IN(p0 + 3)) { WSP(); (void)ws; ph_scan(c); } SEAM(p0 + 3); \
            if (EN(9) && IN(p0 + 4)) { WSP(); SchedDense S; S.o.init(NTOK, D, c.G, c.bx); S.lda = D * 2; S.K = D; \
                const pg8::Gemm g{(const char*)(ws + WS_G), (const char*)(ws + WS_WOUT) + (size_t)jm * D * D * 2, nullptr, D * 2, D}; \
                EpiResid E{(L == 0) ? INP(0) : (const float*)(ws + WS_XF), (float*)(ws + WS_Z)}; \
                pg8::gemm_phase<EpiResid, SchedDense, false>(c.lds, g, S, E, c.tid); } SEAM(p0 + 4); \
        } \
        if (EN(10) && IN(p0 + 5)) { WSP(); (void)ws; ph_lnr(c, L, INP(21) + L * D, INP(22) + L * D, INP(13) + (size_t)L * D * NE, INP(14) + L * NE); } SEAM(p0 + 5); \
        if (EN(11) && IN(p0 + 6)) { WSP(); const int total = moe_tables(c.lds, (unsigned*)(ws + WS_CTL) + CW_CNT + L * 64, c.tid); \
            SchedMoe S{c.lds, total, 8, c.G, c.vcu, (unsigned)(2 * D * D * 2), true}; \
            const pg8::Gemm g{(const char*)(ws + WS_XB), (const char*)(ws + WS_WGU) + (size_t)L * NE * 2 * D * D * 2, (const int*)(ws + WS_LIST) + (size_t)L * NE * NTOK, D * 2, D}; \
            EpiSwiglu E{INP(16) + (size_t)L * NE * D, INP(18) + (size_t)L * NE * D, (bf16_t*)(ws + WS_HB)}; \
            pg8::gemm_phase<EpiSwiglu, SchedMoe, true>(c.lds, g, S, E, c.tid); } SEAM(p0 + 6); \
        if (EN(12) && IN(p0 + 7)) { WSP(); const int total = moe_tables(c.lds, (unsigned*)(ws + WS_CTL) + CW_CNT + L * 64, c.tid); \
            SchedMoe S{c.lds, total, 4, c.G, c.vcu, (unsigned)(D * D * 2), false}; \
            const pg8::Gemm g{(const char*)(ws + WS_HB), (const char*)(ws + WS_WD) + (size_t)L * NE * D * D * 2, nullptr, D * 2, D}; \
            EpiPlain E{(bf16_t*)(ws + WS_YB)}; \
            pg8::gemm_phase<EpiPlain, SchedMoe, false>(c.lds, g, S, E, c.tid); } SEAM(p0 + 7); \
        if (EN(13) && IN(p0 + 8)) { WSP(); ph_comb(c, L, (L == DEPTH - 1) ? args.out : (float*)(ws + WS_XF), INP(23) + L * D, INP(24) + L * D, INP(20) + (size_t)L * NE * D); } SEAM(p0 + 8); \
    } while (0)
    LAYER(0); LAYER(1); LAYER(2); LAYER(3);
#undef IN
#undef SEAM
}

extern "C" void kernel_launch(void* const* d_in, const int* in_sizes, int n_in, void* d_out, int out_size, void* d_ws, size_t ws_size, hipStream_t stream) {
    static int grid = 0;
    if (grid == 0) {
        if (n_in != 25 || out_size != NTOK * D || ws_size < WS_END) { fprintf(stderr, "kernel_launch: unexpected shapes (n_in %d out %d ws %zu)\n", n_in, out_size, ws_size); grid = -1; return; }
        int dev = 0, cus = 0;
        if (hipGetDevice(&dev) != hipSuccess || hipDeviceGetAttribute(&cus, hipDeviceAttributeMultiprocessorCount, dev) != hipSuccess) { grid = -1; return; }
        if (hipFuncSetAttribute((const void*)mk_fwd, hipFuncAttributeMaxDynamicSharedMemorySize, LDS_BYTES) != hipSuccess) { fprintf(stderr, "kernel_launch: hipFuncSetAttribute failed\n"); grid = -1; return; }
        int per_cu = 0;
        if (hipOccupancyMaxActiveBlocksPerMultiprocessor(&per_cu, (const void*)mk_fwd, 512, LDS_BYTES) != hipSuccess || per_cu < 1) fprintf(stderr, "kernel_launch: occupancy query says %d\n", per_cu);
        (void)hipGetLastError();
        grid = cus;
    }
    if (grid < 0) return;
    (void)hipMemsetAsync((char*)d_ws + WS_CTL, 0, CTL_BYTES, stream);
    Args a{};
    for (int i = 0; i < 25; ++i) a.in[i] = (const float*)d_in[i];
    a.out = (float*)d_out; a.ws = (unsigned char*)d_ws;
#if MK_PER_PHASE
    for (int p = 0; p < N_PHASES; ++p) {
        const int L = (p - 1) / PH_PER_LAYER, k = (p - 1) % PH_PER_LAYER; (void)L; (void)k;
        a.ph_lo = p; a.ph_hi = p + 1;
        hipLaunchKernelGGL(mk_fwd, dim3(grid), dim3(512), LDS_BYTES, stream, a);
    }
#else
    a.ph_lo = 0; a.ph_hi = N_PHASES;
    hipLaunchKernelGGL(mk_fwd, dim3(grid), dim3(512), LDS_BYTES, stream, a);
#endif
}
```

```cpp
#include <hip/hip_runtime.h>
#include <cstdio>
#include <cstdint>

#ifndef MK_PER_PHASE
#define MK_PER_PHASE 0
#endif
#ifndef NAIVE_GEMM
#define NAIVE_GEMM 0
#endif
#ifndef NAIVE_ATTN
#define NAIVE_ATTN 0
#endif

#define GAS __attribute__((address_space(1)))
#define LAS __attribute__((address_space(3)))
typedef unsigned short bf16_t;
typedef short bf16x8 __attribute__((ext_vector_type(8)));
typedef float f32x4 __attribute__((ext_vector_type(4)));
typedef float f32x2 __attribute__((ext_vector_type(2)));
typedef unsigned u32x4 __attribute__((ext_vector_type(4)));
typedef unsigned u32x2 __attribute__((ext_vector_type(2)));

constexpr int NB = 4, T = 4096, D = 1024, NTOK = NB * T, NH = 8, HD = 128, MBLK = 256, NBLK = T / MBLK, NE = 32, TOPK = 4, DEPTH = 4;
constexpr float ALPHA = 1.6817928305074290f;
constexpr float LOG2E = 1.4426950408889634f;
constexpr float QSCALE = 0.08838834764831845f * LOG2E;
constexpr float LN_EPS = 1e-5f;
constexpr int MAXMT = NTOK * TOPK / 256 + NE;
constexpr float XS8 = 8.0f, HS8 = 4.0f, WS8_GU = 32.0f, WS8_D = 64.0f;
constexpr int BIAS_W = 704;

constexpr size_t MiB = 1u << 20;
constexpr size_t WS_CTL = 0, CTL_BYTES = 1 * MiB;
constexpr size_t WS_BIAS = 1 * MiB;
constexpr size_t WS_SPT = 1 * MiB + 64 * 1024;
constexpr size_t WS_KMEAN = 1 * MiB + 256 * 1024;
constexpr size_t WS_SEL = 2 * MiB;
constexpr size_t WS_TOPE = 3 * MiB, WS_TOPS = 3 * MiB + 256 * 1024, WS_TOPG = 3 * MiB + 512 * 1024;
constexpr size_t WS_LIST = 4 * MiB;
constexpr size_t WS_WQKV = 16 * MiB, WS_WO = 28 * MiB, WS_WIN = 32 * MiB, WS_WG = 40 * MiB, WS_WOUT = 42 * MiB;
constexpr size_t WS_XB = 48 * MiB, WS_XF = 80 * MiB, WS_Z = 144 * MiB, WS_Q = 208 * MiB, WS_K = 240 * MiB, WS_V = 272 * MiB, WS_O = 304 * MiB;
constexpr size_t WS_YBR = 336 * MiB, WS_R = 368 * MiB, WS_RC = 400 * MiB, WS_AA = 432 * MiB, WS_UU = 496 * MiB, WS_G = 560 * MiB;
constexpr size_t WS_XB8 = 1648 * MiB;
constexpr size_t WS_HB = 592 * MiB, WS_YB = 736 * MiB, WS_WGU = 880 * MiB, WS_WD = 1392 * MiB, WS_END = 1664 * MiB;
constexpr int CW_TMO = 0, CW_BAR = 4096, CW_CNT = 8192;

constexpr int LDS_BYTES = 153600;
constexpr int RING_BYTES = 131072;
constexpr int MOE_OFF = RING_BYTES;
constexpr int LNR_OFF = 147456;
constexpr int MISC_OFF = LDS_BYTES - 256;

#define RLX_AGENT __ATOMIC_RELAXED, __HIP_MEMORY_SCOPE_AGENT
__device__ __forceinline__ unsigned cvt_pk_bf16(float lo, float hi) { unsigned r; asm volatile("v_cvt_pk_bf16_f32 %0, %1, %2" : "=v"(r) : "v"(lo), "v"(hi)); return r; }
__device__ __forceinline__ float bf_lo(unsigned w) { return __uint_as_float(w << 16); }
__device__ __forceinline__ float bf_hi(unsigned w) { return __uint_as_float(w & 0xffff0000u); }
__device__ __forceinline__ float wave_sum(float v) {
#pragma unroll
    for (int o = 1; o < 64; o <<= 1) v += __shfl_xor(v, o);
    return v;
}
__device__ __forceinline__ float wave_max(float v) {
#pragma unroll
    for (int o = 1; o < 64; o <<= 1) v = fmaxf(v, __shfl_xor(v, o));
    return v;
}
__device__ __forceinline__ int opaque_i(int v) { asm volatile("" : "+s"(v)); return v; }
__device__ __forceinline__ int opaque_v(int v) { asm volatile("" : "+v"(v)); return v; }
template <class P> __device__ __forceinline__ P* opaque_p(P* p) { asm volatile("" : "+s"(p)); return p; }
__device__ __forceinline__ float sigmoidf_(float x) { return __builtin_amdgcn_rcpf(1.0f + __builtin_amdgcn_exp2f(-1.4426950408889634f * x)); }

#define XB_TMO      128
#define XB_XCNT(j)  (256  + 64 * (j))
#define XB_XSUB(j)  (1280 + 64 * (j))
#define XB_XGEN(j)  (2304 + 64 * (j))
#define XB_TOP      3328
#define XB_TOPGEN   3392
#define XCD_BAR_WORDS 3456
#define XB_SPIN_CAP (1u << 22)
__device__ __forceinline__ unsigned xb_ld(unsigned* p)              { return __hip_atomic_load(p, __ATOMIC_RELAXED, __HIP_MEMORY_SCOPE_AGENT); }
__device__ __forceinline__ unsigned xb_add(unsigned* p, unsigned v) { return __hip_atomic_fetch_add(p, v, __ATOMIC_RELAXED, __HIP_MEMORY_SCOPE_AGENT); }
__device__ __forceinline__ unsigned xb_xcc_id() { return (unsigned)__builtin_amdgcn_s_getreg((3 << 11) | 20) & 0xFu; }
#define XB_SPIN(cond, bar) do { unsigned _sp = 0; while (cond) { __builtin_amdgcn_s_sleep(1); \
    if ((++_sp & 255u) == 0u) { if (xb_ld(&(bar)[XB_TMO])) break; if (_sp > XB_SPIN_CAP) { atomicAdd(&(bar)[XB_TMO], 1u); break; } } } } while (0)
struct XcdBarrier { unsigned* bar; unsigned x; volatile LAS unsigned* st; };
__device__ __forceinline__ XcdBarrier xcd_barrier_post(unsigned* bar, volatile LAS unsigned* st) {
    XcdBarrier b; b.bar = bar; b.x = xb_xcc_id(); b.st = st;
    if (threadIdx.x == 0) (void)xb_add(&bar[XB_XCNT(b.x)], 1u);
    return b;
}
__device__ __forceinline__ void xcd_barrier_complete(unsigned* bar, unsigned x, unsigned& nloc, unsigned& nx) {
    const unsigned G = gridDim.x * gridDim.y * gridDim.z;
    unsigned sum, cnt, mine, sp = 0u;
    for (;;) {
        sum = 0u; cnt = 0u; mine = 0u;
#pragma unroll
        for (unsigned j = 0; j < 16; ++j) { const unsigned c = xb_ld(&bar[XB_XCNT(j)]); sum += c; cnt += (c > 0u) ? 1u : 0u; mine = (j == x) ? c : mine; }
        if (sum == G) break;
        __builtin_amdgcn_s_sleep(1);
        if ((++sp & 255u) == 0u) { if (xb_ld(&bar[XB_TMO])) break; if (sp > XB_SPIN_CAP) { atomicAdd(&bar[XB_TMO], 1u); break; } }
    }
    nloc = mine > 0u ? mine : 1u; nx = cnt > 0u ? cnt : 1u;
}
__device__ __forceinline__ void xcd_barrier(const XcdBarrier& b) {
    asm volatile("s_waitcnt vmcnt(0)" ::: "memory");
    __syncthreads();
    if (threadIdx.x == 0) {
        unsigned* bar = b.bar;
        __builtin_amdgcn_s_waitcnt(0);
        unsigned nloc = b.st[0], nx = b.st[1];
        if (nloc == 0u) { xcd_barrier_complete(bar, b.x, nloc, nx); b.st[0] = nloc; b.st[1] = nx; }
        const unsigned old = xb_add(&bar[XB_XSUB(b.x)], 1u);
        const unsigned gen = old / nloc;
        if (old + 1u == (gen + 1u) * nloc) {
            __builtin_amdgcn_fence(__ATOMIC_RELEASE, "agent");
            asm volatile("s_waitcnt vmcnt(0)" ::: "memory");
            const unsigned og = xb_add(&bar[XB_TOP], 1u);
            const unsigned tg = og / nx;
            if (og + 1u == (tg + 1u) * nx) xb_add(&bar[XB_TOPGEN], 1u);
            else XB_SPIN(xb_ld(&bar[XB_TOPGEN]) == tg, bar);
            __builtin_amdgcn_fence(__ATOMIC_ACQUIRE, "agent");
            xb_add(&bar[XB_XGEN(b.x)], 1u);
            asm volatile("s_waitcnt vmcnt(0)" ::: "memory");
        } else {
            XB_SPIN(xb_ld(&bar[XB_XGEN(b.x)]) == gen, bar);
            __builtin_amdgcn_fence(__ATOMIC_ACQUIRE, "agent");
            asm volatile("s_waitcnt vmcnt(0)" ::: "memory");
        }
    }
    __syncthreads();
}

namespace pg8 {
constexpr int BM = 256, BK = 64, HALF = 128, HTB = HALF * BK * 2, STAGE_BYTES = 8 * HTB, NXCD = 8, WGM = 8;
__host__ __device__ __forceinline__ int lds_byte(int r, int c) { const int st = (r >> 4) * 2 + (c >> 5), rr = r & 15, cc = c & 31, ob = rr * 64 + cc * 2; return st * 1024 + (ob ^ (((ob >> 9) & 1) << 5)); }
__host__ __device__ __forceinline__ void stage_rc(int b, int& R, int& C) { const int st = b / 1024, sb = b % 1024, swz = sb ^ (((sb >> 9) & 1) << 5); R = (st >> 1) * 16 + swz / 64; C = (st & 1) * 32 + (swz % 64) / 2; }
__host__ __device__ __forceinline__ int perm32(int rho) { const int n = rho >> 4, i = rho & 15; return 8 * (i >> 2) + 4 * n + (i & 3); }

struct Unit { unsigned a, b; int rl; int pm, pn, e, valid; };
struct Gemm { const char* A; const char* B; const int* list; int lda; int kb; };
typedef int v8i32 __attribute__((ext_vector_type(8)));

struct DenseOrder {
    int nM, nN, nwg, G, c;
    __device__ void init(int M, int N, int G_, int c_) { nM = M / BM; nN = N / BM; nwg = nM * nN; G = G_; c = c_; }
    __device__ bool tile(int i, int& pm, int& pn) const {
        const long L = (long)i * G + c; if (L >= nwg) return false;
        int wgid = (int)L; { const int q = nwg / NXCD, r = nwg % NXCD, xcd = wgid % NXCD, off = wgid / NXCD; wgid = (xcd < r ? xcd * (q + 1) : r * (q + 1) + (xcd - r) * q) + off; }
        const int nig = WGM * nN, gid = wgid / nig, fm = gid * WGM, gsz = (nM - fm) < WGM ? (nM - fm) : WGM;
        pm = fm + ((wgid % nig) % gsz); pn = (wgid % nig) / gsz; return true;
    }
};

#if NAIVE_GEMM
template <class Epi, class Sched, bool GATHER, bool FP8 = false>
__device__ __forceinline__ void gemm_phase(LAS unsigned char* lds, const Gemm g, const Sched& S, const Epi& E, const int tid) {
    static_assert(!FP8, "reference K-loop is bf16 only");
    (void)lds;
    const int wid = __builtin_amdgcn_readfirstlane(tid >> 6), lane = tid & 63, wr = wid >> 2, wc = wid & 3, fr = lane & 15, fq = lane >> 4;
    Unit u;
    for (int i = 0; S.next(i, u); ++i) {
        f32x4 acc[2][2][4][2];
#pragma unroll
        for (int a = 0; a < 2; ++a)
#pragma unroll
            for (int b = 0; b < 2; ++b)
#pragma unroll
                for (int m = 0; m < 4; ++m)
#pragma unroll
                    for (int n = 0; n < 2; ++n) { f32x4 z_; asm volatile("v_mov_b32 %0, 0\n\tv_mov_b32 %1, 0\n\tv_mov_b32 %2, 0\n\tv_mov_b32 %3, 0" : "=v"(z_[0]), "=v"(z_[1]), "=v"(z_[2]), "=v"(z_[3])); acc[a][b][m][n] = z_; }
        unsigned ao[2][4], bo[2][2];
#pragma unroll
        for (int ai = 0; ai < 2; ++ai)
#pragma unroll
            for (int m = 0; m < 4; ++m) { const int r = 128 * ai + 64 * wr + 16 * m + fr;
                if (GATHER) { const int idx = g.list[u.rl + (r < u.valid ? r : 0)]; ao[ai][m] = (unsigned)idx * (unsigned)g.lda + fq * 16; }
                else ao[ai][m] = u.a + (unsigned)r * (unsigned)g.lda + fq * 16; }
#pragma unroll
        for (int bj = 0; bj < 2; ++bj)
#pragma unroll
            for (int n = 0; n < 2; ++n) { const int r = 128 * bj + 32 * wc + perm32(16 * n + fr); bo[bj][n] = u.b + (unsigned)r * (unsigned)g.kb + fq * 16; }
#pragma unroll 1
        for (int k0 = 0; k0 < g.kb / 2; k0 += 32) {
            bf16x8 B[2][2];
#pragma unroll
            for (int bj = 0; bj < 2; ++bj)
#pragma unroll
                for (int n = 0; n < 2; ++n) B[bj][n] = *(const bf16x8*)(g.B + bo[bj][n] + k0 * 2);
#pragma unroll
            for (int ai = 0; ai < 2; ++ai) {
                bf16x8 A[4];
#pragma unroll
                for (int m = 0; m < 4; ++m) A[m] = *(const bf16x8*)(g.A + ao[ai][m] + k0 * 2);
#pragma unroll
                for (int bj = 0; bj < 2; ++bj)
#pragma unroll
                    for (int m = 0; m < 4; ++m)
#pragma unroll
                        for (int n = 0; n < 2; ++n) acc[ai][bj][m][n] = __builtin_amdgcn_mfma_f32_16x16x32_bf16(B[bj][n], A[m], acc[ai][bj][m][n], 0, 0, 0);
            }
        }
        E(acc, u, wr, wc, fr, fq);
    }
}
#else
template <class Epi, class Sched, bool GATHER, bool FP8 = false>
__device__ __forceinline__ void gemm_phase(LAS unsigned char* lds, const Gemm g, const Sched& S, const Epi& E, const int tid) {
    const int wid = __builtin_amdgcn_readfirstlane(tid >> 6), lane = tid & 63, wr = wid >> 2, wc = wid & 3, fr = lane & 15, fq = lane >> 4;
    const int KB_ = g.kb, nt = KB_ / (BK * 2);
    unsigned voffB[2], vA0[2], vA1[2], vN0[2], vN1[2];
#pragma unroll
    for (int i = 0; i < 2; ++i) { int R, C; stage_rc(tid * 16 + i * 8192, R, C); const int Rb = (R & ~31) + perm32(R & 31);
        voffB[i] = (unsigned)(Rb * KB_ + C * 2); vA0[i] = (unsigned)(R * g.lda + C * 2); vA1[i] = vA0[i] + (unsigned)(HALF * g.lda); vN0[i] = vA0[i]; vN1[i] = vA1[i]; }
    const size_t kstep = (size_t)(BK * 2);
    const size_t hstepB = (size_t)HALF * KB_;
    const unsigned ldsw = (unsigned)wid * 1024u; const unsigned ldsbase_ = (unsigned)(size_t)lds + ldsw;
    const int aoff = lds_byte(wr * 64 + fr, fq * 8), boff = lds_byte(wc * 32 + fr, fq * 8);
#define PG8_SA(b, h) (((b) * 2 + (h)) * HTB)
#define PG8_SB(b, h) ((4 + (b) * 2 + (h)) * HTB)
#define PG8_STAGE(bufoff, gbase, voff) do { _Pragma("unroll") for (int _i = 0; _i < 2; ++_i) \
        asm volatile("s_mov_b32 m0, %2\n\ts_nop 0\n\tglobal_load_lds_dwordx4 %0, %1" :: "v"((voff)[_i]), "s"((const char*)(gbase)), "s"(ldsbase_ + (unsigned)((bufoff) + _i * 8192)) : "memory", "m0"); } while (0)
#define PG8_LD16A(off_) (*(const LAS i32x4_*)(size_t)(la_ + (unsigned)(off_)))
#define PG8_LD16B(off_) (*(const LAS i32x4_*)(size_t)(lb_ + (unsigned)(off_)))
#define PG8_LDA(dst, b, h) do { _Pragma("unroll") for (int m = 0; m < 4; ++m) dst[m] = __builtin_shufflevector(PG8_LD16A(PG8_SA(b, h) + m * 2048), PG8_LD16A(PG8_SA(b, h) + m * 2048 + 1024), 0, 1, 2, 3, 4, 5, 6, 7); } while (0)
#define PG8_LDB(dst, b, h) do { _Pragma("unroll") for (int n = 0; n < 2; ++n) dst[n] = __builtin_shufflevector(PG8_LD16B(PG8_SA(b, h) + n * 2048), PG8_LD16B(PG8_SA(b, h) + n * 2048 + 1024), 0, 1, 2, 3, 4, 5, 6, 7); } while (0)
#define PG8_MMA(ai, bj, At, Bt) do { __builtin_amdgcn_s_setprio(1); _Pragma("unroll") for (int m = 0; m < 4; ++m) _Pragma("unroll") for (int n = 0; n < 2; ++n) { \
        if constexpr (FP8) acc[ai][bj][m][n] = __builtin_amdgcn_mfma_scale_f32_16x16x128_f8f6f4(Bt[n], At[m], acc[ai][bj][m][n], 0, 0, 0, 0x7f7f7f7f, 0, 0x7f7f7f7f); \
        else { acc[ai][bj][m][n] = __builtin_amdgcn_mfma_f32_16x16x32_bf16(__builtin_bit_cast(bf16x8, __builtin_shufflevector(Bt[n], Bt[n], 0, 1, 2, 3)), __builtin_bit_cast(bf16x8, __builtin_shufflevector(At[m], At[m], 0, 1, 2, 3)), acc[ai][bj][m][n], 0, 0, 0); \
               acc[ai][bj][m][n] = __builtin_amdgcn_mfma_f32_16x16x32_bf16(__builtin_bit_cast(bf16x8, __builtin_shufflevector(Bt[n], Bt[n], 4, 5, 6, 7)), __builtin_bit_cast(bf16x8, __builtin_shufflevector(At[m], At[m], 4, 5, 6, 7)), acc[ai][bj][m][n], 0, 0, 0); } } \
        __builtin_amdgcn_s_setprio(0); } while (0)
#define PG8_WAIT_V(n) asm volatile("s_waitcnt vmcnt(" #n ")" ::: "memory")
#define PG8_WAIT_L(n) asm volatile("s_waitcnt lgkmcnt(" #n ")" ::: "memory")
#define PG8_BAR __builtin_amdgcn_s_barrier()
#define PG8_SCHED __builtin_amdgcn_sched_barrier(0)
#define PG8_GATHER_OFFS(u_, o0, o1) do { if constexpr (GATHER) { const int tq_ = opaque_v(tid); _Pragma("unroll") for (int _i = 0; _i < 2; ++_i) { \
        int sR_, sC_; stage_rc(tq_ * 16 + _i * 8192, sR_, sC_); sC_ *= 2; const int r0_ = sR_, r1_ = sR_ + HALF; const int i0_ = g.list[(u_).rl + (r0_ < (u_).valid ? r0_ : 0)], i1_ = g.list[(u_).rl + (r1_ < (u_).valid ? r1_ : 0)]; \
        o0[_i] = (unsigned)i0_ * (unsigned)g.lda + (unsigned)sC_; o1[_i] = (unsigned)i1_ * (unsigned)g.lda + (unsigned)sC_; } } } while (0)
    Unit cur, nxt; int ui = 0;
    if (!S.next(0, cur)) return;
    f32x4 acc[2][2][4][2];
#pragma unroll
    for (int a = 0; a < 2; ++a)
#pragma unroll
        for (int b = 0; b < 2; ++b)
#pragma unroll
            for (int m = 0; m < 4; ++m)
#pragma unroll
                for (int n = 0; n < 2; ++n) { f32x4 z_; asm volatile("v_mov_b32 %0, 0\n\tv_mov_b32 %1, 0\n\tv_mov_b32 %2, 0\n\tv_mov_b32 %3, 0" : "=v"(z_[0]), "=v"(z_[1]), "=v"(z_[2]), "=v"(z_[3])); acc[a][b][m][n] = z_; }
    typedef int i32x4_ __attribute__((ext_vector_type(4)));
    v8i32 At[4], B0[2], B1[2];
    const char* cA = g.A + cur.a; const char* cB = g.B + cur.b;
    PG8_GATHER_OFFS(cur, vA0, vA1);
    PG8_STAGE(PG8_SB(0, 0), cB, voffB); PG8_STAGE(PG8_SB(0, 1), cB + hstepB, voffB); PG8_STAGE(PG8_SA(0, 0), cA, vA0); PG8_STAGE(PG8_SA(0, 1), cA, vA1);
    if (wr == 1) PG8_BAR;
    PG8_WAIT_V(2); PG8_BAR;
    PG8_STAGE(PG8_SB(1, 0), cB + kstep, voffB); PG8_STAGE(PG8_SA(1, 0), cA + kstep, vA0); PG8_STAGE(PG8_SB(1, 1), cB + hstepB + kstep, voffB);
    PG8_WAIT_V(6); PG8_BAR;
    for (;;) {
        const bool has_next = S.next(ui + 1, nxt);
        const char* nA = has_next ? g.A + nxt.a : cA; const char* nB = has_next ? g.B + nxt.b : cB;
        if constexpr (GATHER) { if (has_next) { PG8_GATHER_OFFS(nxt, vN0, vN1); } else {
#pragma unroll
            for (int i = 0; i < 2; ++i) { vN0[i] = vA0[i]; vN1[i] = vA1[i]; } } }
        for (int t = 0; t < nt; t += 2) {
            const unsigned la_ = (unsigned)opaque_v((int)((unsigned)(size_t)lds + (unsigned)aoff)), lb_ = (unsigned)opaque_v((int)((unsigned)(size_t)lds + (unsigned)boff + 4u * HTB));
            const bool last = (t == nt - 2);
            const char* a1 = cA + (size_t)(t + 1) * kstep;
            const char* a2 = last ? nA : cA + (size_t)(t + 2) * kstep; const char* b2 = last ? nB : cB + (size_t)(t + 2) * kstep;
            const char* a3 = a2 + kstep; const char* b3 = b2 + kstep;
            PG8_LDB(B0, 0, 0); PG8_LDB(B1, 0, 1); PG8_SCHED; PG8_LDA(At, 0, 0); PG8_STAGE(PG8_SA(1, 1), a1, vA1);
            if constexpr (GATHER) { if (last) { _Pragma("unroll") for (int i = 0; i < 2; ++i) { vA0[i] = vN0[i]; vA1[i] = vN1[i]; } } }
            PG8_WAIT_V(8); PG8_WAIT_L(0); PG8_BAR; PG8_MMA(0, 0, At, B0); PG8_MMA(0, 1, At, B1); PG8_BAR; PG8_SCHED;
            PG8_LDA(At, 0, 1); PG8_STAGE(PG8_SB(0, 0), b2, voffB); PG8_STAGE(PG8_SB(0, 1), b2 + hstepB, voffB); PG8_STAGE(PG8_SA(0, 0), a2, vA0);
            PG8_WAIT_V(8); PG8_WAIT_L(0); PG8_BAR; PG8_MMA(1, 0, At, B0); PG8_MMA(1, 1, At, B1); PG8_BAR; PG8_SCHED;
            PG8_LDB(B0, 1, 0); PG8_LDB(B1, 1, 1); PG8_SCHED; PG8_LDA(At, 1, 0); PG8_STAGE(PG8_SA(0, 1), a2, vA1);
            PG8_WAIT_V(8); PG8_WAIT_L(0); PG8_BAR; PG8_MMA(0, 0, At, B0); PG8_MMA(0, 1, At, B1); PG8_BAR; PG8_SCHED;
            PG8_LDA(At, 1, 1); PG8_STAGE(PG8_SB(1, 0), b3, voffB); PG8_STAGE(PG8_SB(1, 1), b3 + hstepB, voffB); PG8_STAGE(PG8_SA(1, 0), a3, vA0);
            PG8_WAIT_V(8); PG8_WAIT_L(0); PG8_BAR; PG8_MMA(1, 0, At, B0); PG8_MMA(1, 1, At, B1); PG8_BAR; PG8_SCHED;
        }
        if (wr == 0) PG8_BAR;
        { const int t2_ = opaque_v(tid), w2_ = __builtin_amdgcn_readfirstlane(t2_ >> 6), l2_ = t2_ & 63; E(acc, cur, w2_ >> 2, w2_ & 3, l2_ & 15, l2_ >> 4); }
        if (!has_next) break;
#pragma unroll
        for (int a = 0; a < 2; ++a)
#pragma unroll
            for (int b = 0; b < 2; ++b)
#pragma unroll
                for (int m = 0; m < 4; ++m)
#pragma unroll
                    for (int n = 0; n < 2; ++n) { f32x4 z_; asm volatile("v_mov_b32 %0, 0\n\tv_mov_b32 %1, 0\n\tv_mov_b32 %2, 0\n\tv_mov_b32 %3, 0" : "=v"(z_[0]), "=v"(z_[1]), "=v"(z_[2]), "=v"(z_[3])); acc[a][b][m][n] = z_; }
        cur = nxt; cA = nA; cB = nB; ++ui;
        if (wr == 1) PG8_BAR;
    }
    PG8_WAIT_V(0);
    PG8_BAR;
#undef PG8_SA
#undef PG8_SB
#undef PG8_STAGE
#undef PG8_LDA
#undef PG8_LD16A
#undef PG8_LD16B
#undef PG8_LDB
#undef PG8_MMA
#undef PG8_WAIT_V
#undef PG8_WAIT_L
#undef PG8_BAR
#undef PG8_SCHED
#undef PG8_GATHER_OFFS
}
#endif
}
using pg8::Unit;

struct SchedDense {
    pg8::DenseOrder o; int lda, kb;
    __device__ __forceinline__ bool next(int i, Unit& u) const { int pm, pn; if (!o.tile(i, pm, pn)) return false;
        u.pm = pm; u.pn = pn; u.e = 0; u.valid = 256; u.rl = 0; u.a = (unsigned)pm * 256u * (unsigned)lda; u.b = (unsigned)pn * 256u * (unsigned)kb; return true; }
};
struct SchedGates {
    pg8::DenseOrder o;
    __device__ __forceinline__ bool next(int i, Unit& u) const { int pm, pn; if (!o.tile(i, pm, pn)) return false;
        const int gi = pn >> 1, hf = pn & 1; u.pm = pm; u.pn = hf; u.e = gi; u.valid = 256; u.rl = 0;
        u.a = (unsigned)pm * 256u * (D * 2) + gi * 256 * 2; u.b = (unsigned)gi * (512 * 256 * 2) + (unsigned)hf * 256 * 256 * 2; return true; }
};
#define MOE_CNT(lds)    ((LAS int*)((lds) + MOE_OFF))
#define MOE_MTBASE(lds) ((LAS int*)((lds) + MOE_OFF + 128))
#define MOE_MTE(lds)    ((LAS int*)((lds) + MOE_OFF + 288))
struct SchedMoe {
    LAS unsigned char* lds; int total, NT, G, c; unsigned bstride, apitch; bool gather;
    __device__ __forceinline__ bool next(int i, Unit& u) const {
        const int L = i * G + c; if (L >= total * NT) return false;
        const int mt = L / NT, nt = L - mt * NT;
        const int e = __builtin_amdgcn_readfirstlane(MOE_MTE(lds)[mt]); const int ml = mt - __builtin_amdgcn_readfirstlane(MOE_MTBASE(lds)[e]);
        const int left = __builtin_amdgcn_readfirstlane(MOE_CNT(lds)[e]) - ml * 256;
        u.pm = mt; u.pn = nt; u.e = e; u.valid = left < 256 ? left : 256; u.rl = e * NTOK + ml * 256;
        u.a = gather ? 0u : (unsigned)mt * 256u * apitch; u.b = (unsigned)e * bstride + (unsigned)nt * 256u * apitch; return true; }
};
__device__ __forceinline__ int moe_tables(LAS unsigned char* lds, const unsigned* cntw, const int tid) {
    LAS int* cnt = MOE_CNT(lds); LAS int* mtbase = MOE_MTBASE(lds); LAS int* mte = MOE_MTE(lds);
    __syncthreads();
    if (tid < 32) cnt[tid] = (int)__hip_atomic_load(cntw + tid, RLX_AGENT);
    __syncthreads();
    if (tid == 0) { int s = 0; for (int e = 0; e < NE; ++e) { mtbase[e] = s; const int n = (cnt[e] + 255) >> 8; for (int j = 0; j < n; ++j) mte[s + j] = e; s += n; } mtbase[NE] = s; }
    __syncthreads();
    return __builtin_amdgcn_readfirstlane(mtbase[NE]);
}

typedef f32x4 Acc[2][2][4][2];
struct EpiQKV {
    bf16_t* q;
    __device__ __forceinline__ void operator()(const Acc& acc, const Unit& u, int wr, int wc, int fr, int fq) const {
        const int which = u.pn >> 2; bf16_t* base = q + (size_t)which * ((WS_K - WS_Q) / 2); const float sc = which == 0 ? QSCALE : 1.0f;
#pragma unroll
        for (int ai = 0; ai < 2; ++ai)
#pragma unroll
            for (int m = 0; m < 4; ++m) { const int ntok = u.pm * 256 + 128 * ai + 64 * wr + 16 * m + fr, b = ntok >> 12, t = ntok & 4095;
#pragma unroll
                for (int bj = 0; bj < 2; ++bj) { const int head = (u.pn & 3) * 2 + bj, d = 32 * wc + 8 * fq;
                    const f32x4 v0 = acc[ai][bj][m][0] * sc, v1 = acc[ai][bj][m][1] * sc;
                    u32x4 w; w.x = cvt_pk_bf16(v0[0], v0[1]); w.y = cvt_pk_bf16(v0[2], v0[3]); w.z = cvt_pk_bf16(v1[0], v1[1]); w.w = cvt_pk_bf16(v1[2], v1[3]);
                    *(u32x4*)(base + ((size_t)((b * NH + head) * T + t)) * HD + d) = w; } }
    }
};
struct EpiResid {
    const float* X; float* Z;
    __device__ __forceinline__ void operator()(const Acc& acc, const Unit& u, int wr, int wc, int fr, int fq) const {
#pragma unroll
        for (int ai = 0; ai < 2; ++ai)
#pragma unroll
            for (int m = 0; m < 4; ++m) { const size_t row = (size_t)(u.pm * 256 + 128 * ai + 64 * wr + 16 * m + fr);
#pragma unroll
                for (int bj = 0; bj < 2; ++bj) { const size_t off = row * D + u.pn * 256 + 128 * bj + 32 * wc + 8 * fq;
                    const f32x4 x0 = *(const f32x4*)(X + off), x1 = *(const f32x4*)(X + off + 4);
                    *(f32x4*)(Z + off) = x0 * ALPHA + acc[ai][bj][m][0]; *(f32x4*)(Z + off + 4) = x1 * ALPHA + acc[ai][bj][m][1]; }
                asm volatile("" ::: "memory"); }
    }
};
__device__ __forceinline__ float gelu_tanh(float x) { const float y = 0.7978845608028654f * (x + 0.044715f * x * x * x); return x * __builtin_amdgcn_rcpf(1.0f + __builtin_amdgcn_exp2f(-2.0f * LOG2E * y)); }
struct EpiLin {
    bf16_t* ybr; bf16_t* r;
    __device__ __forceinline__ void operator()(const Acc& acc, const Unit& u, int wr, int wc, int fr, int fq) const {
        const bool isy = u.pn < 4; bf16_t* base = isy ? ybr : r; const int ct = isy ? u.pn : u.pn - 4;
#pragma unroll
        for (int ai = 0; ai < 2; ++ai)
#pragma unroll
            for (int m = 0; m < 4; ++m) { const size_t row = (size_t)(u.pm * 256 + 128 * ai + 64 * wr + 16 * m + fr);
#pragma unroll
                for (int bj = 0; bj < 2; ++bj) { f32x4 v0 = acc[ai][bj][m][0], v1 = acc[ai][bj][m][1];
                    if (isy) {
#pragma unroll
                        for (int j = 0; j < 4; ++j) { v0[j] = gelu_tanh(v0[j]); v1[j] = gelu_tanh(v1[j]); } }
                    u32x4 w; w.x = cvt_pk_bf16(v0[0], v0[1]); w.y = cvt_pk_bf16(v0[2], v0[3]); w.z = cvt_pk_bf16(v1[0], v1[1]); w.w = cvt_pk_bf16(v1[2], v1[3]);
                    *(u32x4*)(base + row * D + ct * 256 + 128 * bj + 32 * wc + 8 * fq) = w; } }
    }
};
struct EpiGates {
    const bf16_t* rc; const float* bgx; const float* bga; const float* spt; float* Aa; float* Uu;
    __device__ __forceinline__ void operator()(const Acc& acc, const Unit& u, int wr, int wc, int fr, int fq) const {
        const int ch = u.e * 256 + u.pn * 128 + 32 * wc + 8 * fq;
        const f32x4 bx0 = *(const f32x4*)(bgx + ch), bx1 = *(const f32x4*)(bgx + ch + 4), ba0 = *(const f32x4*)(bga + ch), ba1 = *(const f32x4*)(bga + ch + 4), sp0 = *(const f32x4*)(spt + ch), sp1 = *(const f32x4*)(spt + ch + 4);
#pragma unroll
        for (int ai = 0; ai < 2; ++ai)
#pragma unroll
            for (int m = 0; m < 4; ++m) { const size_t row = (size_t)(u.pm * 256 + 128 * ai + 64 * wr + 16 * m + fr);
                const u32x4 rw = *(const u32x4*)(rc + row * D + ch);
                const f32x4 r0 = {bf_lo(rw.x), bf_hi(rw.x), bf_lo(rw.y), bf_hi(rw.y)}, r1 = {bf_lo(rw.z), bf_hi(rw.z), bf_lo(rw.w), bf_hi(rw.w)};
                f32x4 a0, a1, u0, u1;
#pragma unroll
                for (int j = 0; j < 4; ++j) {
                    { const float gx = sigmoidf_(acc[ai][0][m][0][j] + bx0[j]), ga = sigmoidf_(acc[ai][1][m][0][j] + ba0[j]); const float la = ga * sp0[j], x = 2.0f * la;
                      a0[j] = __builtin_amdgcn_exp2f(la * LOG2E); const float om = (x > -0.02f) ? -x * (1.0f + x * (0.5f + x * (1.0f / 6.0f))) : 1.0f - __builtin_amdgcn_exp2f(x * LOG2E); u0[j] = __builtin_amdgcn_sqrtf(om) * gx * r0[j]; }
                    { const float gx = sigmoidf_(acc[ai][0][m][1][j] + bx1[j]), ga = sigmoidf_(acc[ai][1][m][1][j] + ba1[j]); const float la = ga * sp1[j], x = 2.0f * la;
                      a1[j] = __builtin_amdgcn_exp2f(la * LOG2E); const float om = (x > -0.02f) ? -x * (1.0f + x * (0.5f + x * (1.0f / 6.0f))) : 1.0f - __builtin_amdgcn_exp2f(x * LOG2E); u1[j] = __builtin_amdgcn_sqrtf(om) * gx * r1[j]; } }
                *(f32x4*)(Aa + row * D + ch) = a0; *(f32x4*)(Aa + row * D + ch + 4) = a1;
                *(f32x4*)(Uu + row * D + ch) = u0; *(f32x4*)(Uu + row * D + ch + 4) = u1;
                asm volatile("" ::: "memory"); }
    }
};
struct EpiSwiglu {
    const float* bg; const float* bu; unsigned char* hb;
    __device__ __forceinline__ void operator()(const Acc& acc, const Unit& u, int wr, int wc, int fr, int fq) const {
        const int col = u.pn * 128 + 32 * wc + 8 * fq;
        const f32x4 gA = *(const f32x4*)(bg + u.e * D + col), gB = *(const f32x4*)(bg + u.e * D + col + 4), uA = *(const f32x4*)(bu + u.e * D + col), uB = *(const f32x4*)(bu + u.e * D + col + 4);
        const float g0[8] = {gA[0], gA[1], gA[2], gA[3], gB[0], gB[1], gB[2], gB[3]}, u0[8] = {uA[0], uA[1], uA[2], uA[3], uB[0], uB[1], uB[2], uB[3]};
#pragma unroll
        for (int ai = 0; ai < 2; ++ai)
#pragma unroll
            for (int m = 0; m < 4; ++m) { const size_t row = (size_t)(u.pm * 256 + 128 * ai + 64 * wr + 16 * m + fr);
                float h[8];
#pragma unroll
                for (int j = 0; j < 8; ++j) { float gv = acc[ai][0][m][j >> 2][j & 3] * (1.0f / (XS8 * WS8_GU)) + g0[j], uv = acc[ai][1][m][j >> 2][j & 3] * (1.0f / (XS8 * WS8_GU)) + u0[j];
                    gv = fminf(gv, 7.0f); uv = fminf(fmaxf(uv, -7.0f), 7.0f); h[j] = gv * sigmoidf_(1.702f * gv) * (uv + 1.0f) * HS8; }
                int w0 = 0, w1 = 0; w0 = __builtin_amdgcn_cvt_pk_fp8_f32(h[0], h[1], w0, false); w0 = __builtin_amdgcn_cvt_pk_fp8_f32(h[2], h[3], w0, true); w1 = __builtin_amdgcn_cvt_pk_fp8_f32(h[4], h[5], w1, false); w1 = __builtin_amdgcn_cvt_pk_fp8_f32(h[6], h[7], w1, true);
                *(u32x2*)(hb + row * D + col) = (u32x2){(unsigned)w0, (unsigned)w1};
                asm volatile("" ::: "memory"); }
    }
};
struct EpiPlain {
    bf16_t* yb; float sc;
    __device__ __forceinline__ void operator()(const Acc& acc, const Unit& u, int wr, int wc, int fr, int fq) const {
#pragma unroll
        for (int ai = 0; ai < 2; ++ai)
#pragma unroll
            for (int m = 0; m < 4; ++m) { const size_t row = (size_t)(u.pm * 256 + 128 * ai + 64 * wr + 16 * m + fr);
#pragma unroll
                for (int bj = 0; bj < 2; ++bj) { const f32x4 v0 = acc[ai][bj][m][0] * sc, v1 = acc[ai][bj][m][1] * sc;
                    u32x4 w; w.x = cvt_pk_bf16(v0[0], v0[1]); w.y = cvt_pk_bf16(v0[2], v0[3]); w.z = cvt_pk_bf16(v1[0], v1[1]); w.w = cvt_pk_bf16(v1[2], v1[3]);
                    *(u32x4*)(yb + row * D + u.pn * 256 + 128 * bj + 32 * wc + 8 * fq) = w; } }
    }
};

__device__ __forceinline__ void xpose_item(const float* W, int K, int N, bf16_t* WT, int mode, LAS float* scr, int item, int lane) {
    const int nblk = N / 32, kb = item / nblk, nb = item % nblk, k0 = 64 * kb, n0 = 32 * nb;
    const int row0 = mode < 0 ? n0 : ((n0 >> 7) * 256 + mode * 128 + (n0 & 127));
#pragma unroll 8
    for (int i = 0; i < 32; ++i) { const int kk = 2 * i + (lane >> 5); scr[kk * 33 + (lane & 31)] = W[(size_t)(k0 + kk) * N + n0 + (lane & 31)]; }
    asm volatile("s_waitcnt lgkmcnt(0)" ::: "memory");
    const int c = lane & 7;
#pragma unroll
    for (int j = 0; j < 4; ++j) { const int n = (lane >> 3) + 8 * j; const LAS float* s = scr + (8 * c) * 33 + n;
        u32x4 o; o.x = cvt_pk_bf16(s[0 * 33], s[1 * 33]); o.y = cvt_pk_bf16(s[2 * 33], s[3 * 33]); o.z = cvt_pk_bf16(s[4 * 33], s[5 * 33]); o.w = cvt_pk_bf16(s[6 * 33], s[7 * 33]);
        *(u32x4*)(WT + (size_t)(row0 + n) * K + k0 + 8 * c) = o; }
    asm volatile("s_waitcnt lgkmcnt(0)" ::: "memory");
}
__device__ __forceinline__ void xpose_class(const float* src, int nmat, int K, int N, bf16_t* dst, size_t dstride, int mode, LAS float* scr, int gw, int NGW, int lane) {
    const int ipm = (K / 64) * (N / 32);
    for (int it = gw; it < nmat * ipm; it += NGW) { const int mat = it / ipm, r = it - mat * ipm;
        xpose_item(src + (size_t)mat * K * N, K, N, dst + (size_t)mat * dstride, mode, scr, r, lane); }
}

__device__ __forceinline__ void xpose_item8(const float* W, int K, int N, unsigned char* WT, int mode, float scale, LAS float* scr, int item, int lane) {
    const int nblk = N / 32, kb = item / nblk, nb = item % nblk, n0 = 32 * nb;
    const int row0 = mode < 0 ? n0 : ((n0 >> 7) * 256 + mode * 128 + (n0 & 127));
#pragma unroll 1
    for (int hf = 0; hf < 2; ++hf) { const int k0 = 128 * kb + 64 * hf;
#pragma unroll 8
        for (int i = 0; i < 32; ++i) { const int kk = 2 * i + (lane >> 5); scr[kk * 33 + (lane & 31)] = W[(size_t)(k0 + kk) * N + n0 + (lane & 31)] * scale; }
        asm volatile("s_waitcnt lgkmcnt(0)" ::: "memory");
        const int c = lane & 7;
#pragma unroll
        for (int j = 0; j < 4; ++j) { const int n = (lane >> 3) + 8 * j; const LAS float* s = scr + (8 * c) * 33 + n;
            int w0 = 0, w1 = 0; w0 = __builtin_amdgcn_cvt_pk_fp8_f32(s[0 * 33], s[1 * 33], w0, false); w0 = __builtin_amdgcn_cvt_pk_fp8_f32(s[2 * 33], s[3 * 33], w0, true);
            w1 = __builtin_amdgcn_cvt_pk_fp8_f32(s[4 * 33], s[5 * 33], w1, false); w1 = __builtin_amdgcn_cvt_pk_fp8_f32(s[6 * 33], s[7 * 33], w1, true);
            *(u32x2*)(WT + (size_t)(row0 + n) * K + k0 + 8 * c) = (u32x2){(unsigned)w0, (unsigned)w1}; }
        asm volatile("s_waitcnt lgkmcnt(0)" ::: "memory"); }
}
__device__ __forceinline__ void xpose_class8(const float* src, int nmat, int K, int N, unsigned char* dst, size_t dstride, int mode, float scale, LAS float* scr, int gw, int NGW, int lane) {
    const int ipm = (K / 128) * (N / 32);
    for (int it = gw; it < nmat * ipm; it += NGW) { const int mat = it / ipm, r = it - mat * ipm;
        xpose_item8(src + (size_t)mat * K * N, K, N, dst + (size_t)mat * dstride, mode, scale, scr, r, lane); }
}

struct Ctx {
    unsigned char* ws; LAS unsigned char* lds;
    int tid, lane, wave, G, vcu, bx;
};
struct Args { const float* in[25]; float* out; unsigned char* ws; int ph_lo, ph_hi; };

__device__ __forceinline__ void ph_prologue(const Ctx& c, const Args& A) {
    LAS float* scr = (LAS float*)(c.lds + c.wave * 16384);
    const int gw = c.vcu * 8 + c.wave, NGW = c.G * 8;
    unsigned char* ws = c.ws;
    xpose_class(A.in[2], 2, D, 3 * D, (bf16_t*)(ws + WS_WQKV), (size_t)3 * D * D, -1, scr, gw, NGW, c.lane);
    xpose_class(A.in[3], 2, D, D, (bf16_t*)(ws + WS_WO), (size_t)D * D, -1, scr, gw, NGW, c.lane);
    xpose_class(A.in[4], 2, D, 2 * D, (bf16_t*)(ws + WS_WIN), (size_t)2 * D * D, -1, scr, gw, NGW, c.lane);
    xpose_class(A.in[7], 8, 256, 256, (bf16_t*)(ws + WS_WG), (size_t)512 * 256, 0, scr, gw, NGW, c.lane);
    xpose_class(A.in[9], 8, 256, 256, (bf16_t*)(ws + WS_WG), (size_t)512 * 256, 1, scr, gw, NGW, c.lane);
    xpose_class(A.in[12], 2, D, D, (bf16_t*)(ws + WS_WOUT), (size_t)D * D, -1, scr, gw, NGW, c.lane);
    xpose_class8(A.in[15], DEPTH * NE, D, D, (unsigned char*)(ws + WS_WGU), (size_t)2 * D * D, 0, WS8_GU, scr, gw, NGW, c.lane);
    xpose_class8(A.in[17], DEPTH * NE, D, D, (unsigned char*)(ws + WS_WGU), (size_t)2 * D * D, 1, WS8_GU, scr, gw, NGW, c.lane);
    xpose_class8(A.in[19], DEPTH * NE, D, D, (unsigned char*)(ws + WS_WD), (size_t)D * D, -1, WS8_D, scr, gw, NGW, c.lane);
    for (int m = gw; m < NTOK; m += NGW) { const f32x4* xr = (const f32x4*)(A.in[0] + (size_t)m * D) + c.lane; u32x2* o = (u32x2*)((bf16_t*)(ws + WS_XB) + (size_t)m * D) + c.lane;
#pragma unroll
        for (int j = 0; j < 4; ++j) { const f32x4 v = xr[64 * j]; u32x2 w; w.x = cvt_pk_bf16(v[0], v[1]); w.y = cvt_pk_bf16(v[2], v[3]); o[64 * j] = w; } }
    if (c.bx == 0) { float* bt = (float*)(ws + WS_BIAS);
        for (int i = c.tid; i < NH * BIAS_W; i += 512) { const int h = i / BIAS_W; int dist = i % BIAS_W - 64; if (dist < 0) dist = 0;
            int bucket;
            if (dist < 16) bucket = dist; else { const float n = (float)dist; int lg = 16 + (int)(logf(n / 16.0f) / 2.0794415416798357f * 16.0f); bucket = lg < 31 ? lg : 31; }
            bt[i] = A.in[1][bucket * NH + h] * LOG2E; }
        float* spt = (float*)(ws + WS_SPT);
        for (int i = c.tid; i < 2 * D; i += 512) { const float ap = -A.in[11][i]; spt[i] = -8.0f * (ap > 15.f ? ap : log1pf(expf(ap))); } }
}

__device__ __forceinline__ void ph_kmean(const Ctx& c) {
    const bf16_t* Kb = (const bf16_t*)(c.ws + WS_K); float* km = (float*)(c.ws + WS_KMEAN); LAS float* red = (LAS float*)c.lds;
    for (int u = c.vcu; u < NB * NH * NBLK; u += c.G) {
        const int bh = u / NBLK, j = u % NBLK; const bf16_t* Kp = Kb + ((size_t)bh * T + j * MBLK) * HD;
        const int c8 = c.tid & 15, rg = c.tid >> 4; float a[8] = {0, 0, 0, 0, 0, 0, 0, 0};
#pragma unroll
        for (int r = 0; r < 8; ++r) { const u32x4 w = *(const u32x4*)(Kp + (size_t)(rg * 8 + r) * HD + c8 * 8);
            a[0] += bf_lo(w.x); a[1] += bf_hi(w.x); a[2] += bf_lo(w.y); a[3] += bf_hi(w.y); a[4] += bf_lo(w.z); a[5] += bf_hi(w.z); a[6] += bf_lo(w.w); a[7] += bf_hi(w.w); }
#pragma unroll
        for (int i = 0; i < 8; ++i) red[rg * 128 + c8 * 8 + i] = a[i];
        __syncthreads();
        if (c.tid < 128) { float s = 0.f; for (int g = 0; g < 32; ++g) s += red[g * 128 + c.tid]; km[(size_t)u * HD + c.tid] = s * (1.0f / MBLK); }
        __syncthreads();
    }
}
__device__ __forceinline__ void ph_select(const Ctx& c) {
    const bf16_t* Qb = (const bf16_t*)(c.ws + WS_Q); const float* km = (const float*)(c.ws + WS_KMEAN); unsigned* sel = (unsigned*)(c.ws + WS_SEL); LAS float* kl = (LAS float*)c.lds;
    for (int u = c.vcu; u < NB * NH * (T / 512); u += c.G) {
        const int bh = u / (T / 512), ch = u % (T / 512);
        __syncthreads();
        for (int i = c.tid; i < NBLK * HD; i += 512) kl[i] = km[(size_t)bh * NBLK * HD + i];
        __syncthreads();
        const int t = ch * 512 + c.tid, qb = t >> 8;
        float q[HD];
        const u32x4* qp = (const u32x4*)(Qb + ((size_t)bh * T + t) * HD);
#pragma unroll
        for (int i = 0; i < 16; ++i) { const u32x4 w = qp[i]; q[8 * i] = bf_lo(w.x); q[8 * i + 1] = bf_hi(w.x); q[8 * i + 2] = bf_lo(w.y); q[8 * i + 3] = bf_hi(w.y); q[8 * i + 4] = bf_lo(w.z); q[8 * i + 5] = bf_hi(w.z); q[8 * i + 6] = bf_lo(w.w); q[8 * i + 7] = bf_hi(w.w); }
        float v0 = -__builtin_inff(), v1 = v0, v2 = v0; int i0 = -1, i1 = -1, i2 = -1;
        for (int j = 0; j < qb; ++j) {
            float s = 0.f; const LAS f32x4* kp = (const LAS f32x4*)(kl + j * HD);
#pragma unroll
            for (int i = 0; i < 32; ++i) { const f32x4 kv = kp[i]; s += q[4 * i] * kv[0] + q[4 * i + 1] * kv[1] + q[4 * i + 2] * kv[2] + q[4 * i + 3] * kv[3]; }
            if (s > v0) { v2 = v1; i2 = i1; v1 = v0; i1 = i0; v0 = s; i0 = j; }
            else if (s > v1) { v2 = v1; i2 = i1; v1 = s; i1 = j; }
            else if (s > v2) { v2 = s; i2 = j; }
        }
        unsigned m = 0; if (i0 >= 0) m |= 1u << i0; if (i1 >= 0) m |= 1u << i1; if (i2 >= 0) m |= 1u << i2;
        sel[(size_t)bh * T + t] = m;
    }
}

#if NAIVE_ATTN
__device__ __forceinline__ void ph_attn(const Ctx& c) {
    const bf16_t* Qb = (const bf16_t*)(c.ws + WS_Q); const bf16_t* Kb = (const bf16_t*)(c.ws + WS_K); const bf16_t* Vb = (const bf16_t*)(c.ws + WS_V);
    const unsigned* sel = (const unsigned*)(c.ws + WS_SEL); const float* bt = (const float*)(c.ws + WS_BIAS); bf16_t* O = (bf16_t*)(c.ws + WS_O);
    LAS float* ql = (LAS float*)(c.lds + c.wave * 1024); LAS float* pl = ql + 128;
    const int gw = c.vcu * 8 + c.wave, NGW = c.G * 8, lane = c.lane;
    for (int r = gw; r < NB * NH * T; r += NGW) {
        const int bh = r / T, t = r % T, qb = t >> 8, h = bh % NH, b = bh / NH;
        const unsigned w = *(const unsigned*)(Qb + ((size_t)bh * T + t) * HD + 2 * lane);
        ql[2 * lane] = bf_lo(w); ql[2 * lane + 1] = bf_hi(w);
        asm volatile("s_waitcnt lgkmcnt(0)" ::: "memory");
        const unsigned mask = sel[(size_t)bh * T + t] | (1u << qb);
        float mrun = -1e30f, lrun = 0.f, o0 = 0.f, o1 = 0.f;
        for (int jb = 0; jb <= qb; ++jb) {
            if (!((mask >> jb) & 1u)) continue;
            for (int kc = 0; kc < 4; ++kc) {
                const int key = jb * MBLK + kc * 64 + lane;
                const u32x4* kp = (const u32x4*)(Kb + ((size_t)bh * T + key) * HD);
                float s = 0.f;
#pragma unroll
                for (int i = 0; i < 16; ++i) { const u32x4 kw = kp[i]; const LAS float* qq = ql + 8 * i;
                    s += qq[0] * bf_lo(kw.x) + qq[1] * bf_hi(kw.x) + qq[2] * bf_lo(kw.y) + qq[3] * bf_hi(kw.y) + qq[4] * bf_lo(kw.z) + qq[5] * bf_hi(kw.z) + qq[6] * bf_lo(kw.w) + qq[7] * bf_hi(kw.w); }
                const int dist = t - key;
                if (dist < 0) s = -__builtin_inff(); else s += bt[h * BIAS_W + 64 + (dist > 600 ? 600 : dist)];
                const float cm = wave_max(s), mn = fmaxf(mrun, cm), al = exp2f(mrun - mn), p = exp2f(s - mn);
                lrun = lrun * al + wave_sum(p); o0 *= al; o1 *= al; mrun = mn;
                pl[lane] = p;
                asm volatile("s_waitcnt lgkmcnt(0)" ::: "memory");
                const bf16_t* vp = Vb + ((size_t)bh * T + jb * MBLK + kc * 64) * HD + 2 * lane;
                for (int kk = 0; kk < 64; ++kk) { const unsigned vw = *(const unsigned*)(vp + (size_t)kk * HD); const float pk = pl[kk]; o0 += pk * bf_lo(vw); o1 += pk * bf_hi(vw); }
                asm volatile("s_waitcnt lgkmcnt(0)" ::: "memory");
            }
        }
        const float inv = 1.0f / lrun;
        *(unsigned*)(O + ((size_t)(b * T + t)) * D + h * HD + 2 * lane) = cvt_pk_bf16(o0 * inv, o1 * inv);
    }
}
#endif


#if !NAIVE_ATTN
namespace att {
typedef short s16x4 __attribute__((ext_vector_type(4)));
typedef float f32x16 __attribute__((ext_vector_type(16)));
constexpr int SHM_K = 64 * 128 * 2, SHM_V = SHM_K;
constexpr int OFF_V = 0, OFF_K = 2 * SHM_V, OFF_WS = 2 * SHM_V + 2 * SHM_K, OFF_TB = OFF_WS + 8 * 256;
constexpr float THR_L2 = 11.5f;
#define KSWZ(row, colB) ((row) * 256 + ((colB) ^ (((row) & 7) << 4)))
__device__ __forceinline__ int v_st(int k, int c) { const int kk = (k & ~0xC) | ((k & 4) << 1) | ((k & 8) >> 1); return ((kk >> 3) * 4 + (c >> 5)) * 512 + ((kk & 7) * 32 + (c & 31)) * 2; }
__device__ __forceinline__ int v_rd_base(int lane) { return ((lane & 3) << 3) | (((lane >> 2) & 3) << 6) | (((lane >> 4) & 1) << 5) | (((lane >> 5) & 1) << 8); }
constexpr int v_rd_off(int d0, int ks, int half) { return d0 * 512 + ks * 4096 + half * 2048; }
__device__ __forceinline__ int crow(int r, int hi) { return (r & 3) + 8 * (r >> 2) + 4 * hi; }
template <int KB>
__device__ __forceinline__ void qkt(f32x16& p0, f32x16& p1, LAS const char* K_lds, int r32, int hi, const bf16x8* qr) {
#pragma unroll
    for (int r = 0; r < 16; ++r) { p0[r] = 0.f; p1[r] = 0.f; }
    LAS const char* kb[4];
#pragma unroll
    for (int dd = 0; dd < 4; ++dd) kb[dd] = K_lds + KB * SHM_K + KSWZ(r32, (dd * 16 + hi * 8) * 2);
#pragma unroll
    for (int d0 = 0; d0 < 8; ++d0) { LAS const char* a = kb[d0 & 3] + (d0 >> 2) * 128;
        const bf16x8 b0 = *(LAS const bf16x8*)a, b1 = *(LAS const bf16x8*)(a + 32 * 256);
        p0 = __builtin_amdgcn_mfma_f32_32x32x16_bf16(b0, qr[d0], p0, 0, 0, 0);
        p1 = __builtin_amdgcn_mfma_f32_32x32x16_bf16(b1, qr[d0], p1, 0, 0, 0); }
}
template <int VB>
__device__ __forceinline__ void pv_tile(f32x16* o, int vb0, bf16x8 pa0, bf16x8 pa1, bf16x8 pa2, bf16x8 pa3) {
#define TRRD(dst, off) asm volatile("ds_read_b64_tr_b16 %0, %1 offset:%2" : "=&v"(dst) : "v"(vb0), "i"(off) : "memory")
#define PV_D0(d0) do { s16x4 l0, l1, l2, l3, h0, h1, h2, h3; constexpr int b_ = VB * SHM_V + v_rd_off(d0, 0, 0); \
        TRRD(l0, b_); TRRD(h0, b_ + 2048); TRRD(l1, b_ + 4096); TRRD(h1, b_ + 6144); TRRD(l2, b_ + 8192); TRRD(h2, b_ + 10240); TRRD(l3, b_ + 12288); TRRD(h3, b_ + 14336); \
        asm volatile("s_waitcnt lgkmcnt(0)" ::: "memory"); __builtin_amdgcn_sched_barrier(0); \
        o[d0] = __builtin_amdgcn_mfma_f32_32x32x16_bf16(pa0, (bf16x8){l0[0], l0[1], l0[2], l0[3], h0[0], h0[1], h0[2], h0[3]}, o[d0], 0, 0, 0); \
        o[d0] = __builtin_amdgcn_mfma_f32_32x32x16_bf16(pa1, (bf16x8){l1[0], l1[1], l1[2], l1[3], h1[0], h1[1], h1[2], h1[3]}, o[d0], 0, 0, 0); \
        o[d0] = __builtin_amdgcn_mfma_f32_32x32x16_bf16(pa2, (bf16x8){l2[0], l2[1], l2[2], l2[3], h2[0], h2[1], h2[2], h2[3]}, o[d0], 0, 0, 0); \
        o[d0] = __builtin_amdgcn_mfma_f32_32x32x16_bf16(pa3, (bf16x8){l3[0], l3[1], l3[2], l3[3], h3[0], h3[1], h3[2], h3[3]}, o[d0], 0, 0, 0); } while (0)
    PV_D0(0); PV_D0(1); PV_D0(2); PV_D0(3);
#undef PV_D0
#undef TRRD
}
__device__ __forceinline__ void unit(LAS char* lds, const bf16_t* __restrict__ Qh, const bf16_t* __restrict__ Kh, const bf16_t* __restrict__ Vh, const unsigned* __restrict__ selh,
                                     const float* __restrict__ bth, bf16_t* Oq, int qb, int tid) {
    const int wid = __builtin_amdgcn_readfirstlane(tid >> 6), lane = tid & 63, r32 = lane & 31, hi = lane >> 5;
    LAS char* V_lds = lds + OFF_V; LAS char* K_lds = lds + OFF_K;
    LAS float* wsl = (LAS float*)(lds + OFF_WS) + wid * 64; LAS float* li_l = wsl; LAS float* al_l = wsl + 32;
    LAS float* tb = (LAS float*)(lds + OFF_TB);
    const int NT = 4 * (qb + 1);
    const int qlo = qb * 256 + wid * 32, qpos = qlo + r32;
    const int sr = tid >> 4, sc = (tid & 15) * 8, vst0 = v_st(sr, sc), vst1 = v_st(32 + sr, sc), kws = KSWZ(sr, sc * 2);
    const int vb0 = (int)(unsigned)(size_t)V_lds + v_rd_base(lane);
    for (int i = tid; i < BIAS_W; i += 512) tb[i] = bth[i];
    bf16x8 qr[8];
#pragma unroll
    for (int d0 = 0; d0 < 8; ++d0) qr[d0] = *(const bf16x8*)(Qh + (size_t)qpos * HD + d0 * 16 + hi * 8);
    const unsigned selm = selh[qpos];
    const float cfar = bth[BIAS_W - 1];
    bf16x8 st_v0, st_v1, st_k0, st_k1;
#define SLOAD(k0) do { st_v0 = *(const bf16x8*)(Vh + (size_t)((k0) + sr) * HD + sc); st_v1 = *(const bf16x8*)(Vh + (size_t)((k0) + 32 + sr) * HD + sc); \
                       st_k0 = *(const bf16x8*)(Kh + (size_t)((k0) + sr) * HD + sc); st_k1 = *(const bf16x8*)(Kh + (size_t)((k0) + 32 + sr) * HD + sc); } while (0)
#define SWRITE(bf) do { *(LAS bf16x8*)(V_lds + (bf) * SHM_V + vst0) = st_v0; *(LAS bf16x8*)(V_lds + (bf) * SHM_V + vst1) = st_v1; \
                        *(LAS bf16x8*)(K_lds + (bf) * SHM_K + kws) = st_k0; *(LAS bf16x8*)(K_lds + (bf) * SHM_K + kws + 32 * 256) = st_k1; } while (0)
    SLOAD(0); SWRITE(0);
    __syncthreads();
    float m_reg = -1e30f, l_reg = 0.f; f32x16 o[4];
#pragma unroll
    for (int d = 0; d < 4; ++d)
#pragma unroll
        for (int r = 0; r < 16; ++r) o[d][r] = 0.f;
    const float NEG = -__builtin_inff();
#define TILE(t, BUF) do { \
        const int kbase = (t) * 64, jb = (t) >> 2; \
        if ((t) + 1 < NT) SLOAD(kbase + 64); \
        const bool own = (jb == qb); \
        if (!own || kbase <= qlo + 31) { \
            f32x16 p0, p1; \
            qkt<BUF>(p0, p1, K_lds, r32, hi, qr); \
            float addc; \
            if (jb + 1 >= qb) { \
                int bi = qpos - kbase + 1; bi = bi < 0 ? 0 : bi; \
                LAS const float* tp = tb + bi - 4 * hi; \
                _Pragma("unroll") for (int r = 0; r < 16; ++r) { const int c0 = (r & 3) + 8 * (r >> 2); p0[r] += tp[63 - c0]; p1[r] += tp[31 - c0]; } \
                if (own) { addc = 0.f; \
                    if (kbase + 63 > qlo) { const int dq = qpos - kbase - 4 * hi; \
                        _Pragma("unroll") for (int r = 0; r < 16; ++r) { const int c0 = (r & 3) + 8 * (r >> 2); if (dq - c0 < 0) p0[r] = NEG; if (dq - c0 - 32 < 0) p1[r] = NEG; } } } \
                else addc = ((selm >> jb) & 1u) ? 0.f : NEG; \
            } else addc = ((selm >> jb) & 1u) ? cfar : NEG; \
            float pmax = p0[0]; \
            _Pragma("unroll") for (int r = 1; r < 16; ++r) pmax = fmaxf(pmax, p0[r]); \
            _Pragma("unroll") for (int r = 0; r < 16; ++r) pmax = fmaxf(pmax, p1[r]); \
            { auto rr = __builtin_amdgcn_permlane32_swap(__float_as_uint(pmax), __float_as_uint(pmax), false, false); pmax = fmaxf(__uint_as_float(rr[0]), __uint_as_float(rr[1])); } \
            pmax += addc; \
            float mn, alpha; \
            if (__all(pmax - m_reg <= THR_L2)) { mn = m_reg; alpha = 1.f; } \
            else { mn = fmaxf(m_reg, pmax); alpha = __builtin_amdgcn_exp2f(m_reg - mn); m_reg = mn; } \
            const float offc = addc - mn; \
            _Pragma("unroll") for (int r = 0; r < 16; ++r) { p0[r] = __builtin_amdgcn_exp2f(p0[r] + offc); p1[r] = __builtin_amdgcn_exp2f(p1[r] + offc); } \
            float ps = 0.f; \
            _Pragma("unroll") for (int r = 0; r < 16; ++r) ps += p0[r]; \
            _Pragma("unroll") for (int r = 0; r < 16; ++r) ps += p1[r]; \
            { auto rr = __builtin_amdgcn_permlane32_swap(__float_as_uint(ps), __float_as_uint(ps), false, false); ps = __uint_as_float(rr[0]) + __uint_as_float(rr[1]); } \
            l_reg = l_reg * alpha + ps; \
            bf16x8 pa0, pa1, pa2, pa3; \
            PK4(p0, 0, pa0); PK4(p0, 8, pa1); PK4(p1, 0, pa2); PK4(p1, 8, pa3); \
            if (__any(alpha < 1.f)) { if (hi == 0) al_l[r32] = alpha; asm volatile("s_waitcnt lgkmcnt(0)" ::: "memory"); \
                _Pragma("unroll") for (int d_ = 0; d_ < 4; ++d_) _Pragma("unroll") for (int r = 0; r < 16; ++r) o[d_][r] *= al_l[crow(r, hi)]; } \
            pv_tile<BUF>(o, vb0, pa0, pa1, pa2, pa3); \
        } \
        if ((t) + 1 < NT) { asm volatile("s_waitcnt vmcnt(0)" ::: "memory"); SWRITE((BUF) ^ 1); } \
        __syncthreads(); } while (0)
#define PK4(P, B_, OUT) do { const unsigned a0 = cvt_pk_bf16(P[B_ + 0], P[B_ + 1]), a1 = cvt_pk_bf16(P[B_ + 2], P[B_ + 3]), b0 = cvt_pk_bf16(P[B_ + 4], P[B_ + 5]), b1 = cvt_pk_bf16(P[B_ + 6], P[B_ + 7]); \
        auto r0 = __builtin_amdgcn_permlane32_swap(a0, b0, false, false); auto r1 = __builtin_amdgcn_permlane32_swap(a1, b1, false, false); \
        u32x4 w_ = {r0[0], r1[0], r0[1], r1[1]}; OUT = *reinterpret_cast<bf16x8*>(&w_); } while (0)
    for (int t = 0; t < NT; t += 2) { TILE(t, 0); TILE(t + 1, 1); }
#undef TILE
#undef PK4
#undef SLOAD
#undef SWRITE
    if (hi == 0) li_l[r32] = l_reg;
    asm volatile("s_waitcnt lgkmcnt(0)" ::: "memory");
    bf16_t* Ow = Oq + (size_t)(wid * 32) * D;
#pragma unroll
    for (int r = 0; r < 16; ++r) { const int orow = crow(r, hi); const float rl = __builtin_amdgcn_rcpf(li_l[orow]);
#pragma unroll
        for (int d0 = 0; d0 < 4; ++d0) { const float v = o[d0][r] * rl; const float vn = __shfl_xor(v, 1);
            if ((r32 & 1) == 0) *(unsigned*)(Ow + (size_t)orow * D + d0 * 32 + r32) = cvt_pk_bf16(v, vn); } }
    __syncthreads();
}
#undef KSWZ
}
__device__ __forceinline__ void ph_attn(const Ctx& c) {
    const bf16_t* Qb = (const bf16_t*)(c.ws + WS_Q); const bf16_t* Kb = (const bf16_t*)(c.ws + WS_K); const bf16_t* Vb = (const bf16_t*)(c.ws + WS_V);
    const unsigned* sel = (const unsigned*)(c.ws + WS_SEL); const float* bt = (const float*)(c.ws + WS_BIAS); bf16_t* O = (bf16_t*)(c.ws + WS_O);
    for (int u = c.vcu; u < NB * NH * (NBLK / 2); u += c.G) {
        const int bh = u / (NBLK / 2), pi = u % (NBLK / 2), b = bh / NH, h = bh % NH;
#pragma unroll 1
        for (int pass = 0; pass < 2; ++pass) { const int qb = pass == 0 ? NBLK - 1 - pi : pi;
            att::unit((LAS char*)c.lds, Qb + (size_t)bh * T * HD, Kb + (size_t)bh * T * HD, Vb + (size_t)bh * T * HD, sel + (size_t)bh * T, bt + h * BIAS_W,
                      O + ((size_t)(b * T + qb * 256)) * D + h * HD, qb, c.tid); }
    }
}
#endif

__device__ __forceinline__ void ph_conv(const Ctx& c, const float* cw, const float* cb) {
    const bf16_t* R = (const bf16_t*)(c.ws + WS_R); bf16_t* RC = (bf16_t*)(c.ws + WS_RC);
    for (int i = c.vcu * 512 + c.tid; i < NTOK * (D / 8); i += c.G * 512) {
        const int n = i >> 7, c8 = (i & 127) * 8, t = n & (T - 1);
        float a[8];
#pragma unroll
        for (int j = 0; j < 8; ++j) a[j] = cb[c8 + j];
#pragma unroll
        for (int k = 0; k < 4; ++k) { const int tt = t - 3 + k; if (tt < 0) continue;
            const u32x4 w = *(const u32x4*)(R + (size_t)(n - 3 + k) * D + c8); const f32x4 w0 = *(const f32x4*)(cw + k * D + c8), w1 = *(const f32x4*)(cw + k * D + c8 + 4);
            a[0] += w0[0] * bf_lo(w.x); a[1] += w0[1] * bf_hi(w.x); a[2] += w0[2] * bf_lo(w.y); a[3] += w0[3] * bf_hi(w.y);
            a[4] += w1[0] * bf_lo(w.z); a[5] += w1[1] * bf_hi(w.z); a[6] += w1[2] * bf_lo(w.w); a[7] += w1[3] * bf_hi(w.w); }
        u32x4 o; o.x = cvt_pk_bf16(a[0], a[1]); o.y = cvt_pk_bf16(a[2], a[3]); o.z = cvt_pk_bf16(a[4], a[5]); o.w = cvt_pk_bf16(a[6], a[7]);
        *(u32x4*)(RC + (size_t)n * D + c8) = o;
    }
}
__device__ __forceinline__ void ph_scan(const Ctx& c) {
    const float* Aa = (const float*)(c.ws + WS_AA); const float* Uu = (const float*)(c.ws + WS_UU); const bf16_t* Y = (const bf16_t*)(c.ws + WS_YBR); bf16_t* Gq = (bf16_t*)(c.ws + WS_G);
    LAS float* cA = (LAS float*)c.lds; LAS float* cH = cA + 512;
    for (int u = c.vcu; u < NB * (D / 16); u += c.G) {
        const int b = u / (D / 16), cg = u % (D / 16), ch = c.wave * 4 + (c.lane >> 4), col = cg * 16 + (c.lane & 15);
        const size_t base = ((size_t)b * T + ch * 128) * D + col;
        float A = 1.f, H = 0.f;
#pragma unroll 8
        for (int s = 0; s < 128; ++s) { const float a = Aa[base + (size_t)s * D], x = Uu[base + (size_t)s * D]; A *= a; H = a * H + x; }
        __syncthreads();
        cA[ch * 16 + (c.lane & 15)] = A; cH[ch * 16 + (c.lane & 15)] = H;
        __syncthreads();
        float h = 0.f;
        for (int p = 0; p < ch; ++p) h = cA[p * 16 + (c.lane & 15)] * h + cH[p * 16 + (c.lane & 15)];
#pragma unroll 8
        for (int s = 0; s < 128; ++s) { const float a = Aa[base + (size_t)s * D], x = Uu[base + (size_t)s * D]; h = a * h + x;
            const float y = __uint_as_float(((unsigned)Y[base + (size_t)s * D]) << 16); const float gv = h * y;
            unsigned r = __float_as_uint(gv); r += 0x7fffu + ((r >> 16) & 1u); Gq[base + (size_t)s * D] = (bf16_t)(r >> 16); }
    }
}

__device__ __forceinline__ void ln_affine(f32x4 (&v)[4], const float* g, const float* bta, int lane) {
    float s = 0.f;
#pragma unroll
    for (int j = 0; j < 4; ++j) s += (v[j][0] + v[j][1]) + (v[j][2] + v[j][3]);
    const float mean = wave_sum(s) * (1.0f / D); float s2 = 0.f;
#pragma unroll
    for (int j = 0; j < 4; ++j) { v[j] = v[j] - mean; s2 += (v[j][0] * v[j][0] + v[j][1] * v[j][1]) + (v[j][2] * v[j][2] + v[j][3] * v[j][3]); }
    const float rstd = 1.0f / sqrtf(wave_sum(s2) * (1.0f / D) + LN_EPS);
#pragma unroll
    for (int j = 0; j < 4; ++j) { const f32x4 gg = *(const f32x4*)(g + 4 * lane + 256 * j), bb = *(const f32x4*)(bta + 4 * lane + 256 * j); v[j] = v[j] * rstd * gg + bb; }
}
__device__ __forceinline__ void store_row(const f32x4 (&v)[4], float* xf, bf16_t* xb, int lane) {
#pragma unroll
    for (int j = 0; j < 4; ++j) { *(f32x4*)(xf + 4 * lane + 256 * j) = v[j]; u32x2 w; w.x = cvt_pk_bf16(v[j][0], v[j][1]); w.y = cvt_pk_bf16(v[j][2], v[j][3]); *(u32x2*)(xb + 4 * lane + 256 * j) = w; }
}

__device__ __forceinline__ void ph_lnr(const Ctx& c, int layer, const float* g, const float* bta, const float* wr, const float* br) {
    const float* Z = (const float*)(c.ws + WS_Z); float* XF = (float*)(c.ws + WS_XF); unsigned char* XB8 = (unsigned char*)(c.ws + WS_XB8);
    int* tope = (int*)(c.ws + WS_TOPE); int* tops = (int*)(c.ws + WS_TOPS); float* topg = (float*)(c.ws + WS_TOPG);
    int* list = (int*)(c.ws + WS_LIST) + (size_t)layer * NE * NTOK; unsigned* cntw = (unsigned*)(c.ws + WS_CTL) + CW_CNT + layer * 64;
    LAS float* wl = (LAS float*)c.lds;
    LAS int* be = (LAS int*)(c.lds + LNR_OFF); LAS int* brk = be + 256; LAS int* bbase = brk + 256; LAS int* bcnt = bbase + 32;
    const int lane = c.lane;
    __syncthreads();
    for (int idx = c.tid; idx < D * 8; idx += 512) { const int d = idx >> 3, e4 = idx & 7; const int slot = ((d & 255) >> 2) + 64 * ((d >> 8) * 4 + (d & 3));
        *(LAS f32x4*)(wl + slot * 36 + e4 * 4) = *(const f32x4*)(wr + d * NE + e4 * 4); }
    __syncthreads();
    for (int tile = c.vcu; tile < NTOK / 64; tile += c.G) {
        for (int i = 0; i < 8; ++i) {
            const int rit = c.wave * 8 + i, n = tile * 64 + rit;
            f32x4 v[4];
#pragma unroll
            for (int j = 0; j < 4; ++j) v[j] = *(const f32x4*)(Z + (size_t)n * D + 4 * lane + 256 * j);
            ln_affine(v, g, bta, lane);
#pragma unroll
            for (int j = 0; j < 4; ++j) { *(f32x4*)(XF + (size_t)n * D + 4 * lane + 256 * j) = v[j]; int w = 0; w = __builtin_amdgcn_cvt_pk_fp8_f32(v[j][0] * XS8, v[j][1] * XS8, w, false); w = __builtin_amdgcn_cvt_pk_fp8_f32(v[j][2] * XS8, v[j][3] * XS8, w, true);
                *(int*)(XB8 + (size_t)n * D + 4 * lane + 256 * j) = w; }
            float acc[32];
#pragma unroll
            for (int e = 0; e < 32; ++e) acc[e] = 0.f;
#pragma unroll
            for (int j = 0; j < 4; ++j)
#pragma unroll
                for (int q = 0; q < 4; ++q) { const float xv = v[j][q]; const LAS f32x4* wp = (const LAS f32x4*)(wl + (lane + 64 * (4 * j + q)) * 36);
#pragma unroll
                    for (int e4 = 0; e4 < 8; ++e4) { const f32x4 w = wp[e4]; acc[4 * e4] += xv * w[0]; acc[4 * e4 + 1] += xv * w[1]; acc[4 * e4 + 2] += xv * w[2]; acc[4 * e4 + 3] += xv * w[3]; } }
            float a1[16], a2[8], a3[4], a4[2], a5;
#pragma unroll
            for (int k = 0; k < 16; ++k) { const bool hi = lane & 1; const float keep = hi ? acc[2 * k + 1] : acc[2 * k], send = hi ? acc[2 * k] : acc[2 * k + 1]; a1[k] = keep + __shfl_xor(send, 1); }
#pragma unroll
            for (int k = 0; k < 8; ++k) { const bool hi = lane & 2; const float keep = hi ? a1[2 * k + 1] : a1[2 * k], send = hi ? a1[2 * k] : a1[2 * k + 1]; a2[k] = keep + __shfl_xor(send, 2); }
#pragma unroll
            for (int k = 0; k < 4; ++k) { const bool hi = lane & 4; const float keep = hi ? a2[2 * k + 1] : a2[2 * k], send = hi ? a2[2 * k] : a2[2 * k + 1]; a3[k] = keep + __shfl_xor(send, 4); }
#pragma unroll
            for (int k = 0; k < 2; ++k) { const bool hi = lane & 8; const float keep = hi ? a3[2 * k + 1] : a3[2 * k], send = hi ? a3[2 * k] : a3[2 * k + 1]; a4[k] = keep + __shfl_xor(send, 8); }
            { const bool hi = lane & 16; const float keep = hi ? a4[1] : a4[0], send = hi ? a4[0] : a4[1]; a5 = keep + __shfl_xor(send, 16); }
            float val = a5 + __shfl_xor(a5, 32) + br[lane & 31];
            float tv[4]; int te[4];
#pragma unroll
            for (int k = 0; k < 4; ++k) { const float m = wave_max(val); const unsigned long long bal = __ballot(val == m); const int idx = __ffsll((long long)bal) - 1; tv[k] = m; te[k] = idx & 31; if ((lane & 31) == (idx & 31)) val = -__builtin_inff(); }
            const float e1 = __expf(tv[1] - tv[0]), e2 = __expf(tv[2] - tv[0]), e3 = __expf(tv[3] - tv[0]), inv = 1.0f / (1.0f + e1 + e2 + e3);
            if (lane == 0) { be[rit * 4 + 0] = te[0]; be[rit * 4 + 1] = te[1]; be[rit * 4 + 2] = te[2]; be[rit * 4 + 3] = te[3];
                *(f32x4*)(topg + (size_t)n * 4) = (f32x4){inv, e1 * inv, e2 * inv, e3 * inv}; }
        }
        __syncthreads();
        if (c.tid < NE) { int cnt = 0; for (int i = 0; i < 256; ++i) { if (be[i] == c.tid) { brk[i] = cnt; ++cnt; } }
            bcnt[c.tid] = cnt; bbase[c.tid] = cnt ? (int)__hip_atomic_fetch_add(cntw + c.tid, (unsigned)cnt, RLX_AGENT) : 0; }
        __syncthreads();
        if (c.tid < 256) { const int e = be[c.tid], slot = bbase[e] + brk[c.tid], n = tile * 64 + (c.tid >> 2);
            list[(size_t)e * NTOK + slot] = n; tope[(size_t)n * 4 + (c.tid & 3)] = e; tops[(size_t)n * 4 + (c.tid & 3)] = slot; }
        __syncthreads();
    }
}

__device__ __forceinline__ void ph_comb(const Ctx& c, int layer, float* xout, const float* g, const float* bta, const float* bd) {
    const float* XF = (const float*)(c.ws + WS_XF); bf16_t* XB = (bf16_t*)(c.ws + WS_XB); const bf16_t* YB = (const bf16_t*)(c.ws + WS_YB);
    const int* tope = (const int*)(c.ws + WS_TOPE); const int* tops = (const int*)(c.ws + WS_TOPS); const float* topg = (const float*)(c.ws + WS_TOPG);
    (void)moe_tables(c.lds, (const unsigned*)(c.ws + WS_CTL) + CW_CNT + layer * 64, c.tid);
    const int gw = c.vcu * 8 + c.wave, NGW = c.G * 8, lane = c.lane;
    for (int n = gw; n < NTOK; n += NGW) {
        f32x4 v[4];
#pragma unroll
        for (int j = 0; j < 4; ++j) v[j] = *(const f32x4*)(XF + (size_t)n * D + 4 * lane + 256 * j) * ALPHA;
#pragma unroll
        for (int k = 0; k < 4; ++k) { const int e = tope[(size_t)n * 4 + k], slot = tops[(size_t)n * 4 + k]; const float gt = topg[(size_t)n * 4 + k];
            const size_t row = ((size_t)MOE_MTBASE(c.lds)[e] << 8) + slot;
#pragma unroll
            for (int j = 0; j < 4; ++j) { const u32x2 w = *(const u32x2*)(YB + row * D + 4 * lane + 256 * j); const f32x4 bb = *(const f32x4*)(bd + (size_t)e * D + 4 * lane + 256 * j);
                v[j][0] += gt * (bf_lo(w.x) + bb[0]); v[j][1] += gt * (bf_hi(w.x) + bb[1]); v[j][2] += gt * (bf_lo(w.y) + bb[2]); v[j][3] += gt * (bf_hi(w.y) + bb[3]); } }
        ln_affine(v, g, bta, lane);
        store_row(v, xout + (size_t)n * D, XB + (size_t)n * D, lane);
    }
}

constexpr int PH_PER_LAYER = 9, N_PHASES = 1 + DEPTH * PH_PER_LAYER;

__global__ void __launch_bounds__(512, 2) mk_fwd(Args args) {
    extern __shared__ __attribute__((aligned(16))) unsigned char lds_raw[];
    Ctx c0;
    c0.ws = args.ws; c0.lds = (LAS unsigned char*)lds_raw;
    c0.tid = threadIdx.x; c0.lane = c0.tid & 63; c0.wave = __builtin_amdgcn_readfirstlane(c0.tid >> 6);
    c0.G = gridDim.x; c0.bx = blockIdx.x; { const int bx = blockIdx.x; c0.vcu = (c0.G % 8 == 0) ? (bx % 8) * (c0.G / 8) + bx / 8 : bx; }
    volatile LAS unsigned* MISC = (volatile LAS unsigned*)(c0.lds + MISC_OFF);
    if (c0.tid < 64) MISC[c0.tid] = 0u;
    __syncthreads();
    unsigned* ctl = (unsigned*)(c0.ws + WS_CTL);
#if MK_PER_PHASE
#define GRID_BAR() do { } while (0)
#else
    XcdBarrier bar = xcd_barrier_post(ctl + CW_BAR, MISC + 8);
#define GRID_BAR() xcd_barrier(bar)
#endif
    const int lo = args.ph_lo, hi = args.ph_hi;
#ifndef PMASK
#define PMASK 0xFFFF
#endif
#define EN(b) ((PMASK >> (b)) & 1)
#ifndef REPMASK
#define REPMASK 0
#endif
#define REPS(b) (1 + ((REPMASK >> (b)) & 1))
#define IN(k) (lo <= (k) && (k) < hi)
#define SEAM(k) do { if (IN(k) && IN((k) + 1)) GRID_BAR(); } while (0)
#define INP(i) (args.in[opaque_i(i)] + (size_t)(unsigned)opaque_i(0))
#define WSP() Ctx c = c0; c.ws = c0.ws + (size_t)(unsigned)opaque_i(0); c.tid = opaque_v(c0.tid); c.lane = c.tid & 63; c.wave = __builtin_amdgcn_readfirstlane(c.tid >> 6); c.G = opaque_i(c0.G); c.vcu = opaque_i(c0.vcu); c.bx = opaque_i(c0.bx); unsigned char* ws = c.ws

    if (EN(15) && IN(0)) for (int rep_ = 0; rep_ < REPS(15); ++rep_) { WSP(); (void)ws; ph_prologue(c, args); } SEAM(0);

#define LAYER(L_) do { \
        constexpr int L = L_; constexpr int p0 = 1 + L * PH_PER_LAYER, jm = L >> 1; \
        if constexpr ((L & 1) == 0) { \
            if (EN(0) && IN(p0 + 0)) for (int rep_ = 0; rep_ < REPS(0); ++rep_) { WSP(); SchedDense S; S.o.init(NTOK, 3 * D, c.G, c.bx); S.lda = D * 2; S.kb = D * 2; \
                const pg8::Gemm g{(const char*)(ws + WS_XB), (const char*)(ws + WS_WQKV) + (size_t)jm * 3 * D * D * 2, nullptr, D * 2, D * 2}; \
                EpiQKV E{(bf16_t*)(ws + WS_Q)}; \
                pg8::gemm_phase<EpiQKV, SchedDense, false>(c.lds, g, S, E, c.tid); } SEAM(p0 + 0); \
            if (EN(1) && IN(p0 + 1)) for (int rep_ = 0; rep_ < REPS(1); ++rep_) { WSP(); (void)ws; ph_kmean(c); } SEAM(p0 + 1); \
            if (EN(2) && IN(p0 + 2)) for (int rep_ = 0; rep_ < REPS(2); ++rep_) { WSP(); (void)ws; ph_select(c); } SEAM(p0 + 2); \
            if (EN(3) && IN(p0 + 3)) for (int rep_ = 0; rep_ < REPS(3); ++rep_) { WSP(); (void)ws; ph_attn(c); } SEAM(p0 + 3); \
            if (EN(4) && IN(p0 + 4)) for (int rep_ = 0; rep_ < REPS(4); ++rep_) { WSP(); SchedDense S; S.o.init(NTOK, D, c.G, c.bx); S.lda = D * 2; S.kb = D * 2; \
                const pg8::Gemm g{(const char*)(ws + WS_O), (const char*)(ws + WS_WO) + (size_t)jm * D * D * 2, nullptr, D * 2, D * 2}; \
                EpiResid E{(L == 0) ? INP(0) : (const float*)(ws + WS_XF), (float*)(ws + WS_Z)}; \
                pg8::gemm_phase<EpiResid, SchedDense, false>(c.lds, g, S, E, c.tid); } SEAM(p0 + 4); \
        } else { \
            if (EN(5) && IN(p0 + 0)) for (int rep_ = 0; rep_ < REPS(5); ++rep_) { WSP(); SchedDense S; S.o.init(NTOK, 2 * D, c.G, c.bx); S.lda = D * 2; S.kb = D * 2; \
                const pg8::Gemm g{(const char*)(ws + WS_XB), (const char*)(ws + WS_WIN) + (size_t)jm * 2 * D * D * 2, nullptr, D * 2, D * 2}; \
                EpiLin E{(bf16_t*)(ws + WS_YBR), (bf16_t*)(ws + WS_R)}; \
                pg8::gemm_phase<EpiLin, SchedDense, false>(c.lds, g, S, E, c.tid); } SEAM(p0 + 0); \
            if (EN(6) && IN(p0 + 1)) for (int rep_ = 0; rep_ < REPS(6); ++rep_) { WSP(); (void)ws; ph_conv(c, INP(5) + (size_t)jm * 4 * D, INP(6) + (size_t)jm * D); } SEAM(p0 + 1); \
            if (EN(7) && IN(p0 + 2)) for (int rep_ = 0; rep_ < REPS(7); ++rep_) { WSP(); SchedGates S; S.o.init(NTOK, 2 * D, c.G, c.bx); \
                const pg8::Gemm g{(const char*)(ws + WS_RC), (const char*)(ws + WS_WG) + (size_t)jm * 4 * 512 * 256 * 2, nullptr, D * 2, opaque_i(512)}; \
                EpiGates E{(const bf16_t*)(ws + WS_RC), INP(8) + (size_t)jm * D, INP(10) + (size_t)jm * D, (const float*)(ws + WS_SPT) + (size_t)jm * D, (float*)(ws + WS_AA), (float*)(ws + WS_UU)}; \
                pg8::gemm_phase<EpiGates, SchedGates, false>(c.lds, g, S, E, c.tid); } SEAM(p0 + 2); \
            if (EN(8) && IN(p0 + 3)) for (int rep_ = 0; rep_ < REPS(8); ++rep_) { WSP(); (void)ws; ph_scan(c); } SEAM(p0 + 3); \
            if (EN(9) && IN(p0 + 4)) for (int rep_ = 0; rep_ < REPS(9); ++rep_) { WSP(); SchedDense S; S.o.init(NTOK, D, c.G, c.bx); S.lda = D * 2; S.kb = D * 2; \
                const pg8::Gemm g{(const char*)(ws + WS_G), (const char*)(ws + WS_WOUT) + (size_t)jm * D * D * 2, nullptr, D * 2, D * 2}; \
                EpiResid E{(L == 0) ? INP(0) : (const float*)(ws + WS_XF), (float*)(ws + WS_Z)}; \
                pg8::gemm_phase<EpiResid, SchedDense, false>(c.lds, g, S, E, c.tid); } SEAM(p0 + 4); \
        } \
        if (EN(10) && IN(p0 + 5)) for (int rep_ = 0; rep_ < REPS(10); ++rep_) { WSP(); (void)ws; ph_lnr(c, L, INP(21) + L * D, INP(22) + L * D, INP(13) + (size_t)L * D * NE, INP(14) + L * NE); } SEAM(p0 + 5); \
        if (EN(11) && IN(p0 + 6)) for (int rep_ = 0; rep_ < REPS(11); ++rep_) { WSP(); const int total = moe_tables(c.lds, (unsigned*)(ws + WS_CTL) + CW_CNT + L * 64, c.tid); \
            SchedMoe S{c.lds, total, 8, c.G, c.vcu, (unsigned)(2 * D * D), (unsigned)D, true}; \
            const pg8::Gemm g{(const char*)(ws + WS_XB8), (const char*)(ws + WS_WGU) + (size_t)L * NE * 2 * D * D, (const int*)(ws + WS_LIST) + (size_t)L * NE * NTOK, D, opaque_i(D)}; \
            EpiSwiglu E{INP(16) + (size_t)L * NE * D, INP(18) + (size_t)L * NE * D, (unsigned char*)(ws + WS_HB)}; \
            pg8::gemm_phase<EpiSwiglu, SchedMoe, true, true>(c.lds, g, S, E, c.tid); } SEAM(p0 + 6); \
        if (EN(12) && IN(p0 + 7)) for (int rep_ = 0; rep_ < REPS(12); ++rep_) { WSP(); const int total = moe_tables(c.lds, (unsigned*)(ws + WS_CTL) + CW_CNT + L * 64, c.tid); \
            SchedMoe S{c.lds, total, 4, c.G, c.vcu, (unsigned)(D * D), (unsigned)D, false}; \
            const pg8::Gemm g{(const char*)(ws + WS_HB), (const char*)(ws + WS_WD) + (size_t)L * NE * D * D, nullptr, D, opaque_i(D)}; \
            EpiPlain E{(bf16_t*)(ws + WS_YB), 1.0f / (HS8 * WS8_D)}; \
            pg8::gemm_phase<EpiPlain, SchedMoe, false, true>(c.lds, g, S, E, c.tid); } SEAM(p0 + 7); \
        if (EN(13) && IN(p0 + 8)) for (int rep_ = 0; rep_ < REPS(13); ++rep_) { WSP(); ph_comb(c, L, (L == DEPTH - 1) ? args.out : (float*)(ws + WS_XF), INP(23) + L * D, INP(24) + L * D, INP(20) + (size_t)L * NE * D); } SEAM(p0 + 8); \
    } while (0)
    LAYER(0); LAYER(1); LAYER(2); LAYER(3);
#undef IN
#undef SEAM
}

extern "C" void kernel_launch(void* const* d_in, const int* in_sizes, int n_in, void* d_out, int out_size, void* d_ws, size_t ws_size, hipStream_t stream) {
    static int grid = 0;
    if (grid == 0) {
        if (n_in != 25 || out_size != NTOK * D || ws_size < WS_END) { fprintf(stderr, "kernel_launch: unexpected shapes (n_in %d out %d ws %zu)\n", n_in, out_size, ws_size); grid = -1; return; }
        int dev = 0, cus = 0;
        if (hipGetDevice(&dev) != hipSuccess || hipDeviceGetAttribute(&cus, hipDeviceAttributeMultiprocessorCount, dev) != hipSuccess) { grid = -1; return; }
        if (hipFuncSetAttribute((const void*)mk_fwd, hipFuncAttributeMaxDynamicSharedMemorySize, LDS_BYTES) != hipSuccess) { fprintf(stderr, "kernel_launch: hipFuncSetAttribute failed\n"); grid = -1; return; }
        int per_cu = 0;
        if (hipOccupancyMaxActiveBlocksPerMultiprocessor(&per_cu, (const void*)mk_fwd, 512, LDS_BYTES) != hipSuccess || per_cu < 1) fprintf(stderr, "kernel_launch: occupancy query says %d\n", per_cu);
        (void)hipGetLastError();
        grid = cus;
    }
    if (grid < 0) return;
    (void)hipMemsetAsync((char*)d_ws + WS_CTL, 0, CTL_BYTES, stream);
    Args a{};
    for (int i = 0; i < 25; ++i) a.in[i] = (const float*)d_in[i];
    a.out = (float*)d_out; a.ws = (unsigned char*)d_ws;
#if MK_PER_PHASE
    for (int p = 0; p < N_PHASES; ++p) {
        const int L = (p - 1) / PH_PER_LAYER, k = (p - 1) % PH_PER_LAYER; (void)L; (void)k;
        a.ph_lo = p; a.ph_hi = p + 1;
        hipLaunchKernelGGL(mk_fwd, dim3(grid), dim3(512), LDS_BYTES, stream, a);
    }
#else
    a.ph_lo = 0; a.ph_hi = N_PHASES;
    hipLaunchKernelGGL(mk_fwd, dim3(grid), dim3(512), LDS_BYTES, stream, a);
#endif
}
```

```cpp
#include <hip/hip_runtime.h>
#include <cstdio>
#include <cstdint>

#ifndef MK_PER_PHASE
#define MK_PER_PHASE 0
#endif
#ifndef NAIVE_GEMM
#define NAIVE_GEMM 0
#endif
#ifndef NAIVE_ATTN
#define NAIVE_ATTN 0
#endif

#define GAS __attribute__((address_space(1)))
#define LAS __attribute__((address_space(3)))
typedef unsigned short bf16_t;
typedef short bf16x8 __attribute__((ext_vector_type(8)));
typedef float f32x4 __attribute__((ext_vector_type(4)));
typedef float f32x2 __attribute__((ext_vector_type(2)));
typedef unsigned u32x4 __attribute__((ext_vector_type(4)));
typedef unsigned u32x2 __attribute__((ext_vector_type(2)));

constexpr int NB = 4, T = 4096, D = 1024, NTOK = NB * T, NH = 8, HD = 128, MBLK = 256, NBLK = T / MBLK, NE = 32, TOPK = 4, DEPTH = 4;
constexpr float ALPHA = 1.6817928305074290f;
constexpr float LOG2E = 1.4426950408889634f;
constexpr float QSCALE = 0.08838834764831845f * LOG2E;
constexpr float LN_EPS = 1e-5f;
constexpr int MAXMT = NTOK * TOPK / 256 + NE;
constexpr float XS8 = 8.0f, HS8 = 4.0f, WS8_GU = 32.0f, WS8_D = 64.0f;
constexpr int BIAS_W = 704;

constexpr size_t MiB = 1u << 20;
constexpr size_t WS_CTL = 0, CTL_BYTES = 1 * MiB;
constexpr size_t WS_BIAS = 1 * MiB;
constexpr size_t WS_SPT = 1 * MiB + 64 * 1024;
constexpr size_t WS_KMEAN = 1 * MiB + 256 * 1024;
constexpr size_t WS_SEL = 2 * MiB;
constexpr size_t WS_TOPE = 3 * MiB, WS_TOPS = 3 * MiB + 256 * 1024, WS_TOPG = 3 * MiB + 512 * 1024;
constexpr size_t WS_LIST = 4 * MiB;
constexpr size_t WS_WQKV = 16 * MiB, WS_WO = 28 * MiB, WS_WIN = 32 * MiB, WS_WG = 40 * MiB, WS_WOUT = 42 * MiB;
constexpr size_t WS_XB = 48 * MiB, WS_XF = 80 * MiB, WS_Z = 144 * MiB, WS_Q = 208 * MiB, WS_K = 240 * MiB, WS_V = 272 * MiB, WS_O = 304 * MiB;
constexpr size_t WS_YBR = 336 * MiB, WS_R = 368 * MiB, WS_RC = 400 * MiB, WS_AA = 432 * MiB, WS_UU = 496 * MiB, WS_G = 560 * MiB;
constexpr size_t WS_XB8 = 1648 * MiB;
constexpr size_t WS_HB = 592 * MiB, WS_YB = 736 * MiB, WS_WGU = 880 * MiB, WS_WD = 1392 * MiB, WS_END = 1664 * MiB;
constexpr int CW_TMO = 0, CW_BAR = 4096, CW_CNT = 8192;

constexpr int LDS_BYTES = 153600;
constexpr int RING_BYTES = 131072;
constexpr int MOE_OFF = RING_BYTES;
constexpr int LNR_OFF = 147456;
constexpr int MISC_OFF = LDS_BYTES - 256;

#define RLX_AGENT __ATOMIC_RELAXED, __HIP_MEMORY_SCOPE_AGENT
__device__ __forceinline__ unsigned cvt_pk_bf16(float lo, float hi) { unsigned r; asm volatile("v_cvt_pk_bf16_f32 %0, %1, %2" : "=v"(r) : "v"(lo), "v"(hi)); return r; }
__device__ __forceinline__ float bf_lo(unsigned w) { return __uint_as_float(w << 16); }
__device__ __forceinline__ float bf_hi(unsigned w) { return __uint_as_float(w & 0xffff0000u); }
__device__ __forceinline__ float wave_sum(float v) {
#pragma unroll
    for (int o = 1; o < 64; o <<= 1) v += __shfl_xor(v, o);
    return v;
}
__device__ __forceinline__ float wave_max(float v) {
#pragma unroll
    for (int o = 1; o < 64; o <<= 1) v = fmaxf(v, __shfl_xor(v, o));
    return v;
}
__device__ __forceinline__ int opaque_i(int v) { asm volatile("" : "+s"(v)); return v; }
__device__ __forceinline__ int opaque_v(int v) { asm volatile("" : "+v"(v)); return v; }
template <class P> __device__ __forceinline__ P* opaque_p(P* p) { asm volatile("" : "+s"(p)); return p; }
__device__ __forceinline__ float sigmoidf_(float x) { return __builtin_amdgcn_rcpf(1.0f + __builtin_amdgcn_exp2f(-1.4426950408889634f * x)); }

#define XB_TMO      128
#define XB_XCNT(j)  (256  + 64 * (j))
#define XB_XSUB(j)  (1280 + 64 * (j))
#define XB_XGEN(j)  (2304 + 64 * (j))
#define XB_TOP      3328
#define XB_TOPGEN   3392
#define XCD_BAR_WORDS 3456
#define XB_SPIN_CAP (1u << 22)
__device__ __forceinline__ unsigned xb_ld(unsigned* p)              { return __hip_atomic_load(p, __ATOMIC_RELAXED, __HIP_MEMORY_SCOPE_AGENT); }
__device__ __forceinline__ unsigned xb_add(unsigned* p, unsigned v) { return __hip_atomic_fetch_add(p, v, __ATOMIC_RELAXED, __HIP_MEMORY_SCOPE_AGENT); }
__device__ __forceinline__ unsigned xb_xcc_id() { return (unsigned)__builtin_amdgcn_s_getreg((3 << 11) | 20) & 0xFu; }
#define XB_SPIN(cond, bar) do { unsigned _sp = 0; while (cond) { __builtin_amdgcn_s_sleep(1); \
    if ((++_sp & 255u) == 0u) { if (xb_ld(&(bar)[XB_TMO])) break; if (_sp > XB_SPIN_CAP) { atomicAdd(&(bar)[XB_TMO], 1u); break; } } } } while (0)
struct XcdBarrier { unsigned* bar; unsigned x; volatile LAS unsigned* st; };
__device__ __forceinline__ XcdBarrier xcd_barrier_post(unsigned* bar, volatile LAS unsigned* st) {
    XcdBarrier b; b.bar = bar; b.x = xb_xcc_id(); b.st = st;
    if (threadIdx.x == 0) (void)xb_add(&bar[XB_XCNT(b.x)], 1u);
    return b;
}
__device__ __forceinline__ void xcd_barrier_complete(unsigned* bar, unsigned x, unsigned& nloc, unsigned& nx) {
    const unsigned G = gridDim.x * gridDim.y * gridDim.z;
    unsigned sum, cnt, mine, sp = 0u;
    for (;;) {
        sum = 0u; cnt = 0u; mine = 0u;
#pragma unroll
        for (unsigned j = 0; j < 16; ++j) { const unsigned c = xb_ld(&bar[XB_XCNT(j)]); sum += c; cnt += (c > 0u) ? 1u : 0u; mine = (j == x) ? c : mine; }
        if (sum == G) break;
        __builtin_amdgcn_s_sleep(1);
        if ((++sp & 255u) == 0u) { if (xb_ld(&bar[XB_TMO])) break; if (sp > XB_SPIN_CAP) { atomicAdd(&bar[XB_TMO], 1u); break; } }
    }
    nloc = mine > 0u ? mine : 1u; nx = cnt > 0u ? cnt : 1u;
}
__device__ __forceinline__ void xcd_barrier(const XcdBarrier& b) {
    asm volatile("s_waitcnt vmcnt(0)" ::: "memory");
    __syncthreads();
    if (threadIdx.x == 0) {
        unsigned* bar = b.bar;
        __builtin_amdgcn_s_waitcnt(0);
        unsigned nloc = b.st[0], nx = b.st[1];
        if (nloc == 0u) { xcd_barrier_complete(bar, b.x, nloc, nx); b.st[0] = nloc; b.st[1] = nx; }
        const unsigned old = xb_add(&bar[XB_XSUB(b.x)], 1u);
        const unsigned gen = old / nloc;
        if (old + 1u == (gen + 1u) * nloc) {
            __builtin_amdgcn_fence(__ATOMIC_RELEASE, "agent");
            asm volatile("s_waitcnt vmcnt(0)" ::: "memory");
            const unsigned og = xb_add(&bar[XB_TOP], 1u);
            const unsigned tg = og / nx;
            if (og + 1u == (tg + 1u) * nx) xb_add(&bar[XB_TOPGEN], 1u);
            else XB_SPIN(xb_ld(&bar[XB_TOPGEN]) == tg, bar);
            __builtin_amdgcn_fence(__ATOMIC_ACQUIRE, "agent");
            xb_add(&bar[XB_XGEN(b.x)], 1u);
            asm volatile("s_waitcnt vmcnt(0)" ::: "memory");
        } else {
            XB_SPIN(xb_ld(&bar[XB_XGEN(b.x)]) == gen, bar);
            __builtin_amdgcn_fence(__ATOMIC_ACQUIRE, "agent");
            asm volatile("s_waitcnt vmcnt(0)" ::: "memory");
        }
    }
    __syncthreads();
}

namespace pg8 {
constexpr int BM = 256, BK = 64, HALF = 128, HTB = HALF * BK * 2, STAGE_BYTES = 8 * HTB, NXCD = 8, WGM = 8;
__host__ __device__ __forceinline__ int lds_byte(int r, int c) { const int st = (r >> 4) * 2 + (c >> 5), rr = r & 15, cc = c & 31, ob = rr * 64 + cc * 2; return st * 1024 + (ob ^ (((ob >> 9) & 1) << 5)); }
__host__ __device__ __forceinline__ void stage_rc(int b, int& R, int& C) { const int st = b / 1024, sb = b % 1024, swz = sb ^ (((sb >> 9) & 1) << 5); R = (st >> 1) * 16 + swz / 64; C = (st & 1) * 32 + (swz % 64) / 2; }
__host__ __device__ __forceinline__ int perm32(int rho) { const int n = rho >> 4, i = rho & 15; return 8 * (i >> 2) + 4 * n + (i & 3); }

struct Unit { unsigned a, b; int rl; int pm, pn, e, valid; };
struct Gemm { const char* A; const char* B; const int* list; int lda; int kb; };
typedef int v8i32 __attribute__((ext_vector_type(8)));

struct DenseOrder {
    int nM, nN, nwg, G, c;
    __device__ void init(int M, int N, int G_, int c_) { nM = M / BM; nN = N / BM; nwg = nM * nN; G = G_; c = c_; }
    __device__ bool tile(int i, int& pm, int& pn) const {
        const long L = (long)i * G + c; if (L >= nwg) return false;
        int wgid = (int)L; { const int q = nwg / NXCD, r = nwg % NXCD, xcd = wgid % NXCD, off = wgid / NXCD; wgid = (xcd < r ? xcd * (q + 1) : r * (q + 1) + (xcd - r) * q) + off; }
        const int nig = WGM * nN, gid = wgid / nig, fm = gid * WGM, gsz = (nM - fm) < WGM ? (nM - fm) : WGM;
        pm = fm + ((wgid % nig) % gsz); pn = (wgid % nig) / gsz; return true;
    }
};

#if NAIVE_GEMM
template <class Epi, class Sched, bool GATHER, bool FP8 = false>
__device__ __forceinline__ void gemm_phase(LAS unsigned char* lds, const Gemm g, const Sched& S, const Epi& E, const int tid) {
    static_assert(!FP8, "reference K-loop is bf16 only");
    (void)lds;
    const int wid = __builtin_amdgcn_readfirstlane(tid >> 6), lane = tid & 63, wr = wid >> 2, wc = wid & 3, fr = lane & 15, fq = lane >> 4;
    Unit u;
    for (int i = 0; S.next(i, u); ++i) {
        f32x4 acc[2][2][4][2];
#pragma unroll
        for (int a = 0; a < 2; ++a)
#pragma unroll
            for (int b = 0; b < 2; ++b)
#pragma unroll
                for (int m = 0; m < 4; ++m)
#pragma unroll
                    for (int n = 0; n < 2; ++n) { f32x4 z_; asm volatile("v_mov_b32 %0, 0\n\tv_mov_b32 %1, 0\n\tv_mov_b32 %2, 0\n\tv_mov_b32 %3, 0" : "=v"(z_[0]), "=v"(z_[1]), "=v"(z_[2]), "=v"(z_[3])); acc[a][b][m][n] = z_; }
        unsigned ao[2][4], bo[2][2];
#pragma unroll
        for (int ai = 0; ai < 2; ++ai)
#pragma unroll
            for (int m = 0; m < 4; ++m) { const int r = 128 * ai + 64 * wr + 16 * m + fr;
                if (GATHER) { const int idx = g.list[u.rl + (r < u.valid ? r : 0)]; ao[ai][m] = (unsigned)idx * (unsigned)g.lda + fq * 16; }
                else ao[ai][m] = u.a + (unsigned)r * (unsigned)g.lda + fq * 16; }
#pragma unroll
        for (int bj = 0; bj < 2; ++bj)
#pragma unroll
            for (int n = 0; n < 2; ++n) { const int r = 128 * bj + 32 * wc + perm32(16 * n + fr); bo[bj][n] = u.b + (unsigned)r * (unsigned)g.kb + fq * 16; }
#pragma unroll 1
        for (int k0 = 0; k0 < g.kb / 2; k0 += 32) {
            bf16x8 B[2][2];
#pragma unroll
            for (int bj = 0; bj < 2; ++bj)
#pragma unroll
                for (int n = 0; n < 2; ++n) B[bj][n] = *(const bf16x8*)(g.B + bo[bj][n] + k0 * 2);
#pragma unroll
            for (int ai = 0; ai < 2; ++ai) {
                bf16x8 A[4];
#pragma unroll
                for (int m = 0; m < 4; ++m) A[m] = *(const bf16x8*)(g.A + ao[ai][m] + k0 * 2);
#pragma unroll
                for (int bj = 0; bj < 2; ++bj)
#pragma unroll
                    for (int m = 0; m < 4; ++m)
#pragma unroll
                        for (int n = 0; n < 2; ++n) acc[ai][bj][m][n] = __builtin_amdgcn_mfma_f32_16x16x32_bf16(B[bj][n], A[m], acc[ai][bj][m][n], 0, 0, 0);
            }
        }
        E(acc, u, wr, wc, fr, fq);
    }
}
#else
template <class Epi, class Sched, bool GATHER, bool FP8 = false>
__device__ __forceinline__ void gemm_phase(LAS unsigned char* lds, const Gemm g, const Sched& S, const Epi& E, const int tid) {
    const int wid = __builtin_amdgcn_readfirstlane(tid >> 6), lane = tid & 63, wr = wid >> 2, wc = wid & 3, fr = lane & 15, fq = lane >> 4;
    const int KB_ = g.kb, nt = KB_ / (BK * 2);
    unsigned voffB[2], vA0[2], vA1[2], vN0[2], vN1[2];
#pragma unroll
    for (int i = 0; i < 2; ++i) { int R, C; stage_rc(tid * 16 + i * 8192, R, C); const int Rb = (R & ~31) + perm32(R & 31);
        voffB[i] = (unsigned)(Rb * KB_ + C * 2); vA0[i] = (unsigned)(R * g.lda + C * 2); vA1[i] = vA0[i] + (unsigned)(HALF * g.lda); vN0[i] = vA0[i]; vN1[i] = vA1[i]; }
    const size_t kstep = (size_t)(BK * 2);
    const size_t hstepB = (size_t)HALF * KB_;
    const unsigned ldsw = (unsigned)wid * 1024u; const unsigned ldsbase_ = (unsigned)(size_t)lds + ldsw;
    const int aoff = lds_byte(wr * 64 + fr, fq * 8), boff = lds_byte(wc * 32 + fr, fq * 8);
#define PG8_SA(b, h) (((b) * 2 + (h)) * HTB)
#define PG8_SB(b, h) ((4 + (b) * 2 + (h)) * HTB)
#define PG8_STAGE(bufoff, gbase, voff) do { _Pragma("unroll") for (int _i = 0; _i < 2; ++_i) \
        asm volatile("s_mov_b32 m0, %2\n\ts_nop 0\n\tglobal_load_lds_dwordx4 %0, %1" :: "v"((voff)[_i]), "s"((const char*)(gbase)), "s"(ldsbase_ + (unsigned)((bufoff) + _i * 8192)) : "memory", "m0"); } while (0)
#define PG8_LD16A(off_) (*(const LAS i32x4_*)(size_t)(la_ + (unsigned)(off_)))
#define PG8_LD16B(off_) (*(const LAS i32x4_*)(size_t)(lb_ + (unsigned)(off_)))
#define PG8_LDA(dst, b, h) do { _Pragma("unroll") for (int m = 0; m < 4; ++m) dst[m] = __builtin_shufflevector(PG8_LD16A(PG8_SA(b, h) + m * 2048), PG8_LD16A(PG8_SA(b, h) + m * 2048 + 1024), 0, 1, 2, 3, 4, 5, 6, 7); } while (0)
#define PG8_LDB(dst, b, h) do { _Pragma("unroll") for (int n = 0; n < 2; ++n) dst[n] = __builtin_shufflevector(PG8_LD16B(PG8_SA(b, h) + n * 2048), PG8_LD16B(PG8_SA(b, h) + n * 2048 + 1024), 0, 1, 2, 3, 4, 5, 6, 7); } while (0)
#define PG8_MMA(ai, bj, At, Bt) do { __builtin_amdgcn_s_setprio(1); _Pragma("unroll") for (int m = 0; m < 4; ++m) _Pragma("unroll") for (int n = 0; n < 2; ++n) { \
        if constexpr (FP8) acc[ai][bj][m][n] = __builtin_amdgcn_mfma_scale_f32_16x16x128_f8f6f4(Bt[n], At[m], acc[ai][bj][m][n], 0, 0, 0, 0x7f7f7f7f, 0, 0x7f7f7f7f); \
        else { acc[ai][bj][m][n] = __builtin_amdgcn_mfma_f32_16x16x32_bf16(__builtin_bit_cast(bf16x8, __builtin_shufflevector(Bt[n], Bt[n], 0, 1, 2, 3)), __builtin_bit_cast(bf16x8, __builtin_shufflevector(At[m], At[m], 0, 1, 2, 3)), acc[ai][bj][m][n], 0, 0, 0); \
               acc[ai][bj][m][n] = __builtin_amdgcn_mfma_f32_16x16x32_bf16(__builtin_bit_cast(bf16x8, __builtin_shufflevector(Bt[n], Bt[n], 4, 5, 6, 7)), __builtin_bit_cast(bf16x8, __builtin_shufflevector(At[m], At[m], 4, 5, 6, 7)), acc[ai][bj][m][n], 0, 0, 0); } } \
        __builtin_amdgcn_s_setprio(0); } while (0)
#define PG8_WAIT_V(n) asm volatile("s_waitcnt vmcnt(" #n ")" ::: "memory")
#define PG8_WAIT_L(n) asm volatile("s_waitcnt lgkmcnt(" #n ")" ::: "memory")
#define PG8_BAR __builtin_amdgcn_s_barrier()
#define PG8_SCHED __builtin_amdgcn_sched_barrier(0)
#define PG8_GATHER_OFFS(u_, o0, o1) do { if constexpr (GATHER) { const int tq_ = opaque_v(tid); _Pragma("unroll") for (int _i = 0; _i < 2; ++_i) { \
        int sR_, sC_; stage_rc(tq_ * 16 + _i * 8192, sR_, sC_); sC_ *= 2; const int r0_ = sR_, r1_ = sR_ + HALF; const int i0_ = g.list[(u_).rl + (r0_ < (u_).valid ? r0_ : 0)], i1_ = g.list[(u_).rl + (r1_ < (u_).valid ? r1_ : 0)]; \
        o0[_i] = (unsigned)i0_ * (unsigned)g.lda + (unsigned)sC_; o1[_i] = (unsigned)i1_ * (unsigned)g.lda + (unsigned)sC_; } } } while (0)
    Unit cur, nxt; int ui = 0;
    if (!S.next(0, cur)) return;
    f32x4 acc[2][2][4][2];
#pragma unroll
    for (int a = 0; a < 2; ++a)
#pragma unroll
        for (int b = 0; b < 2; ++b)
#pragma unroll
            for (int m = 0; m < 4; ++m)
#pragma unroll
                for (int n = 0; n < 2; ++n) { f32x4 z_; asm volatile("v_mov_b32 %0, 0\n\tv_mov_b32 %1, 0\n\tv_mov_b32 %2, 0\n\tv_mov_b32 %3, 0" : "=v"(z_[0]), "=v"(z_[1]), "=v"(z_[2]), "=v"(z_[3])); acc[a][b][m][n] = z_; }
    typedef int i32x4_ __attribute__((ext_vector_type(4)));
    v8i32 At[4], B0[2], B1[2];
    const char* cA = g.A + cur.a; const char* cB = g.B + cur.b;
    PG8_GATHER_OFFS(cur, vA0, vA1);
    PG8_STAGE(PG8_SB(0, 0), cB, voffB); PG8_STAGE(PG8_SB(0, 1), cB + hstepB, voffB); PG8_STAGE(PG8_SA(0, 0), cA, vA0); PG8_STAGE(PG8_SA(0, 1), cA, vA1);
    if (wr == 1) PG8_BAR;
    PG8_WAIT_V(2); PG8_BAR;
    PG8_STAGE(PG8_SB(1, 0), cB + kstep, voffB); PG8_STAGE(PG8_SA(1, 0), cA + kstep, vA0); PG8_STAGE(PG8_SB(1, 1), cB + hstepB + kstep, voffB);
    PG8_WAIT_V(6); PG8_BAR;
    for (;;) {
        const bool has_next = S.next(ui + 1, nxt);
        const char* nA = has_next ? g.A + nxt.a : cA; const char* nB = has_next ? g.B + nxt.b : cB;
        if constexpr (GATHER) { if (has_next) { PG8_GATHER_OFFS(nxt, vN0, vN1); } else {
#pragma unroll
            for (int i = 0; i < 2; ++i) { vN0[i] = vA0[i]; vN1[i] = vA1[i]; } } }
        for (int t = 0; t < nt; t += 2) {
            const unsigned la_ = (unsigned)opaque_v((int)((unsigned)(size_t)lds + (unsigned)aoff)), lb_ = (unsigned)opaque_v((int)((unsigned)(size_t)lds + (unsigned)boff + 4u * HTB));
            const bool last = (t == nt - 2);
            const char* a1 = cA + (size_t)(t + 1) * kstep;
            const char* a2 = last ? nA : cA + (size_t)(t + 2) * kstep; const char* b2 = last ? nB : cB + (size_t)(t + 2) * kstep;
            const char* a3 = a2 + kstep; const char* b3 = b2 + kstep;
            PG8_LDB(B0, 0, 0); PG8_LDB(B1, 0, 1); PG8_SCHED; PG8_LDA(At, 0, 0); PG8_STAGE(PG8_SA(1, 1), a1, vA1);
            if constexpr (GATHER) { if (last) { _Pragma("unroll") for (int i = 0; i < 2; ++i) { vA0[i] = vN0[i]; vA1[i] = vN1[i]; } } }
            PG8_WAIT_V(8); PG8_WAIT_L(0); PG8_BAR; PG8_MMA(0, 0, At, B0); PG8_MMA(0, 1, At, B1); PG8_BAR; PG8_SCHED;
            PG8_LDA(At, 0, 1); PG8_STAGE(PG8_SB(0, 0), b2, voffB); PG8_STAGE(PG8_SB(0, 1), b2 + hstepB, voffB); PG8_STAGE(PG8_SA(0, 0), a2, vA0);
            PG8_WAIT_V(8); PG8_WAIT_L(0); PG8_BAR; PG8_MMA(1, 0, At, B0); PG8_MMA(1, 1, At, B1); PG8_BAR; PG8_SCHED;
            PG8_LDB(B0, 1, 0); PG8_LDB(B1, 1, 1); PG8_SCHED; PG8_LDA(At, 1, 0); PG8_STAGE(PG8_SA(0, 1), a2, vA1);
            PG8_WAIT_V(8); PG8_WAIT_L(0); PG8_BAR; PG8_MMA(0, 0, At, B0); PG8_MMA(0, 1, At, B1); PG8_BAR; PG8_SCHED;
            PG8_LDA(At, 1, 1); PG8_STAGE(PG8_SB(1, 0), b3, voffB); PG8_STAGE(PG8_SB(1, 1), b3 + hstepB, voffB); PG8_STAGE(PG8_SA(1, 0), a3, vA0);
            PG8_WAIT_V(8); PG8_WAIT_L(0); PG8_BAR; PG8_MMA(1, 0, At, B0); PG8_MMA(1, 1, At, B1); PG8_BAR; PG8_SCHED;
        }
        if (wr == 0) PG8_BAR;
        { const int t2_ = opaque_v(tid), w2_ = __builtin_amdgcn_readfirstlane(t2_ >> 6), l2_ = t2_ & 63; E(acc, cur, w2_ >> 2, w2_ & 3, l2_ & 15, l2_ >> 4); }
        if (!has_next) break;
#pragma unroll
        for (int a = 0; a < 2; ++a)
#pragma unroll
            for (int b = 0; b < 2; ++b)
#pragma unroll
                for (int m = 0; m < 4; ++m)
#pragma unroll
                    for (int n = 0; n < 2; ++n) { f32x4 z_; asm volatile("v_mov_b32 %0, 0\n\tv_mov_b32 %1, 0\n\tv_mov_b32 %2, 0\n\tv_mov_b32 %3, 0" : "=v"(z_[0]), "=v"(z_[1]), "=v"(z_[2]), "=v"(z_[3])); acc[a][b][m][n] = z_; }
        cur = nxt; cA = nA; cB = nB; ++ui;
        if (wr == 1) PG8_BAR;
    }
    PG8_WAIT_V(0);
    PG8_BAR;
#undef PG8_SA
#undef PG8_SB
#undef PG8_STAGE
#undef PG8_LDA
#undef PG8_LD16A
#undef PG8_LD16B
#undef PG8_LDB
#undef PG8_MMA
#undef PG8_WAIT_V
#undef PG8_WAIT_L
#undef PG8_BAR
#undef PG8_SCHED
#undef PG8_GATHER_OFFS
}
#endif
}
using pg8::Unit;

struct SchedDense {
    pg8::DenseOrder o; int lda, kb;
    __device__ __forceinline__ bool next(int i, Unit& u) const { int pm, pn; if (!o.tile(i, pm, pn)) return false;
        u.pm = pm; u.pn = pn; u.e = 0; u.valid = 256; u.rl = 0; u.a = (unsigned)pm * 256u * (unsigned)lda; u.b = (unsigned)pn * 256u * (unsigned)kb; return true; }
};
struct SchedGates {
    pg8::DenseOrder o;
    __device__ __forceinline__ bool next(int i, Unit& u) const { int pm, pn; if (!o.tile(i, pm, pn)) return false;
        const int gi = pn >> 1, hf = pn & 1; u.pm = pm; u.pn = hf; u.e = gi; u.valid = 256; u.rl = 0;
        u.a = (unsigned)pm * 256u * (D * 2) + gi * 256 * 2; u.b = (unsigned)gi * (512 * 256 * 2) + (unsigned)hf * 256 * 256 * 2; return true; }
};
#define MOE_CNT(lds)    ((LAS int*)((lds) + MOE_OFF))
#define MOE_MTBASE(lds) ((LAS int*)((lds) + MOE_OFF + 128))
#define MOE_MTE(lds)    ((LAS int*)((lds) + MOE_OFF + 288))
struct SchedMoe {
    LAS unsigned char* lds; int total, NT, G, c; unsigned bstride, apitch; bool gather;
    __device__ __forceinline__ bool next(int i, Unit& u) const {
        const int L = i * G + c; if (L >= total * NT) return false;
        const int mt = L / NT, nt = L - mt * NT;
        const int e = __builtin_amdgcn_readfirstlane(MOE_MTE(lds)[mt]); const int ml = mt - __builtin_amdgcn_readfirstlane(MOE_MTBASE(lds)[e]);
        const int left = __builtin_amdgcn_readfirstlane(MOE_CNT(lds)[e]) - ml * 256;
        u.pm = mt; u.pn = nt; u.e = e; u.valid = left < 256 ? left : 256; u.rl = e * NTOK + ml * 256;
        u.a = gather ? 0u : (unsigned)mt * 256u * apitch; u.b = (unsigned)e * bstride + (unsigned)nt * 256u * apitch; return true; }
};
__device__ __forceinline__ int moe_tables(LAS unsigned char* lds, const unsigned* cntw, const int tid) {
    LAS int* cnt = MOE_CNT(lds); LAS int* mtbase = MOE_MTBASE(lds); LAS int* mte = MOE_MTE(lds);
    __syncthreads();
    if (tid < 32) cnt[tid] = (int)__hip_atomic_load(cntw + tid, RLX_AGENT);
    __syncthreads();
    if (tid == 0) { int s = 0; for (int e = 0; e < NE; ++e) { mtbase[e] = s; const int n = (cnt[e] + 255) >> 8; for (int j = 0; j < n; ++j) mte[s + j] = e; s += n; } mtbase[NE] = s; }
    __syncthreads();
    return __builtin_amdgcn_readfirstlane(mtbase[NE]);
}

typedef f32x4 Acc[2][2][4][2];
struct EpiQKV {
    bf16_t* q;
    __device__ __forceinline__ void operator()(const Acc& acc, const Unit& u, int wr, int wc, int fr, int fq) const {
        const int which = u.pn >> 2; bf16_t* base = q + (size_t)which * ((WS_K - WS_Q) / 2); const float sc = which == 0 ? QSCALE : 1.0f;
#pragma unroll
        for (int ai = 0; ai < 2; ++ai)
#pragma unroll
            for (int m = 0; m < 4; ++m) { const int ntok = u.pm * 256 + 128 * ai + 64 * wr + 16 * m + fr, b = ntok >> 12, t = ntok & 4095;
#pragma unroll
                for (int bj = 0; bj < 2; ++bj) { const int head = (u.pn & 3) * 2 + bj, d = 32 * wc + 8 * fq;
                    const f32x4 v0 = acc[ai][bj][m][0] * sc, v1 = acc[ai][bj][m][1] * sc;
                    u32x4 w; w.x = cvt_pk_bf16(v0[0], v0[1]); w.y = cvt_pk_bf16(v0[2], v0[3]); w.z = cvt_pk_bf16(v1[0], v1[1]); w.w = cvt_pk_bf16(v1[2], v1[3]);
                    *(u32x4*)(base + ((size_t)((b * NH + head) * T + t)) * HD + d) = w; } }
    }
};
struct EpiResid {
    const bf16_t* X; bf16_t* Z; float sc;
    __device__ __forceinline__ void operator()(const Acc& acc, const Unit& u, int wr, int wc, int fr, int fq) const {
#pragma unroll
        for (int ai = 0; ai < 2; ++ai)
#pragma unroll
            for (int m = 0; m < 4; ++m) { const size_t row = (size_t)(u.pm * 256 + 128 * ai + 64 * wr + 16 * m + fr);
#pragma unroll
                for (int bj = 0; bj < 2; ++bj) { const size_t off = row * D + u.pn * 256 + 128 * bj + 32 * wc + 8 * fq;
                    const u32x4 xw = *(const u32x4*)(X + off); const f32x4 a0 = acc[ai][bj][m][0] * sc, a1 = acc[ai][bj][m][1] * sc;
                    u32x4 w; w.x = cvt_pk_bf16(bf_lo(xw.x) * ALPHA + a0[0], bf_hi(xw.x) * ALPHA + a0[1]); w.y = cvt_pk_bf16(bf_lo(xw.y) * ALPHA + a0[2], bf_hi(xw.y) * ALPHA + a0[3]);
                    w.z = cvt_pk_bf16(bf_lo(xw.z) * ALPHA + a1[0], bf_hi(xw.z) * ALPHA + a1[1]); w.w = cvt_pk_bf16(bf_lo(xw.w) * ALPHA + a1[2], bf_hi(xw.w) * ALPHA + a1[3]);
                    *(u32x4*)(Z + off) = w; }
                asm volatile("" ::: "memory"); }
    }
};
__device__ __forceinline__ float gelu_tanh(float x) { const float y = 0.7978845608028654f * (x + 0.044715f * x * x * x); return x * __builtin_amdgcn_rcpf(1.0f + __builtin_amdgcn_exp2f(-2.0f * LOG2E * y)); }
struct EpiLin {
    bf16_t* ybr; bf16_t* r;
    __device__ __forceinline__ void operator()(const Acc& acc, const Unit& u, int wr, int wc, int fr, int fq) const {
        const bool isy = u.pn < 4; bf16_t* base = isy ? ybr : r; const int ct = isy ? u.pn : u.pn - 4;
#pragma unroll
        for (int ai = 0; ai < 2; ++ai)
#pragma unroll
            for (int m = 0; m < 4; ++m) { const size_t row = (size_t)(u.pm * 256 + 128 * ai + 64 * wr + 16 * m + fr);
#pragma unroll
                for (int bj = 0; bj < 2; ++bj) { f32x4 v0 = acc[ai][bj][m][0], v1 = acc[ai][bj][m][1];
                    if (isy) {
#pragma unroll
                        for (int j = 0; j < 4; ++j) { v0[j] = gelu_tanh(v0[j]); v1[j] = gelu_tanh(v1[j]); } }
                    u32x4 w; w.x = cvt_pk_bf16(v0[0], v0[1]); w.y = cvt_pk_bf16(v0[2], v0[3]); w.z = cvt_pk_bf16(v1[0], v1[1]); w.w = cvt_pk_bf16(v1[2], v1[3]);
                    *(u32x4*)(base + row * D + ct * 256 + 128 * bj + 32 * wc + 8 * fq) = w; } }
    }
};
struct EpiGates {
    const bf16_t* rc; const float* bgx; const float* bga; const float* spt; float* Aa; float* Uu;
    __device__ __forceinline__ void operator()(const Acc& acc, const Unit& u, int wr, int wc, int fr, int fq) const {
        const int ch = u.e * 256 + u.pn * 128 + 32 * wc + 8 * fq;
        const f32x4 bx0 = *(const f32x4*)(bgx + ch), bx1 = *(const f32x4*)(bgx + ch + 4), ba0 = *(const f32x4*)(bga + ch), ba1 = *(const f32x4*)(bga + ch + 4), sp0 = *(const f32x4*)(spt + ch), sp1 = *(const f32x4*)(spt + ch + 4);
#pragma unroll
        for (int ai = 0; ai < 2; ++ai)
#pragma unroll
            for (int m = 0; m < 4; ++m) { const size_t row = (size_t)(u.pm * 256 + 128 * ai + 64 * wr + 16 * m + fr);
                const u32x4 rw = *(const u32x4*)(rc + row * D + ch);
                const f32x4 r0 = {bf_lo(rw.x), bf_hi(rw.x), bf_lo(rw.y), bf_hi(rw.y)}, r1 = {bf_lo(rw.z), bf_hi(rw.z), bf_lo(rw.w), bf_hi(rw.w)};
                f32x4 a0, a1, u0, u1;
#pragma unroll
                for (int j = 0; j < 4; ++j) {
                    { const float gx = sigmoidf_(acc[ai][0][m][0][j] + bx0[j]), ga = sigmoidf_(acc[ai][1][m][0][j] + ba0[j]); const float la = ga * sp0[j], x = 2.0f * la;
                      a0[j] = __builtin_amdgcn_exp2f(la * LOG2E); const float om = (x > -0.02f) ? -x * (1.0f + x * (0.5f + x * (1.0f / 6.0f))) : 1.0f - __builtin_amdgcn_exp2f(x * LOG2E); u0[j] = __builtin_amdgcn_sqrtf(om) * gx * r0[j]; }
                    { const float gx = sigmoidf_(acc[ai][0][m][1][j] + bx1[j]), ga = sigmoidf_(acc[ai][1][m][1][j] + ba1[j]); const float la = ga * sp1[j], x = 2.0f * la;
                      a1[j] = __builtin_amdgcn_exp2f(la * LOG2E); const float om = (x > -0.02f) ? -x * (1.0f + x * (0.5f + x * (1.0f / 6.0f))) : 1.0f - __builtin_amdgcn_exp2f(x * LOG2E); u1[j] = __builtin_amdgcn_sqrtf(om) * gx * r1[j]; } }
                *(f32x4*)(Aa + row * D + ch) = a0; *(f32x4*)(Aa + row * D + ch + 4) = a1;
                *(f32x4*)(Uu + row * D + ch) = u0; *(f32x4*)(Uu + row * D + ch + 4) = u1;
                asm volatile("" ::: "memory"); }
    }
};
struct EpiSwiglu {
    const float* bg; const float* bu; unsigned char* hb;
    __device__ __forceinline__ void operator()(const Acc& acc, const Unit& u, int wr, int wc, int fr, int fq) const {
        const int col = u.pn * 128 + 32 * wc + 8 * fq;
        const f32x4 gA = *(const f32x4*)(bg + u.e * D + col), gB = *(const f32x4*)(bg + u.e * D + col + 4), uA = *(const f32x4*)(bu + u.e * D + col), uB = *(const f32x4*)(bu + u.e * D + col + 4);
        const float g0[8] = {gA[0], gA[1], gA[2], gA[3], gB[0], gB[1], gB[2], gB[3]}, u0[8] = {uA[0], uA[1], uA[2], uA[3], uB[0], uB[1], uB[2], uB[3]};
#pragma unroll
        for (int ai = 0; ai < 2; ++ai)
#pragma unroll
            for (int m = 0; m < 4; ++m) { const size_t row = (size_t)(u.pm * 256 + 128 * ai + 64 * wr + 16 * m + fr);
                float h[8];
#pragma unroll
                for (int j = 0; j < 8; ++j) { float gv = acc[ai][0][m][j >> 2][j & 3] * (1.0f / (XS8 * WS8_GU)) + g0[j], uv = acc[ai][1][m][j >> 2][j & 3] * (1.0f / (XS8 * WS8_GU)) + u0[j];
                    gv = fminf(gv, 7.0f); uv = fminf(fmaxf(uv, -7.0f), 7.0f); h[j] = gv * sigmoidf_(1.702f * gv) * (uv + 1.0f) * HS8; }
                int w0 = 0, w1 = 0; w0 = __builtin_amdgcn_cvt_pk_fp8_f32(h[0], h[1], w0, false); w0 = __builtin_amdgcn_cvt_pk_fp8_f32(h[2], h[3], w0, true); w1 = __builtin_amdgcn_cvt_pk_fp8_f32(h[4], h[5], w1, false); w1 = __builtin_amdgcn_cvt_pk_fp8_f32(h[6], h[7], w1, true);
                *(u32x2*)(hb + row * D + col) = (u32x2){(unsigned)w0, (unsigned)w1};
                asm volatile("" ::: "memory"); }
    }
};
struct EpiPlain {
    bf16_t* yb; float sc;
    __device__ __forceinline__ void operator()(const Acc& acc, const Unit& u, int wr, int wc, int fr, int fq) const {
#pragma unroll
        for (int ai = 0; ai < 2; ++ai)
#pragma unroll
            for (int m = 0; m < 4; ++m) { const size_t row = (size_t)(u.pm * 256 + 128 * ai + 64 * wr + 16 * m + fr);
#pragma unroll
                for (int bj = 0; bj < 2; ++bj) { const f32x4 v0 = acc[ai][bj][m][0] * sc, v1 = acc[ai][bj][m][1] * sc;
                    u32x4 w; w.x = cvt_pk_bf16(v0[0], v0[1]); w.y = cvt_pk_bf16(v0[2], v0[3]); w.z = cvt_pk_bf16(v1[0], v1[1]); w.w = cvt_pk_bf16(v1[2], v1[3]);
                    *(u32x4*)(yb + row * D + u.pn * 256 + 128 * bj + 32 * wc + 8 * fq) = w; } }
    }
};

__device__ __forceinline__ void xpose_item(const float* W, int K, int N, bf16_t* WT, int mode, LAS float* scr, int item, int lane) {
    const int nblk = N / 32, kb = item / nblk, nb = item % nblk, k0 = 64 * kb, n0 = 32 * nb;
    const int row0 = mode < 0 ? n0 : ((n0 >> 7) * 256 + mode * 128 + (n0 & 127));
#pragma unroll 8
    for (int i = 0; i < 32; ++i) { const int kk = 2 * i + (lane >> 5); scr[kk * 33 + (lane & 31)] = W[(size_t)(k0 + kk) * N + n0 + (lane & 31)]; }
    asm volatile("s_waitcnt lgkmcnt(0)" ::: "memory");
    const int c = lane & 7;
#pragma unroll
    for (int j = 0; j < 4; ++j) { const int n = (lane >> 3) + 8 * j; const LAS float* s = scr + (8 * c) * 33 + n;
        u32x4 o; o.x = cvt_pk_bf16(s[0 * 33], s[1 * 33]); o.y = cvt_pk_bf16(s[2 * 33], s[3 * 33]); o.z = cvt_pk_bf16(s[4 * 33], s[5 * 33]); o.w = cvt_pk_bf16(s[6 * 33], s[7 * 33]);
        *(u32x4*)(WT + (size_t)(row0 + n) * K + k0 + 8 * c) = o; }
    asm volatile("s_waitcnt lgkmcnt(0)" ::: "memory");
}
__device__ __forceinline__ void xpose_class(const float* src, int nmat, int K, int N, bf16_t* dst, size_t dstride, int mode, LAS float* scr, int gw, int NGW, int lane) {
    const int ipm = (K / 64) * (N / 32);
    for (int it = gw; it < nmat * ipm; it += NGW) { const int mat = it / ipm, r = it - mat * ipm;
        xpose_item(src + (size_t)mat * K * N, K, N, dst + (size_t)mat * dstride, mode, scr, r, lane); }
}

__device__ __forceinline__ void xpose_item8(const float* W, int K, int N, unsigned char* WT, int mode, float scale, LAS float* scr, int item, int lane) {
    const int nblk = N / 32, kb = item / nblk, nb = item % nblk, n0 = 32 * nb;
    const int row0 = mode < 0 ? n0 : ((n0 >> 7) * 256 + mode * 128 + (n0 & 127));
#pragma unroll 1
    for (int hf = 0; hf < 2; ++hf) { const int k0 = 128 * kb + 64 * hf;
#pragma unroll 8
        for (int i = 0; i < 32; ++i) { const int kk = 2 * i + (lane >> 5); scr[kk * 33 + (lane & 31)] = W[(size_t)(k0 + kk) * N + n0 + (lane & 31)] * scale; }
        asm volatile("s_waitcnt lgkmcnt(0)" ::: "memory");
        const int c = lane & 7;
#pragma unroll
        for (int j = 0; j < 4; ++j) { const int n = (lane >> 3) + 8 * j; const LAS float* s = scr + (8 * c) * 33 + n;
            int w0 = 0, w1 = 0; w0 = __builtin_amdgcn_cvt_pk_fp8_f32(s[0 * 33], s[1 * 33], w0, false); w0 = __builtin_amdgcn_cvt_pk_fp8_f32(s[2 * 33], s[3 * 33], w0, true);
            w1 = __builtin_amdgcn_cvt_pk_fp8_f32(s[4 * 33], s[5 * 33], w1, false); w1 = __builtin_amdgcn_cvt_pk_fp8_f32(s[6 * 33], s[7 * 33], w1, true);
            *(u32x2*)(WT + (size_t)(row0 + n) * K + k0 + 8 * c) = (u32x2){(unsigned)w0, (unsigned)w1}; }
        asm volatile("s_waitcnt lgkmcnt(0)" ::: "memory"); }
}
__device__ __forceinline__ void xpose_class8(const float* src, int nmat, int K, int N, unsigned char* dst, size_t dstride, int mode, float scale, LAS float* scr, int gw, int NGW, int lane) {
    const int ipm = (K / 128) * (N / 32);
    for (int it = gw; it < nmat * ipm; it += NGW) { const int mat = it / ipm, r = it - mat * ipm;
        xpose_item8(src + (size_t)mat * K * N, K, N, dst + (size_t)mat * dstride, mode, scale, scr, r, lane); }
}

struct Ctx {
    unsigned char* ws; LAS unsigned char* lds;
    int tid, lane, wave, G, vcu, bx;
};
struct Args { const float* in[25]; float* out; unsigned char* ws; int ph_lo, ph_hi; };

__device__ __forceinline__ void ph_prologue(const Ctx& c, const Args& A) {
    LAS float* scr = (LAS float*)(c.lds + c.wave * 16384);
    const int gw = c.vcu * 8 + c.wave, NGW = c.G * 8;
    unsigned char* ws = c.ws;
    xpose_class(A.in[2], 2, D, 3 * D, (bf16_t*)(ws + WS_WQKV), (size_t)3 * D * D, -1, scr, gw, NGW, c.lane);
    xpose_class(A.in[3], 2, D, D, (bf16_t*)(ws + WS_WO), (size_t)D * D, -1, scr, gw, NGW, c.lane);
    xpose_class(A.in[4], 2, D, 2 * D, (bf16_t*)(ws + WS_WIN), (size_t)2 * D * D, -1, scr, gw, NGW, c.lane);
    xpose_class(A.in[7], 8, 256, 256, (bf16_t*)(ws + WS_WG), (size_t)512 * 256, 0, scr, gw, NGW, c.lane);
    xpose_class(A.in[9], 8, 256, 256, (bf16_t*)(ws + WS_WG), (size_t)512 * 256, 1, scr, gw, NGW, c.lane);
    xpose_class(A.in[12], 2, D, D, (bf16_t*)(ws + WS_WOUT), (size_t)D * D, -1, scr, gw, NGW, c.lane);
#if NAIVE_ATTN
    xpose_class8(A.in[15], DEPTH * NE, D, D, (unsigned char*)(ws + WS_WGU), (size_t)2 * D * D, 0, WS8_GU, scr, gw, NGW, c.lane);
    xpose_class8(A.in[17], DEPTH * NE, D, D, (unsigned char*)(ws + WS_WGU), (size_t)2 * D * D, 1, WS8_GU, scr, gw, NGW, c.lane);
    xpose_class8(A.in[19], DEPTH * NE, D, D, (unsigned char*)(ws + WS_WD), (size_t)D * D, -1, WS8_D, scr, gw, NGW, c.lane);
#endif
    for (int m = gw; m < NTOK; m += NGW) { const f32x4* xr = (const f32x4*)(A.in[0] + (size_t)m * D) + c.lane; u32x2* o = (u32x2*)((bf16_t*)(ws + WS_XB) + (size_t)m * D) + c.lane;
#pragma unroll
        for (int j = 0; j < 4; ++j) { const f32x4 v = xr[64 * j]; u32x2 w; w.x = cvt_pk_bf16(v[0], v[1]); w.y = cvt_pk_bf16(v[2], v[3]); o[64 * j] = w; } }
    if (c.bx == 0) { float* bt = (float*)(ws + WS_BIAS);
        for (int i = c.tid; i < NH * BIAS_W; i += 512) { const int h = i / BIAS_W; int dist = i % BIAS_W - 64; if (dist < 0) dist = 0;
            int bucket;
            if (dist < 16) bucket = dist; else { const float n = (float)dist; int lg = 16 + (int)(logf(n / 16.0f) / 2.0794415416798357f * 16.0f); bucket = lg < 31 ? lg : 31; }
            bt[i] = A.in[1][bucket * NH + h] * LOG2E; }
        float* spt = (float*)(ws + WS_SPT);
        for (int i = c.tid; i < 2 * D; i += 512) { const float ap = -A.in[11][i]; spt[i] = -8.0f * (ap > 15.f ? ap : log1pf(expf(ap))); } }
}

__device__ __forceinline__ void ph_kmean(const Ctx& c) {
    const bf16_t* Kb = (const bf16_t*)(c.ws + WS_K); float* km = (float*)(c.ws + WS_KMEAN); LAS float* red = (LAS float*)c.lds;
    for (int u = c.vcu; u < NB * NH * NBLK; u += c.G) {
        const int bh = u / NBLK, j = u % NBLK; const bf16_t* Kp = Kb + ((size_t)bh * T + j * MBLK) * HD;
        const int c8 = c.tid & 15, rg = c.tid >> 4; float a[8] = {0, 0, 0, 0, 0, 0, 0, 0};
#pragma unroll
        for (int r = 0; r < 8; ++r) { const u32x4 w = *(const u32x4*)(Kp + (size_t)(rg * 8 + r) * HD + c8 * 8);
            a[0] += bf_lo(w.x); a[1] += bf_hi(w.x); a[2] += bf_lo(w.y); a[3] += bf_hi(w.y); a[4] += bf_lo(w.z); a[5] += bf_hi(w.z); a[6] += bf_lo(w.w); a[7] += bf_hi(w.w); }
#pragma unroll
        for (int i = 0; i < 8; ++i) red[rg * 128 + c8 * 8 + i] = a[i];
        __syncthreads();
        if (c.tid < 128) { float s = 0.f; for (int g = 0; g < 32; ++g) s += red[g * 128 + c.tid]; km[(size_t)u * HD + c.tid] = s * (1.0f / MBLK); }
        __syncthreads();
    }
}
__device__ __forceinline__ void ph_select(const Ctx& c) {
    const bf16_t* Qb = (const bf16_t*)(c.ws + WS_Q); const float* km = (const float*)(c.ws + WS_KMEAN); unsigned* sel = (unsigned*)(c.ws + WS_SEL); LAS float* kl = (LAS float*)c.lds;
    for (int u = c.vcu; u < NB * NH * (T / 512); u += c.G) {
        const int bh = u / (T / 512), ch = u % (T / 512);
        __syncthreads();
        for (int i = c.tid; i < NBLK * HD; i += 512) kl[i] = km[(size_t)bh * NBLK * HD + i];
        __syncthreads();
        const int t = ch * 512 + c.tid, qb = t >> 8;
        float q[HD];
        const u32x4* qp = (const u32x4*)(Qb + ((size_t)bh * T + t) * HD);
#pragma unroll
        for (int i = 0; i < 16; ++i) { const u32x4 w = qp[i]; q[8 * i] = bf_lo(w.x); q[8 * i + 1] = bf_hi(w.x); q[8 * i + 2] = bf_lo(w.y); q[8 * i + 3] = bf_hi(w.y); q[8 * i + 4] = bf_lo(w.z); q[8 * i + 5] = bf_hi(w.z); q[8 * i + 6] = bf_lo(w.w); q[8 * i + 7] = bf_hi(w.w); }
        float v0 = -__builtin_inff(), v1 = v0, v2 = v0; int i0 = -1, i1 = -1, i2 = -1;
        for (int j = 0; j < qb; ++j) {
            float s = 0.f; const LAS f32x4* kp = (const LAS f32x4*)(kl + j * HD);
#pragma unroll
            for (int i = 0; i < 32; ++i) { const f32x4 kv = kp[i]; s += q[4 * i] * kv[0] + q[4 * i + 1] * kv[1] + q[4 * i + 2] * kv[2] + q[4 * i + 3] * kv[3]; }
            if (s > v0) { v2 = v1; i2 = i1; v1 = v0; i1 = i0; v0 = s; i0 = j; }
            else if (s > v1) { v2 = v1; i2 = i1; v1 = s; i1 = j; }
            else if (s > v2) { v2 = s; i2 = j; }
        }
        unsigned m = 0; if (i0 >= 0) m |= 1u << i0; if (i1 >= 0) m |= 1u << i1; if (i2 >= 0) m |= 1u << i2;
        sel[(size_t)bh * T + t] = m;
    }
}

#if NAIVE_ATTN
__device__ __forceinline__ void ph_attn(const Ctx& c, const float*, const float*, const float*, int) {
    const bf16_t* Qb = (const bf16_t*)(c.ws + WS_Q); const bf16_t* Kb = (const bf16_t*)(c.ws + WS_K); const bf16_t* Vb = (const bf16_t*)(c.ws + WS_V);
    const unsigned* sel = (const unsigned*)(c.ws + WS_SEL); const float* bt = (const float*)(c.ws + WS_BIAS); bf16_t* O = (bf16_t*)(c.ws + WS_O);
    LAS float* ql = (LAS float*)(c.lds + c.wave * 1024); LAS float* pl = ql + 128;
    const int gw = c.vcu * 8 + c.wave, NGW = c.G * 8, lane = c.lane;
    for (int r = gw; r < NB * NH * T; r += NGW) {
        const int bh = r / T, t = r % T, qb = t >> 8, h = bh % NH, b = bh / NH;
        const unsigned w = *(const unsigned*)(Qb + ((size_t)bh * T + t) * HD + 2 * lane);
        ql[2 * lane] = bf_lo(w); ql[2 * lane + 1] = bf_hi(w);
        asm volatile("s_waitcnt lgkmcnt(0)" ::: "memory");
        const unsigned mask = sel[(size_t)bh * T + t] | (1u << qb);
        float mrun = -1e30f, lrun = 0.f, o0 = 0.f, o1 = 0.f;
        for (int jb = 0; jb <= qb; ++jb) {
            if (!((mask >> jb) & 1u)) continue;
            for (int kc = 0; kc < 4; ++kc) {
                const int key = jb * MBLK + kc * 64 + lane;
                const u32x4* kp = (const u32x4*)(Kb + ((size_t)bh * T + key) * HD);
                float s = 0.f;
#pragma unroll
                for (int i = 0; i < 16; ++i) { const u32x4 kw = kp[i]; const LAS float* qq = ql + 8 * i;
                    s += qq[0] * bf_lo(kw.x) + qq[1] * bf_hi(kw.x) + qq[2] * bf_lo(kw.y) + qq[3] * bf_hi(kw.y) + qq[4] * bf_lo(kw.z) + qq[5] * bf_hi(kw.z) + qq[6] * bf_lo(kw.w) + qq[7] * bf_hi(kw.w); }
                const int dist = t - key;
                if (dist < 0) s = -__builtin_inff(); else s += bt[h * BIAS_W + 64 + (dist > 600 ? 600 : dist)];
                const float cm = wave_max(s), mn = fmaxf(mrun, cm), al = exp2f(mrun - mn), p = exp2f(s - mn);
                lrun = lrun * al + wave_sum(p); o0 *= al; o1 *= al; mrun = mn;
                pl[lane] = p;
                asm volatile("s_waitcnt lgkmcnt(0)" ::: "memory");
                const bf16_t* vp = Vb + ((size_t)bh * T + jb * MBLK + kc * 64) * HD + 2 * lane;
                for (int kk = 0; kk < 64; ++kk) { const unsigned vw = *(const unsigned*)(vp + (size_t)kk * HD); const float pk = pl[kk]; o0 += pk * bf_lo(vw); o1 += pk * bf_hi(vw); }
                asm volatile("s_waitcnt lgkmcnt(0)" ::: "memory");
            }
        }
        const float inv = 1.0f / lrun;
        *(unsigned*)(O + ((size_t)(b * T + t)) * D + h * HD + 2 * lane) = cvt_pk_bf16(o0 * inv, o1 * inv);
    }
}
#endif


struct ConvJob { const float* wg; const float* wu; const float* wd; unsigned char* wgu8; unsigned char* wd8; int Lb; int NGW; };
constexpr int CONV_ITEMS = 3 * 64 * 256;
struct ConvState { int cj, half; bool pend; unsigned char* pdst; float pscale; };
__device__ __forceinline__ void conv_consume(ConvState& S, unsigned cvs_b  , int lane) {
    const int c = lane & 7, n4 = lane >> 3;
    if (S.pend) {
        asm volatile("s_waitcnt vmcnt(0)" ::: "memory");
        const unsigned rb = cvs_b + (unsigned)(c * 1040 + n4 * 128);
        const float sc = S.pscale;
        f32x4 v[8];
#pragma unroll
        for (int i = 0; i < 8; ++i) v[i] = *(const LAS f32x4*)(size_t)(rb + (unsigned)(i * 16)) * sc;
#pragma unroll
        for (int q = 0; q < 4; ++q) {
            int w0 = 0, w1 = 0; w0 = __builtin_amdgcn_cvt_pk_fp8_f32(v[0][q], v[1][q], w0, false); w0 = __builtin_amdgcn_cvt_pk_fp8_f32(v[2][q], v[3][q], w0, true);
            w1 = __builtin_amdgcn_cvt_pk_fp8_f32(v[4][q], v[5][q], w1, false); w1 = __builtin_amdgcn_cvt_pk_fp8_f32(v[6][q], v[7][q], w1, true);
            *(u32x2*)(S.pdst + (unsigned)((4 * n4 + q) * D + 8 * c)) = (u32x2){(unsigned)w0, (unsigned)w1}; }
        asm volatile("s_waitcnt lgkmcnt(0)" ::: "memory");
        S.pend = false;
    }
}
__device__ __forceinline__ void conv_issue(const ConvJob& J, ConvState& S, unsigned cvs_b, int lane) {
    const int c = lane & 7, nn = lane >> 3;
    if (S.cj < CONV_ITEMS) {
        const int j = S.cj, cls = j >> 14, r = j & 16383, mat = J.Lb * NE + (r >> 8), it = r & 255, kb = it >> 5, nb = it & 31, n0 = 32 * nb, k0 = 128 * kb + 64 * S.half;
        const float* Wb = J.wd; if (cls == 0) Wb = opaque_p(J.wg); if (cls == 1) Wb = opaque_p(J.wu);
        const float* W = Wb + (size_t)mat * D * D + (size_t)k0 * D + n0;
        const int row0 = cls == 2 ? n0 : ((n0 >> 7) * 256 + cls * 128 + (n0 & 127));
        unsigned char* db = J.wgu8 + (size_t)mat * 2 * D * D; if (cls == 2) db = opaque_p(J.wd8) + (size_t)mat * D * D;
        S.pdst = db + (size_t)row0 * D + k0;
        S.pscale = cls == 2 ? WS8_D : WS8_GU;
        const unsigned voff = (unsigned)(c * (D * 4) + nn * 16);
#pragma unroll
        for (int g = 0; g < 8; ++g)
            asm volatile("s_mov_b32 m0, %2\n\ts_nop 0\n\tglobal_load_lds_dwordx4 %0, %1" :: "v"(voff), "s"((const char*)(W + (size_t)g * 8 * D)), "s"(cvs_b + (unsigned)(g * 1040)) : "memory", "m0");
        S.pend = true;
        if (S.half) { S.half = 0; S.cj += J.NGW; } else S.half = 1;
    }
}

#if !NAIVE_ATTN
namespace att {
typedef short s16x4 __attribute__((ext_vector_type(4)));
typedef float f32x16 __attribute__((ext_vector_type(16)));
constexpr int SHM_K = 64 * 128 * 2, SHM_V = SHM_K;
constexpr int OFF_V = 0, OFF_K = 2 * SHM_V, OFF_WS = 2 * SHM_V + 2 * SHM_K, OFF_TB = OFF_WS + 8 * 256, OFF_CV = 73728;
constexpr float THR_L2 = 11.5f;
#define KSWZ(row, colB) ((row) * 256 + ((colB) ^ (((row) & 7) << 4)))
__device__ __forceinline__ int v_st(int k, int c) { const int kk = (k & ~0xC) | ((k & 4) << 1) | ((k & 8) >> 1); return ((kk >> 3) * 4 + (c >> 5)) * 512 + ((kk & 7) * 32 + (c & 31)) * 2; }
__device__ __forceinline__ int v_rd_base(int lane) { return ((lane & 3) << 3) | (((lane >> 2) & 3) << 6) | (((lane >> 4) & 1) << 5) | (((lane >> 5) & 1) << 8); }
constexpr int v_rd_off(int d0, int ks, int half) { return d0 * 512 + ks * 4096 + half * 2048; }
__device__ __forceinline__ int crow(int r, int hi) { return (r & 3) + 8 * (r >> 2) + 4 * hi; }
template <int KB>
__device__ __forceinline__ void qkt(f32x16& p0, f32x16& p1, LAS const char* K_lds, int r32, int hi, const bf16x8* qr) {
#pragma unroll
    for (int r = 0; r < 16; ++r) { p0[r] = 0.f; p1[r] = 0.f; }
    LAS const char* kb[4];
#pragma unroll
    for (int dd = 0; dd < 4; ++dd) kb[dd] = K_lds + KB * SHM_K + KSWZ(r32, (dd * 16 + hi * 8) * 2);
#pragma unroll
    for (int d0 = 0; d0 < 8; ++d0) { LAS const char* a = kb[d0 & 3] + (d0 >> 2) * 128;
        const bf16x8 b0 = *(LAS const bf16x8*)a, b1 = *(LAS const bf16x8*)(a + 32 * 256);
        p0 = __builtin_amdgcn_mfma_f32_32x32x16_bf16(b0, qr[d0], p0, 0, 0, 0);
        p1 = __builtin_amdgcn_mfma_f32_32x32x16_bf16(b1, qr[d0], p1, 0, 0, 0); }
}
template <int VB>
__device__ __forceinline__ void pv_tile(f32x16* o, int vb0, bf16x8 pa0, bf16x8 pa1, bf16x8 pa2, bf16x8 pa3) {
#define TRRD(dst, off) asm volatile("ds_read_b64_tr_b16 %0, %1 offset:%2" : "=&v"(dst) : "v"(vb0), "i"(off) : "memory")
#define PV_D0(d0) do { s16x4 l0, l1, l2, l3, h0, h1, h2, h3; constexpr int b_ = VB * SHM_V + v_rd_off(d0, 0, 0); \
        TRRD(l0, b_); TRRD(h0, b_ + 2048); TRRD(l1, b_ + 4096); TRRD(h1, b_ + 6144); TRRD(l2, b_ + 8192); TRRD(h2, b_ + 10240); TRRD(l3, b_ + 12288); TRRD(h3, b_ + 14336); \
        asm volatile("s_waitcnt lgkmcnt(0)" ::: "memory"); __builtin_amdgcn_sched_barrier(0); \
        o[d0] = __builtin_amdgcn_mfma_f32_32x32x16_bf16(pa0, (bf16x8){l0[0], l0[1], l0[2], l0[3], h0[0], h0[1], h0[2], h0[3]}, o[d0], 0, 0, 0); \
        o[d0] = __builtin_amdgcn_mfma_f32_32x32x16_bf16(pa1, (bf16x8){l1[0], l1[1], l1[2], l1[3], h1[0], h1[1], h1[2], h1[3]}, o[d0], 0, 0, 0); \
        o[d0] = __builtin_amdgcn_mfma_f32_32x32x16_bf16(pa2, (bf16x8){l2[0], l2[1], l2[2], l2[3], h2[0], h2[1], h2[2], h2[3]}, o[d0], 0, 0, 0); \
        o[d0] = __builtin_amdgcn_mfma_f32_32x32x16_bf16(pa3, (bf16x8){l3[0], l3[1], l3[2], l3[3], h3[0], h3[1], h3[2], h3[3]}, o[d0], 0, 0, 0); } while (0)
    PV_D0(0); PV_D0(1); PV_D0(2); PV_D0(3);
#undef PV_D0
#undef TRRD
}
__device__ __forceinline__ void unit(LAS char* lds, const bf16_t* __restrict__ Qh, const bf16_t* __restrict__ Kh, const bf16_t* __restrict__ Vh, const unsigned* __restrict__ selh,
                                     const float* __restrict__ bth, bf16_t* Oq, int qb, int tid, const ConvJob& J, ConvState& CS) {
    const int wid = __builtin_amdgcn_readfirstlane(tid >> 6), lane = tid & 63, r32 = lane & 31, hi = lane >> 5;
    LAS char* V_lds = lds + OFF_V; LAS char* K_lds = lds + OFF_K;
    LAS float* wsl = (LAS float*)(lds + OFF_WS) + wid * 64; LAS float* li_l = wsl; LAS float* al_l = wsl + 32;
    LAS float* tb = (LAS float*)(lds + OFF_TB); const unsigned cvs_b = (unsigned)(size_t)(lds + OFF_CV) + (unsigned)wid * 8448u;
    const int NT = 4 * (qb + 1);
    const int qlo = qb * 256 + wid * 32, qpos = qlo + r32;
    const int sr = tid >> 4, sc = (tid & 15) * 8, vst0 = v_st(sr, sc), vst1 = v_st(32 + sr, sc), kws = KSWZ(sr, sc * 2);
    const int vb0 = (int)(unsigned)(size_t)V_lds + v_rd_base(lane);
    for (int i = tid; i < BIAS_W; i += 512) tb[i] = bth[i];
    bf16x8 qr[8];
#pragma unroll
    for (int d0 = 0; d0 < 8; ++d0) qr[d0] = *(const bf16x8*)((const char*)Qh + ((unsigned)(qpos * HD + hi * 8) * 2u + (unsigned)d0 * 32u));
    const unsigned selm = selh[qpos];
    const float cfar = bth[BIAS_W - 1];
    bf16x8 st_v0, st_v1, st_k0, st_k1;
    const unsigned so0 = (unsigned)(sr * HD + sc) * 2u, so1 = so0 + 32u * HD * 2u;
#define SLOAD(k0) do { const char* vb_ = (const char*)Vh + (size_t)(k0) * (HD * 2); const char* kb_ = (const char*)Kh + (size_t)(k0) * (HD * 2); \
                       st_v0 = *(const bf16x8*)(vb_ + so0); st_v1 = *(const bf16x8*)(vb_ + so1); st_k0 = *(const bf16x8*)(kb_ + so0); st_k1 = *(const bf16x8*)(kb_ + so1); } while (0)
#define SWRITE(bf) do { *(LAS bf16x8*)(V_lds + (bf) * SHM_V + vst0) = st_v0; *(LAS bf16x8*)(V_lds + (bf) * SHM_V + vst1) = st_v1; \
                        *(LAS bf16x8*)(K_lds + (bf) * SHM_K + kws) = st_k0; *(LAS bf16x8*)(K_lds + (bf) * SHM_K + kws + 32 * 256) = st_k1; } while (0)
    SLOAD(0); SWRITE(0);
    __syncthreads();
    float m_reg = -1e30f, l_reg = 0.f; f32x16 o[4];
#pragma unroll
    for (int d = 0; d < 4; ++d)
#pragma unroll
        for (int r = 0; r < 16; ++r) o[d][r] = 0.f;
    const float NEG = -__builtin_inff();
#define TILE(t, BUF) do { \
        const int kbase = (t) * 64, jb = (t) >> 2; \
        if ((t) + 1 < NT) SLOAD(kbase + 64); \
        const bool own = (jb == qb); \
        if (!own || kbase <= qlo + 31) { \
            f32x16 p0, p1; \
            qkt<BUF>(p0, p1, K_lds, r32, hi, qr); \
            float addc; \
            if (jb + 1 >= qb) { \
                int bi = qpos - kbase + 1; bi = bi < 0 ? 0 : bi; \
                LAS const float* tp = tb + bi - 4 * hi; \
                _Pragma("unroll") for (int r = 0; r < 8; ++r) { const int c0 = (r & 3) + 8 * (r >> 2); p0[r] += tp[63 - c0]; p1[r] += tp[31 - c0]; } \
                asm volatile("" ::: "memory"); \
                _Pragma("unroll") for (int r = 8; r < 16; ++r) { const int c0 = (r & 3) + 8 * (r >> 2); p0[r] += tp[63 - c0]; p1[r] += tp[31 - c0]; } \
                if (own) { addc = 0.f; \
                    if (kbase + 63 > qlo) { const int dq = qpos - kbase - 4 * hi; \
                        _Pragma("unroll") for (int r = 0; r < 16; ++r) { const int c0 = (r & 3) + 8 * (r >> 2); if (dq - c0 < 0) p0[r] = NEG; if (dq - c0 - 32 < 0) p1[r] = NEG; } } } \
                else addc = ((selm >> jb) & 1u) ? 0.f : NEG; \
            } else addc = ((selm >> jb) & 1u) ? cfar : NEG; \
            float pmax = p0[0]; \
            _Pragma("unroll") for (int r = 1; r < 16; ++r) pmax = fmaxf(pmax, p0[r]); \
            _Pragma("unroll") for (int r = 0; r < 16; ++r) pmax = fmaxf(pmax, p1[r]); \
            { auto rr = __builtin_amdgcn_permlane32_swap(__float_as_uint(pmax), __float_as_uint(pmax), false, false); pmax = fmaxf(__uint_as_float(rr[0]), __uint_as_float(rr[1])); } \
            pmax += addc; \
            float mn, alpha; \
            if (__all(pmax - m_reg <= THR_L2)) { mn = m_reg; alpha = 1.f; } \
            else { mn = fmaxf(m_reg, pmax); alpha = __builtin_amdgcn_exp2f(m_reg - mn); m_reg = mn; } \
            const float offc = addc - mn; \
            _Pragma("unroll") for (int r = 0; r < 16; ++r) { p0[r] = __builtin_amdgcn_exp2f(p0[r] + offc); p1[r] = __builtin_amdgcn_exp2f(p1[r] + offc); } \
            float ps = 0.f; \
            _Pragma("unroll") for (int r = 0; r < 16; ++r) ps += p0[r]; \
            _Pragma("unroll") for (int r = 0; r < 16; ++r) ps += p1[r]; \
            { auto rr = __builtin_amdgcn_permlane32_swap(__float_as_uint(ps), __float_as_uint(ps), false, false); ps = __uint_as_float(rr[0]) + __uint_as_float(rr[1]); } \
            l_reg = l_reg * alpha + ps; \
            bf16x8 pa0, pa1, pa2, pa3; \
            PK4(p0, 0, pa0); PK4(p0, 8, pa1); PK4(p1, 0, pa2); PK4(p1, 8, pa3); \
            if (__any(alpha < 1.f)) { if (hi == 0) al_l[r32] = alpha; asm volatile("s_waitcnt lgkmcnt(0)" ::: "memory"); \
                _Pragma("unroll") for (int d_ = 0; d_ < 4; ++d_) _Pragma("unroll") for (int r = 0; r < 16; ++r) o[d_][r] *= al_l[crow(r, hi)]; } \
            pv_tile<BUF>(o, vb0, pa0, pa1, pa2, pa3); \
        } \
        if ((t) + 1 < NT) { asm volatile("s_waitcnt vmcnt(0)" ::: "memory"); SWRITE((BUF) ^ 1); } \
        conv_consume(CS, cvs_b, lane); conv_issue(J, CS, cvs_b, lane); \
        __syncthreads(); } while (0)
#define PK4(P, B_, OUT) do { const unsigned a0 = cvt_pk_bf16(P[B_ + 0], P[B_ + 1]), a1 = cvt_pk_bf16(P[B_ + 2], P[B_ + 3]), b0 = cvt_pk_bf16(P[B_ + 4], P[B_ + 5]), b1 = cvt_pk_bf16(P[B_ + 6], P[B_ + 7]); \
        auto r0 = __builtin_amdgcn_permlane32_swap(a0, b0, false, false); auto r1 = __builtin_amdgcn_permlane32_swap(a1, b1, false, false); \
        u32x4 w_ = {r0[0], r1[0], r0[1], r1[1]}; OUT = *reinterpret_cast<bf16x8*>(&w_); } while (0)
    for (int t = 0; t < NT; t += 2) { TILE(t, 0); TILE(t + 1, 1); }
#undef TILE
#undef PK4
#undef SLOAD
#undef SWRITE
    if (hi == 0) li_l[r32] = l_reg;
    asm volatile("s_waitcnt lgkmcnt(0)" ::: "memory");
    const unsigned ob = (unsigned)((wid * 32 + 4 * hi) * D + r32) * 2u;
#pragma unroll
    for (int r = 0; r < 16; ++r) { const int orow = crow(r, hi); const float rl = __builtin_amdgcn_rcpf(li_l[orow]);
#pragma unroll
        for (int d0 = 0; d0 < 4; ++d0) { const float v = o[d0][r] * rl; const float vn = __shfl_xor(v, 1);
            if ((r32 & 1) == 0) *(unsigned*)((char*)Oq + (ob + (unsigned)(((r & 3) + 8 * (r >> 2)) * D * 2 + d0 * 64))) = cvt_pk_bf16(v, vn); } }
    __syncthreads();
}
#undef KSWZ
}
__device__ __forceinline__ void ph_attn(const Ctx& c, const float* wg, const float* wu, const float* wd, int Lb) {
    const bf16_t* Qb = (const bf16_t*)(c.ws + WS_Q); const bf16_t* Kb = (const bf16_t*)(c.ws + WS_K); const bf16_t* Vb = (const bf16_t*)(c.ws + WS_V);
    const unsigned* sel = (const unsigned*)(c.ws + WS_SEL); const float* bt = (const float*)(c.ws + WS_BIAS); bf16_t* O = (bf16_t*)(c.ws + WS_O);
    const ConvJob J{wg, wu, wd, (unsigned char*)(c.ws + WS_WGU), (unsigned char*)(c.ws + WS_WD), Lb, c.G * 8};
    ConvState CS{c.vcu * 8 + c.wave, 0, false, nullptr, 0.f};
    for (int u = c.vcu; u < NB * NH * (NBLK / 2); u += c.G) {
        const int bh = u / (NBLK / 2), pi = u % (NBLK / 2), b = bh / NH, h = bh % NH;
#pragma unroll 1
        for (int pass = 0; pass < 2; ++pass) { const int qb = pass == 0 ? NBLK - 1 - pi : pi;
            att::unit((LAS char*)c.lds, Qb + (size_t)bh * T * HD, Kb + (size_t)bh * T * HD, Vb + (size_t)bh * T * HD, sel + (size_t)bh * T, bt + h * BIAS_W,
                      O + ((size_t)(b * T + qb * 256)) * D + h * HD, qb, c.tid, J, CS); }
    }
    { const unsigned cvs_b = (unsigned)(size_t)(c.lds + att::OFF_CV) + (unsigned)c.wave * 8448u;
      while (CS.pend || CS.cj < CONV_ITEMS) { conv_consume(CS, cvs_b, c.lane); conv_issue(J, CS, cvs_b, c.lane); } }
}
#endif

__device__ __forceinline__ void ph_conv(const Ctx& c, const float* cw, const float* cb) {
    const bf16_t* R = (const bf16_t*)(c.ws + WS_R); bf16_t* RC = (bf16_t*)(c.ws + WS_RC);
    for (int i = c.vcu * 512 + c.tid; i < NTOK * (D / 8); i += c.G * 512) {
        const int n = i >> 7, c8 = (i & 127) * 8, t = n & (T - 1);
        float a[8];
#pragma unroll
        for (int j = 0; j < 8; ++j) a[j] = cb[c8 + j];
#pragma unroll
        for (int k = 0; k < 4; ++k) { const int tt = t - 3 + k; if (tt < 0) continue;
            const u32x4 w = *(const u32x4*)(R + (size_t)(n - 3 + k) * D + c8); const f32x4 w0 = *(const f32x4*)(cw + k * D + c8), w1 = *(const f32x4*)(cw + k * D + c8 + 4);
            a[0] += w0[0] * bf_lo(w.x); a[1] += w0[1] * bf_hi(w.x); a[2] += w0[2] * bf_lo(w.y); a[3] += w0[3] * bf_hi(w.y);
            a[4] += w1[0] * bf_lo(w.z); a[5] += w1[1] * bf_hi(w.z); a[6] += w1[2] * bf_lo(w.w); a[7] += w1[3] * bf_hi(w.w); }
        u32x4 o; o.x = cvt_pk_bf16(a[0], a[1]); o.y = cvt_pk_bf16(a[2], a[3]); o.z = cvt_pk_bf16(a[4], a[5]); o.w = cvt_pk_bf16(a[6], a[7]);
        *(u32x4*)(RC + (size_t)n * D + c8) = o;
    }
}
__device__ __forceinline__ void ph_scan(const Ctx& c) {
    const float* Aa = (const float*)(c.ws + WS_AA); const float* Uu = (const float*)(c.ws + WS_UU); const bf16_t* Y = (const bf16_t*)(c.ws + WS_YBR); bf16_t* Gq = (bf16_t*)(c.ws + WS_G);
    LAS float* cA = (LAS float*)c.lds; LAS float* cH = cA + 512;
    for (int u = c.vcu; u < NB * (D / 16); u += c.G) {
        const int b = u / (D / 16), cg = u % (D / 16), ch = c.wave * 4 + (c.lane >> 4), col = cg * 16 + (c.lane & 15);
        const size_t base = ((size_t)b * T + ch * 128) * D + col;
        float A = 1.f, H = 0.f;
#pragma unroll 8
        for (int s = 0; s < 128; ++s) { const float a = Aa[base + (size_t)s * D], x = Uu[base + (size_t)s * D]; A *= a; H = a * H + x; }
        __syncthreads();
        cA[ch * 16 + (c.lane & 15)] = A; cH[ch * 16 + (c.lane & 15)] = H;
        __syncthreads();
        float h = 0.f;
        for (int p = 0; p < ch; ++p) h = cA[p * 16 + (c.lane & 15)] * h + cH[p * 16 + (c.lane & 15)];
#pragma unroll 8
        for (int s = 0; s < 128; ++s) { const float a = Aa[base + (size_t)s * D], x = Uu[base + (size_t)s * D]; h = a * h + x;
            const float y = __uint_as_float(((unsigned)Y[base + (size_t)s * D]) << 16); const float gv = h * y;
            unsigned r = __float_as_uint(gv); r += 0x7fffu + ((r >> 16) & 1u); Gq[base + (size_t)s * D] = (bf16_t)(r >> 16); }
    }
}

__device__ __forceinline__ void ln_affine(f32x4 (&v)[4], const float* g, const float* bta, int lane) {
    float s = 0.f;
#pragma unroll
    for (int j = 0; j < 4; ++j) s += (v[j][0] + v[j][1]) + (v[j][2] + v[j][3]);
    const float mean = wave_sum(s) * (1.0f / D); float s2 = 0.f;
#pragma unroll
    for (int j = 0; j < 4; ++j) { v[j] = v[j] - mean; s2 += (v[j][0] * v[j][0] + v[j][1] * v[j][1]) + (v[j][2] * v[j][2] + v[j][3] * v[j][3]); }
    const float rstd = 1.0f / sqrtf(wave_sum(s2) * (1.0f / D) + LN_EPS);
#pragma unroll
    for (int j = 0; j < 4; ++j) { const f32x4 gg = *(const f32x4*)(g + 4 * lane + 256 * j), bb = *(const f32x4*)(bta + 4 * lane + 256 * j); v[j] = v[j] * rstd * gg + bb; }
}
__device__ __forceinline__ void store_row(const f32x4 (&v)[4], float* xf, bf16_t* xb, int lane) {
#pragma unroll
    for (int j = 0; j < 4; ++j) { *(f32x4*)(xf + 4 * lane + 256 * j) = v[j]; u32x2 w; w.x = cvt_pk_bf16(v[j][0], v[j][1]); w.y = cvt_pk_bf16(v[j][2], v[j][3]); *(u32x2*)(xb + 4 * lane + 256 * j) = w; }
}

__device__ __forceinline__ void ph_lnr(const Ctx& c, int layer, const float* g, const float* bta, const float* wr, const float* br) {
    const bf16_t* Z = (const bf16_t*)(c.ws + WS_Z); bf16_t* XB = (bf16_t*)(c.ws + WS_XB); unsigned char* XB8 = (unsigned char*)(c.ws + WS_XB8);
    int* tope = (int*)(c.ws + WS_TOPE); int* tops = (int*)(c.ws + WS_TOPS); float* topg = (float*)(c.ws + WS_TOPG);
    int* list = (int*)(c.ws + WS_LIST) + (size_t)layer * NE * NTOK; unsigned* cntw = (unsigned*)(c.ws + WS_CTL) + CW_CNT + layer * 64;
    LAS float* wl = (LAS float*)c.lds;
    LAS int* be = (LAS int*)(c.lds + LNR_OFF); LAS int* brk = be + 256; LAS int* bbase = brk + 256; LAS int* bcnt = bbase + 32;
    const int lane = c.lane;
    __syncthreads();
    for (int idx = c.tid; idx < D * 8; idx += 512) { const int d = idx >> 3, e4 = idx & 7; const int slot = ((d & 255) >> 2) + 64 * ((d >> 8) * 4 + (d & 3));
        *(LAS f32x4*)(wl + slot * 36 + e4 * 4) = *(const f32x4*)(wr + d * NE + e4 * 4); }
    __syncthreads();
    for (int tile = c.vcu; tile < NTOK / 64; tile += c.G) {
        for (int i = 0; i < 8; ++i) {
            const int rit = c.wave * 8 + i, n = tile * 64 + rit;
            f32x4 v[4];
#pragma unroll
            for (int j = 0; j < 4; ++j) { const u32x2 zw = *(const u32x2*)(Z + (size_t)n * D + 4 * lane + 256 * j); v[j] = (f32x4){bf_lo(zw.x), bf_hi(zw.x), bf_lo(zw.y), bf_hi(zw.y)}; }
            ln_affine(v, g, bta, lane);
#pragma unroll
            for (int j = 0; j < 4; ++j) { { u32x2 wb; wb.x = cvt_pk_bf16(v[j][0], v[j][1]); wb.y = cvt_pk_bf16(v[j][2], v[j][3]); *(u32x2*)(XB + (size_t)n * D + 4 * lane + 256 * j) = wb; } int w = 0; w = __builtin_amdgcn_cvt_pk_fp8_f32(v[j][0] * XS8, v[j][1] * XS8, w, false); w = __builtin_amdgcn_cvt_pk_fp8_f32(v[j][2] * XS8, v[j][3] * XS8, w, true);
                *(int*)(XB8 + (size_t)n * D + 4 * lane + 256 * j) = w; }
            float acc[32];
#pragma unroll
            for (int e = 0; e < 32; ++e) acc[e] = 0.f;
#pragma unroll
            for (int j = 0; j < 4; ++j)
#pragma unroll
                for (int q = 0; q < 4; ++q) { const float xv = v[j][q]; const LAS f32x4* wp = (const LAS f32x4*)(wl + (lane + 64 * (4 * j + q)) * 36);
#pragma unroll
                    for (int e4 = 0; e4 < 8; ++e4) { const f32x4 w = wp[e4]; acc[4 * e4] += xv * w[0]; acc[4 * e4 + 1] += xv * w[1]; acc[4 * e4 + 2] += xv * w[2]; acc[4 * e4 + 3] += xv * w[3]; } }
            float a1[16], a2[8], a3[4], a4[2], a5;
#pragma unroll
            for (int k = 0; k < 16; ++k) { const bool hi = lane & 1; const float keep = hi ? acc[2 * k + 1] : acc[2 * k], send = hi ? acc[2 * k] : acc[2 * k + 1]; a1[k] = keep + __shfl_xor(send, 1); }
#pragma unroll
            for (int k = 0; k < 8; ++k) { const bool hi = lane & 2; const float keep = hi ? a1[2 * k + 1] : a1[2 * k], send = hi ? a1[2 * k] : a1[2 * k + 1]; a2[k] = keep + __shfl_xor(send, 2); }
#pragma unroll
            for (int k = 0; k < 4; ++k) { const bool hi = lane & 4; const float keep = hi ? a2[2 * k + 1] : a2[2 * k], send = hi ? a2[2 * k] : a2[2 * k + 1]; a3[k] = keep + __shfl_xor(send, 4); }
#pragma unroll
            for (int k = 0; k < 2; ++k) { const bool hi = lane & 8; const float keep = hi ? a3[2 * k + 1] : a3[2 * k], send = hi ? a3[2 * k] : a3[2 * k + 1]; a4[k] = keep + __shfl_xor(send, 8); }
            { const bool hi = lane & 16; const float keep = hi ? a4[1] : a4[0], send = hi ? a4[0] : a4[1]; a5 = keep + __shfl_xor(send, 16); }
            float val = a5 + __shfl_xor(a5, 32) + br[lane & 31];
            float tv[4]; int te[4];
#pragma unroll
            for (int k = 0; k < 4; ++k) { const float m = wave_max(val); const unsigned long long bal = __ballot(val == m); const int idx = __ffsll((long long)bal) - 1; tv[k] = m; te[k] = idx & 31; if ((lane & 31) == (idx & 31)) val = -__builtin_inff(); }
            const float e1 = __expf(tv[1] - tv[0]), e2 = __expf(tv[2] - tv[0]), e3 = __expf(tv[3] - tv[0]), inv = 1.0f / (1.0f + e1 + e2 + e3);
            if (lane == 0) { be[rit * 4 + 0] = te[0]; be[rit * 4 + 1] = te[1]; be[rit * 4 + 2] = te[2]; be[rit * 4 + 3] = te[3];
                *(f32x4*)(topg + (size_t)n * 4) = (f32x4){inv, e1 * inv, e2 * inv, e3 * inv}; }
        }
        __syncthreads();
        if (c.tid < NE) { int cnt = 0; for (int i = 0; i < 256; ++i) { if (be[i] == c.tid) { brk[i] = cnt; ++cnt; } }
            bcnt[c.tid] = cnt; bbase[c.tid] = cnt ? (int)__hip_atomic_fetch_add(cntw + c.tid, (unsigned)cnt, RLX_AGENT) : 0; }
        __syncthreads();
        if (c.tid < 256) { const int e = be[c.tid], slot = bbase[e] + brk[c.tid], n = tile * 64 + (c.tid >> 2);
            list[(size_t)e * NTOK + slot] = n; tope[(size_t)n * 4 + (c.tid & 3)] = e; tops[(size_t)n * 4 + (c.tid & 3)] = slot; }
        __syncthreads();
    }
}

__device__ __forceinline__ void ph_comb(const Ctx& c, int layer, float* xout, const float* g, const float* bta, const float* bd) {
    bf16_t* XB = (bf16_t*)(c.ws + WS_XB); const bf16_t* YB = (const bf16_t*)(c.ws + WS_YB);
    const int* tope = (const int*)(c.ws + WS_TOPE); const int* tops = (const int*)(c.ws + WS_TOPS); const float* topg = (const float*)(c.ws + WS_TOPG);
    (void)moe_tables(c.lds, (const unsigned*)(c.ws + WS_CTL) + CW_CNT + layer * 64, c.tid);
    const int gw = c.vcu * 8 + c.wave, NGW = c.G * 8, lane = c.lane;
    for (int n = gw; n < NTOK; n += NGW) {
        f32x4 v[4];
#pragma unroll
        for (int j = 0; j < 4; ++j) { const u32x2 xw = *(const u32x2*)(XB + (size_t)n * D + 4 * lane + 256 * j); v[j] = (f32x4){bf_lo(xw.x), bf_hi(xw.x), bf_lo(xw.y), bf_hi(xw.y)} * ALPHA; }
#pragma unroll
        for (int k = 0; k < 4; ++k) { const int e = tope[(size_t)n * 4 + k], slot = tops[(size_t)n * 4 + k]; const float gt = topg[(size_t)n * 4 + k];
            const size_t row = ((size_t)MOE_MTBASE(c.lds)[e] << 8) + slot;
#pragma unroll
            for (int j = 0; j < 4; ++j) { const u32x2 w = *(const u32x2*)(YB + row * D + 4 * lane + 256 * j); const f32x4 bb = *(const f32x4*)(bd + (size_t)e * D + 4 * lane + 256 * j);
                v[j][0] += gt * (bf_lo(w.x) + bb[0]); v[j][1] += gt * (bf_hi(w.x) + bb[1]); v[j][2] += gt * (bf_lo(w.y) + bb[2]); v[j][3] += gt * (bf_hi(w.y) + bb[3]); } }
        ln_affine(v, g, bta, lane);
        if (xout) {
#pragma unroll
            for (int j = 0; j < 4; ++j) *(f32x4*)(xout + (size_t)n * D + 4 * lane + 256 * j) = v[j]; }
        else {
#pragma unroll
            for (int j = 0; j < 4; ++j) { u32x2 w; w.x = cvt_pk_bf16(v[j][0], v[j][1]); w.y = cvt_pk_bf16(v[j][2], v[j][3]); *(u32x2*)(XB + (size_t)n * D + 4 * lane + 256 * j) = w; } }
    }
}

constexpr int PH_PER_LAYER = 9, N_PHASES = 1 + DEPTH * PH_PER_LAYER;

__global__ void __launch_bounds__(512, 2) mk_fwd(Args args) {
    extern __shared__ __attribute__((aligned(16))) unsigned char lds_raw[];
    Ctx c0;
    c0.ws = args.ws; c0.lds = (LAS unsigned char*)lds_raw;
    c0.tid = threadIdx.x; c0.lane = c0.tid & 63; c0.wave = __builtin_amdgcn_readfirstlane(c0.tid >> 6);
    c0.G = gridDim.x; c0.bx = blockIdx.x; { const int bx = blockIdx.x; c0.vcu = (c0.G % 8 == 0) ? (bx % 8) * (c0.G / 8) + bx / 8 : bx; }
    volatile LAS unsigned* MISC = (volatile LAS unsigned*)(c0.lds + MISC_OFF);
    if (c0.tid < 64) MISC[c0.tid] = 0u;
    __syncthreads();
    unsigned* ctl = (unsigned*)(c0.ws + WS_CTL);
#if MK_PER_PHASE
#define GRID_BAR() do { } while (0)
#else
    XcdBarrier bar = xcd_barrier_post(ctl + CW_BAR, MISC + 8);
#define GRID_BAR() xcd_barrier(bar)
#endif
    const int lo = args.ph_lo, hi = args.ph_hi;
#ifndef PMASK
#define PMASK 0xFFFF
#endif
#define EN(b) ((PMASK >> (b)) & 1)
#ifndef REPMASK
#define REPMASK 0
#endif
#define REPS(b) (1 + ((REPMASK >> (b)) & 1))
#define IN(k) (lo <= (k) && (k) < hi)
#define SEAM(k) do { if (IN(k) && IN((k) + 1)) GRID_BAR(); } while (0)
#define INP(i) (args.in[opaque_i(i)] + (size_t)(unsigned)opaque_i(0))
#define WSP() Ctx c = c0; c.ws = c0.ws + (size_t)(unsigned)opaque_i(0); c.tid = opaque_v(c0.tid); c.lane = c.tid & 63; c.wave = __builtin_amdgcn_readfirstlane(c.tid >> 6); c.G = opaque_i(c0.G); c.vcu = opaque_i(c0.vcu); c.bx = opaque_i(c0.bx); unsigned char* ws = c.ws

    if (EN(15) && IN(0)) for (int rep_ = 0; rep_ < REPS(15); ++rep_) { WSP(); (void)ws; ph_prologue(c, args); } SEAM(0);

#define LAYER(L_) do { \
        constexpr int L = L_; constexpr int p0 = 1 + L * PH_PER_LAYER, jm = L >> 1; \
        if constexpr ((L & 1) == 0) { \
            if (EN(0) && IN(p0 + 0)) for (int rep_ = 0; rep_ < REPS(0); ++rep_) { WSP(); SchedDense S; S.o.init(NTOK, 3 * D, c.G, c.bx); S.lda = D * 2; S.kb = D * 2; \
                const pg8::Gemm g{(const char*)(ws + WS_XB), (const char*)(ws + WS_WQKV) + (size_t)jm * 3 * D * D * 2, nullptr, D * 2, D * 2}; \
                EpiQKV E{(bf16_t*)(ws + WS_Q)}; \
                pg8::gemm_phase<EpiQKV, SchedDense, false>(c.lds, g, S, E, c.tid); } SEAM(p0 + 0); \
            if (EN(1) && IN(p0 + 1)) for (int rep_ = 0; rep_ < REPS(1); ++rep_) { WSP(); (void)ws; ph_kmean(c); } SEAM(p0 + 1); \
            if (EN(2) && IN(p0 + 2)) for (int rep_ = 0; rep_ < REPS(2); ++rep_) { WSP(); (void)ws; ph_select(c); } SEAM(p0 + 2); \
            if (EN(3) && IN(p0 + 3)) for (int rep_ = 0; rep_ < REPS(3); ++rep_) { WSP(); (void)ws; ph_attn(c, INP(15), INP(17), INP(19), L); } SEAM(p0 + 3); \
            if (EN(4) && IN(p0 + 4)) for (int rep_ = 0; rep_ < REPS(4); ++rep_) { WSP(); SchedDense S; S.o.init(NTOK, D, c.G, c.bx); S.lda = D * 2; S.kb = D * 2; \
                const pg8::Gemm g{(const char*)(ws + WS_O), (const char*)(ws + WS_WO) + (size_t)jm * D * D * 2, nullptr, D * 2, D * 2}; \
                EpiResid E{(const bf16_t*)(ws + WS_XB), (bf16_t*)(ws + WS_Z), 1.0f}; \
                pg8::gemm_phase<EpiResid, SchedDense, false>(c.lds, g, S, E, c.tid); } SEAM(p0 + 4); \
        } else { \
            if (EN(5) && IN(p0 + 0)) for (int rep_ = 0; rep_ < REPS(5); ++rep_) { WSP(); SchedDense S; S.o.init(NTOK, 2 * D, c.G, c.bx); S.lda = D * 2; S.kb = D * 2; \
                const pg8::Gemm g{(const char*)(ws + WS_XB), (const char*)(ws + WS_WIN) + (size_t)jm * 2 * D * D * 2, nullptr, D * 2, D * 2}; \
                EpiLin E{(bf16_t*)(ws + WS_YBR), (bf16_t*)(ws + WS_R)}; \
                pg8::gemm_phase<EpiLin, SchedDense, false>(c.lds, g, S, E, c.tid); } SEAM(p0 + 0); \
            if (EN(6) && IN(p0 + 1)) for (int rep_ = 0; rep_ < REPS(6); ++rep_) { WSP(); (void)ws; ph_conv(c, INP(5) + (size_t)jm * 4 * D, INP(6) + (size_t)jm * D); } SEAM(p0 + 1); \
            if (EN(7) && IN(p0 + 2)) for (int rep_ = 0; rep_ < REPS(7); ++rep_) { WSP(); SchedGates S; S.o.init(NTOK, 2 * D, c.G, c.bx); \
                const pg8::Gemm g{(const char*)(ws + WS_RC), (const char*)(ws + WS_WG) + (size_t)jm * 4 * 512 * 256 * 2, nullptr, D * 2, opaque_i(512)}; \
                EpiGates E{(const bf16_t*)(ws + WS_RC), INP(8) + (size_t)jm * D, INP(10) + (size_t)jm * D, (const float*)(ws + WS_SPT) + (size_t)jm * D, (float*)(ws + WS_AA), (float*)(ws + WS_UU)}; \
                pg8::gemm_phase<EpiGates, SchedGates, false>(c.lds, g, S, E, c.tid); } SEAM(p0 + 2); \
            if (EN(8) && IN(p0 + 3)) for (int rep_ = 0; rep_ < REPS(8); ++rep_) { WSP(); (void)ws; ph_scan(c); } SEAM(p0 + 3); \
            if (EN(9) && IN(p0 + 4)) for (int rep_ = 0; rep_ < REPS(9); ++rep_) { WSP(); SchedDense S; S.o.init(NTOK, D, c.G, c.bx); S.lda = D * 2; S.kb = D * 2; \
                const pg8::Gemm g{(const char*)(ws + WS_G), (const char*)(ws + WS_WOUT) + (size_t)jm * D * D * 2, nullptr, D * 2, D * 2}; \
                EpiResid E{(const bf16_t*)(ws + WS_XB), (bf16_t*)(ws + WS_Z), 1.0f}; \
                pg8::gemm_phase<EpiResid, SchedDense, false>(c.lds, g, S, E, c.tid); } SEAM(p0 + 4); \
        } \
        if (EN(10) && IN(p0 + 5)) for (int rep_ = 0; rep_ < REPS(10); ++rep_) { WSP(); (void)ws; ph_lnr(c, L, INP(21) + L * D, INP(22) + L * D, INP(13) + (size_t)L * D * NE, INP(14) + L * NE); } SEAM(p0 + 5); \
        if (EN(11) && IN(p0 + 6)) for (int rep_ = 0; rep_ < REPS(11); ++rep_) { WSP(); const int total = moe_tables(c.lds, (unsigned*)(ws + WS_CTL) + CW_CNT + L * 64, c.tid); \
            SchedMoe S{c.lds, total, 8, c.G, c.vcu, (unsigned)(2 * D * D), (unsigned)D, true}; \
            const pg8::Gemm g{(const char*)(ws + WS_XB8), (const char*)(ws + WS_WGU) + (size_t)L * NE * 2 * D * D, (const int*)(ws + WS_LIST) + (size_t)L * NE * NTOK, D, opaque_i(D)}; \
            EpiSwiglu E{INP(16) + (size_t)L * NE * D, INP(18) + (size_t)L * NE * D, (unsigned char*)(ws + WS_HB)}; \
            pg8::gemm_phase<EpiSwiglu, SchedMoe, true, true>(c.lds, g, S, E, c.tid); } SEAM(p0 + 6); \
        if (EN(12) && IN(p0 + 7)) for (int rep_ = 0; rep_ < REPS(12); ++rep_) { WSP(); const int total = moe_tables(c.lds, (unsigned*)(ws + WS_CTL) + CW_CNT + L * 64, c.tid); \
            SchedMoe S{c.lds, total, 4, c.G, c.vcu, (unsigned)(D * D), (unsigned)D, false}; \
            const pg8::Gemm g{(const char*)(ws + WS_HB), (const char*)(ws + WS_WD) + (size_t)L * NE * D * D, nullptr, D, opaque_i(D)}; \
            EpiPlain E{(bf16_t*)(ws + WS_YB), 1.0f / (HS8 * WS8_D)}; \
            pg8::gemm_phase<EpiPlain, SchedMoe, false, true>(c.lds, g, S, E, c.tid); } SEAM(p0 + 7); \
        if (EN(13) && IN(p0 + 8)) for (int rep_ = 0; rep_ < REPS(13); ++rep_) { WSP(); ph_comb(c, L, (L == DEPTH - 1) ? args.out : (float*)nullptr, INP(23) + L * D, INP(24) + L * D, INP(20) + (size_t)L * NE * D); } SEAM(p0 + 8); \
    } while (0)
    LAYER(0); LAYER(1); LAYER(2); LAYER(3);
#undef IN
#undef SEAM
}

extern "C" void kernel_launch(void* const* d_in, const int* in_sizes, int n_in, void* d_out, int out_size, void* d_ws, size_t ws_size, hipStream_t stream) {
    static int grid = 0;
    if (grid == 0) {
        if (n_in != 25 || out_size != NTOK * D || ws_size < WS_END) { fprintf(stderr, "kernel_launch: unexpected shapes (n_in %d out %d ws %zu)\n", n_in, out_size, ws_size); grid = -1; return; }
        int dev = 0, cus = 0;
        if (hipGetDevice(&dev) != hipSuccess || hipDeviceGetAttribute(&cus, hipDeviceAttributeMultiprocessorCount, dev) != hipSuccess) { grid = -1; return; }
        if (hipFuncSetAttribute((const void*)mk_fwd, hipFuncAttributeMaxDynamicSharedMemorySize, LDS_BYTES) != hipSuccess) { fprintf(stderr, "kernel_launch: hipFuncSetAttribute failed\n"); grid = -1; return; }
        int per_cu = 0;
        if (hipOccupancyMaxActiveBlocksPerMultiprocessor(&per_cu, (const void*)mk_fwd, 512, LDS_BYTES) != hipSuccess || per_cu < 1) fprintf(stderr, "kernel_launch: occupancy query says %d\n", per_cu);
        (void)hipGetLastError();
        grid = cus;
    }
    if (grid < 0) return;
    (void)hipMemsetAsync((char*)d_ws + WS_CTL, 0, CTL_BYTES, stream);
    Args a{};
    for (int i = 0; i < 25; ++i) a.in[i] = (const float*)d_in[i];
    a.out = (float*)d_out; a.ws = (unsigned char*)d_ws;
#if MK_PER_PHASE
    for (int p = 0; p < N_PHASES; ++p) {
        const int L = (p - 1) / PH_PER_LAYER, k = (p - 1) % PH_PER_LAYER; (void)L; (void)k;
        a.ph_lo = p; a.ph_hi = p + 1;
        hipLaunchKernelGGL(mk_fwd, dim3(grid), dim3(512), LDS_BYTES, stream, a);
    }
#else
    a.ph_lo = 0; a.ph_hi = N_PHASES;
    hipLaunchKernelGGL(mk_fwd, dim3(grid), dim3(512), LDS_BYTES, stream, a);
#endif
}
```

```cpp
#include <hip/hip_runtime.h>
#include <cstdio>
#include <cstdint>

#ifndef MK_PER_PHASE
#define MK_PER_PHASE 0
#endif
#ifndef NAIVE_GEMM
#define NAIVE_GEMM 0
#endif
#ifndef NAIVE_ATTN
#define NAIVE_ATTN 0
#endif

#define GAS __attribute__((address_space(1)))
#define LAS __attribute__((address_space(3)))
typedef unsigned short bf16_t;
typedef short bf16x8 __attribute__((ext_vector_type(8)));
typedef float f32x4 __attribute__((ext_vector_type(4)));
typedef float f32x2 __attribute__((ext_vector_type(2)));
typedef unsigned u32x4 __attribute__((ext_vector_type(4)));
typedef unsigned u32x2 __attribute__((ext_vector_type(2)));

constexpr int NB = 4, T = 4096, D = 1024, NTOK = NB * T, NH = 8, HD = 128, MBLK = 256, NBLK = T / MBLK, NE = 32, TOPK = 4, DEPTH = 4;
constexpr float ALPHA = 1.6817928305074290f;
constexpr float LOG2E = 1.4426950408889634f;
constexpr float QSCALE = 0.08838834764831845f * LOG2E;
constexpr float LN_EPS = 1e-5f;
constexpr int MAXMT = NTOK * TOPK / 256 + NE;
constexpr float XS8 = 8.0f, HS8 = 4.0f, WS8_GU = 32.0f, WS8_D = 64.0f, OS8 = 64.0f, GS8 = 16.0f, WS8_QKV = 32.0f, WS8_O = 64.0f, WS8_IN = 32.0f, WS8_OUT = 64.0f;
constexpr int BIAS_W = 704;

constexpr size_t MiB = 1u << 20;
constexpr size_t WS_CTL = 0, CTL_BYTES = 1 * MiB;
constexpr size_t WS_BIAS = 1 * MiB;
constexpr size_t WS_SPT = 1 * MiB + 64 * 1024;
constexpr size_t WS_KMEAN = 1 * MiB + 256 * 1024;
constexpr size_t WS_SEL = 2 * MiB;
constexpr size_t WS_TOPE = 3 * MiB, WS_TOPS = 3 * MiB + 256 * 1024, WS_TOPG = 3 * MiB + 512 * 1024;
constexpr size_t WS_LIST = 4 * MiB;
constexpr size_t WS_WQKV = 16 * MiB, WS_WO = 28 * MiB, WS_WIN = 32 * MiB, WS_WG = 40 * MiB, WS_WOUT = 42 * MiB;
constexpr size_t WS_XB = 48 * MiB, WS_XF = 80 * MiB, WS_Z = 144 * MiB, WS_Q = 208 * MiB, WS_K = 240 * MiB, WS_V = 272 * MiB, WS_O = 304 * MiB;
constexpr size_t WS_YBR = 336 * MiB, WS_R = 368 * MiB, WS_RC = 400 * MiB, WS_AA = 432 * MiB, WS_UU = 496 * MiB, WS_G = 560 * MiB;
constexpr size_t WS_XB8 = 1648 * MiB;
constexpr size_t WS_HB = 592 * MiB, WS_YB = 736 * MiB, WS_WGU = 880 * MiB, WS_WD = 1392 * MiB, WS_END = 1664 * MiB;
constexpr int CW_TMO = 0, CW_BAR = 4096, CW_CNT = 8192;

constexpr int LDS_BYTES = 153600;
constexpr int RING_BYTES = 131072;
constexpr int MOE_OFF = RING_BYTES;
constexpr int LNR_OFF = 147456;
constexpr int MISC_OFF = LDS_BYTES - 256;

#define RLX_AGENT __ATOMIC_RELAXED, __HIP_MEMORY_SCOPE_AGENT
__device__ __forceinline__ unsigned cvt_pk_bf16(float lo, float hi) { unsigned r; asm volatile("v_cvt_pk_bf16_f32 %0, %1, %2" : "=v"(r) : "v"(lo), "v"(hi)); return r; }
__device__ __forceinline__ float bf_lo(unsigned w) { return __uint_as_float(w << 16); }
__device__ __forceinline__ float bf_hi(unsigned w) { return __uint_as_float(w & 0xffff0000u); }
__device__ __forceinline__ float wave_sum(float v) {
#pragma unroll
    for (int o = 1; o < 64; o <<= 1) v += __shfl_xor(v, o);
    return v;
}
__device__ __forceinline__ float wave_max(float v) {
#pragma unroll
    for (int o = 1; o < 64; o <<= 1) v = fmaxf(v, __shfl_xor(v, o));
    return v;
}
__device__ __forceinline__ int opaque_i(int v) { asm volatile("" : "+s"(v)); return v; }
__device__ __forceinline__ int opaque_v(int v) { asm volatile("" : "+v"(v)); return v; }
template <class P> __device__ __forceinline__ P* opaque_p(P* p) { asm volatile("" : "+s"(p)); return p; }
__device__ __forceinline__ int lane_id_asm() { int l; asm volatile("v_mbcnt_lo_u32_b32 %0, -1, 0\n\tv_mbcnt_hi_u32_b32 %0, -1, %0" : "=v"(l)); return l; }
__device__ __forceinline__ float sigmoidf_(float x) { return __builtin_amdgcn_rcpf(1.0f + __builtin_amdgcn_exp2f(-1.4426950408889634f * x)); }

#define XB_TMO      128
#define XB_XCNT(j)  (256  + 64 * (j))
#define XB_XSUB(j)  (1280 + 64 * (j))
#define XB_XGEN(j)  (2304 + 64 * (j))
#define XB_TOP      3328
#define XB_TOPGEN   3392
#define XCD_BAR_WORDS 3456
#define XB_SPIN_CAP (1u << 22)
__device__ __forceinline__ unsigned xb_ld(unsigned* p)              { return __hip_atomic_load(p, __ATOMIC_RELAXED, __HIP_MEMORY_SCOPE_AGENT); }
__device__ __forceinline__ unsigned xb_add(unsigned* p, unsigned v) { return __hip_atomic_fetch_add(p, v, __ATOMIC_RELAXED, __HIP_MEMORY_SCOPE_AGENT); }
__device__ __forceinline__ unsigned xb_xcc_id() { return (unsigned)__builtin_amdgcn_s_getreg((3 << 11) | 20) & 0xFu; }
#define XB_SPIN(cond, bar) do { unsigned _sp = 0; while (cond) { __builtin_amdgcn_s_sleep(1); \
    if ((++_sp & 255u) == 0u) { if (xb_ld(&(bar)[XB_TMO])) break; if (_sp > XB_SPIN_CAP) { atomicAdd(&(bar)[XB_TMO], 1u); break; } } } } while (0)
struct XcdBarrier { unsigned* bar; unsigned x; volatile LAS unsigned* st; };
__device__ __forceinline__ XcdBarrier xcd_barrier_post(unsigned* bar, volatile LAS unsigned* st) {
    XcdBarrier b; b.bar = bar; b.x = xb_xcc_id(); b.st = st;
    if (threadIdx.x == 0) (void)xb_add(&bar[XB_XCNT(b.x)], 1u);
    return b;
}
__device__ __forceinline__ void xcd_barrier_complete(unsigned* bar, unsigned x, unsigned& nloc, unsigned& nx) {
    const unsigned G = gridDim.x * gridDim.y * gridDim.z;
    unsigned sum, cnt, mine, sp = 0u;
    for (;;) {
        sum = 0u; cnt = 0u; mine = 0u;
#pragma unroll
        for (unsigned j = 0; j < 16; ++j) { const unsigned c = xb_ld(&bar[XB_XCNT(j)]); sum += c; cnt += (c > 0u) ? 1u : 0u; mine = (j == x) ? c : mine; }
        if (sum == G) break;
        __builtin_amdgcn_s_sleep(1);
        if ((++sp & 255u) == 0u) { if (xb_ld(&bar[XB_TMO])) break; if (sp > XB_SPIN_CAP) { atomicAdd(&bar[XB_TMO], 1u); break; } }
    }
    nloc = mine > 0u ? mine : 1u; nx = cnt > 0u ? cnt : 1u;
}
__device__ __forceinline__ void xcd_barrier(const XcdBarrier& b) {
    asm volatile("s_waitcnt vmcnt(0)" ::: "memory");
    __syncthreads();
    if (threadIdx.x == 0) {
        unsigned* bar = b.bar;
        __builtin_amdgcn_s_waitcnt(0);
        unsigned nloc = b.st[0], nx = b.st[1];
        if (nloc == 0u) { xcd_barrier_complete(bar, b.x, nloc, nx); b.st[0] = nloc; b.st[1] = nx; }
        const unsigned old = xb_add(&bar[XB_XSUB(b.x)], 1u);
        const unsigned gen = old / nloc;
        if (old + 1u == (gen + 1u) * nloc) {
            __builtin_amdgcn_fence(__ATOMIC_RELEASE, "agent");
            asm volatile("s_waitcnt vmcnt(0)" ::: "memory");
            const unsigned og = xb_add(&bar[XB_TOP], 1u);
            const unsigned tg = og / nx;
            if (og + 1u == (tg + 1u) * nx) xb_add(&bar[XB_TOPGEN], 1u);
            else XB_SPIN(xb_ld(&bar[XB_TOPGEN]) == tg, bar);
            __builtin_amdgcn_fence(__ATOMIC_ACQUIRE, "agent");
            xb_add(&bar[XB_XGEN(b.x)], 1u);
            asm volatile("s_waitcnt vmcnt(0)" ::: "memory");
        } else {
            XB_SPIN(xb_ld(&bar[XB_XGEN(b.x)]) == gen, bar);
            __builtin_amdgcn_fence(__ATOMIC_ACQUIRE, "agent");
            asm volatile("s_waitcnt vmcnt(0)" ::: "memory");
        }
    }
    __syncthreads();
}

namespace pg8 {
constexpr int BM = 256, BK = 64, HALF = 128, HTB = HALF * BK * 2, STAGE_BYTES = 8 * HTB, NXCD = 8, WGM = 8;
__host__ __device__ __forceinline__ int lds_byte(int r, int c) { const int st = (r >> 4) * 2 + (c >> 5), rr = r & 15, cc = c & 31, ob = rr * 64 + cc * 2; return st * 1024 + (ob ^ (((ob >> 9) & 1) << 5)); }
__host__ __device__ __forceinline__ void stage_rc(int b, int& R, int& C) { const int st = b / 1024, sb = b % 1024, swz = sb ^ (((sb >> 9) & 1) << 5); R = (st >> 1) * 16 + swz / 64; C = (st & 1) * 32 + (swz % 64) / 2; }
__host__ __device__ __forceinline__ int perm32(int rho) { const int n = rho >> 4, i = rho & 15; return 8 * (i >> 2) + 4 * n + (i & 3); }

struct Unit { unsigned a, b; int rl; int pm, pn, e, valid; };
struct Gemm { const char* A; const char* B; const int* list; int lda; int kb; };
typedef int v8i32 __attribute__((ext_vector_type(8)));

struct DenseOrder {
    int nM, nN, nwg, G, c;
    __device__ void init(int M, int N, int G_, int c_) { nM = M / BM; nN = N / BM; nwg = nM * nN; G = G_; c = c_; }
    __device__ bool tile(int i, int& pm, int& pn) const {
        const long L = (long)i * G + c; if (L >= nwg) return false;
        int wgid = (int)L; { const int q = nwg / NXCD, r = nwg % NXCD, xcd = wgid % NXCD, off = wgid / NXCD; wgid = (xcd < r ? xcd * (q + 1) : r * (q + 1) + (xcd - r) * q) + off; }
        const int nig = WGM * nN, gid = wgid / nig, fm = gid * WGM, gsz = (nM - fm) < WGM ? (nM - fm) : WGM;
        pm = fm + ((wgid % nig) % gsz); pn = (wgid % nig) / gsz; return true;
    }
};

#if NAIVE_GEMM
template <class Epi, class Sched, bool GATHER, bool FP8 = false>
__device__ __forceinline__ void gemm_phase(LAS unsigned char* lds, const Gemm g, const Sched& S, const Epi& E, const int tid) {
    static_assert(!FP8, "reference K-loop is bf16 only");
    (void)lds;
    const int wid = __builtin_amdgcn_readfirstlane(tid >> 6), lane = tid & 63, wr = wid >> 2, wc = wid & 3, fr = lane & 15, fq = lane >> 4;
    Unit u;
    for (int i = 0; S.next(i, u); ++i) {
        f32x4 acc[2][2][4][2];
#pragma unroll
        for (int a = 0; a < 2; ++a)
#pragma unroll
            for (int b = 0; b < 2; ++b)
#pragma unroll
                for (int m = 0; m < 4; ++m)
#pragma unroll
                    for (int n = 0; n < 2; ++n) { f32x4 z_; asm volatile("v_mov_b32 %0, 0\n\tv_mov_b32 %1, 0\n\tv_mov_b32 %2, 0\n\tv_mov_b32 %3, 0" : "=v"(z_[0]), "=v"(z_[1]), "=v"(z_[2]), "=v"(z_[3])); acc[a][b][m][n] = z_; }
        unsigned ao[2][4], bo[2][2];
#pragma unroll
        for (int ai = 0; ai < 2; ++ai)
#pragma unroll
            for (int m = 0; m < 4; ++m) { const int r = 128 * ai + 64 * wr + 16 * m + fr;
                if (GATHER) { const int idx = g.list[u.rl + (r < u.valid ? r : 0)]; ao[ai][m] = (unsigned)idx * (unsigned)g.lda + fq * 16; }
                else ao[ai][m] = u.a + (unsigned)r * (unsigned)g.lda + fq * 16; }
#pragma unroll
        for (int bj = 0; bj < 2; ++bj)
#pragma unroll
            for (int n = 0; n < 2; ++n) { const int r = 128 * bj + 32 * wc + perm32(16 * n + fr); bo[bj][n] = u.b + (unsigned)r * (unsigned)g.kb + fq * 16; }
#pragma unroll 1
        for (int k0 = 0; k0 < g.kb / 2; k0 += 32) {
            bf16x8 B[2][2];
#pragma unroll
            for (int bj = 0; bj < 2; ++bj)
#pragma unroll
                for (int n = 0; n < 2; ++n) B[bj][n] = *(const bf16x8*)(g.B + bo[bj][n] + k0 * 2);
#pragma unroll
            for (int ai = 0; ai < 2; ++ai) {
                bf16x8 A[4];
#pragma unroll
                for (int m = 0; m < 4; ++m) A[m] = *(const bf16x8*)(g.A + ao[ai][m] + k0 * 2);
#pragma unroll
                for (int bj = 0; bj < 2; ++bj)
#pragma unroll
                    for (int m = 0; m < 4; ++m)
#pragma unroll
                        for (int n = 0; n < 2; ++n) acc[ai][bj][m][n] = __builtin_amdgcn_mfma_f32_16x16x32_bf16(B[bj][n], A[m], acc[ai][bj][m][n], 0, 0, 0);
            }
        }
        E(acc, u, wr, wc, fr, fq);
    }
}
#else
template <class Epi, class Sched, bool GATHER, bool FP8 = false>
__device__ __forceinline__ void gemm_phase(LAS unsigned char* lds, const Gemm g, const Sched& S, const Epi& E, const int tid) {
    const int wid = __builtin_amdgcn_readfirstlane(tid >> 6), lane = tid & 63, wr = wid >> 2, wc = wid & 3, fr = lane & 15, fq = lane >> 4;
    const int KB_ = g.kb, nt = KB_ / (BK * 2);
    unsigned voffB[2], vA0[2], vA1[2], vN0[2], vN1[2];
#pragma unroll
    for (int i = 0; i < 2; ++i) { int R, C; stage_rc(tid * 16 + i * 8192, R, C); const int Rb = (R & ~31) + perm32(R & 31);
        voffB[i] = (unsigned)(Rb * KB_ + C * 2); vA0[i] = (unsigned)(R * g.lda + C * 2); vA1[i] = vA0[i] + (unsigned)(HALF * g.lda); vN0[i] = vA0[i]; vN1[i] = vA1[i]; }
    const size_t kstep = (size_t)(BK * 2);
    const size_t hstepB = (size_t)HALF * KB_;
    const unsigned ldsw = (unsigned)wid * 1024u; const unsigned ldsbase_ = (unsigned)(size_t)lds + ldsw;
    const int aoff = lds_byte(wr * 64 + fr, fq * 8), boff = lds_byte(wc * 32 + fr, fq * 8);
#define PG8_SA(b, h) (((b) * 2 + (h)) * HTB)
#define PG8_SB(b, h) ((4 + (b) * 2 + (h)) * HTB)
#define PG8_STAGE(bufoff, gbase, voff) do { _Pragma("unroll") for (int _i = 0; _i < 2; ++_i) \
        asm volatile("s_mov_b32 m0, %2\n\ts_nop 0\n\tglobal_load_lds_dwordx4 %0, %1" :: "v"((voff)[_i]), "s"((const char*)(gbase)), "s"(ldsbase_ + (unsigned)((bufoff) + _i * 8192)) : "memory", "m0"); } while (0)
#define PG8_LD16A(off_) (*(const LAS i32x4_*)(size_t)(la_ + (unsigned)(off_)))
#define PG8_LD16B(off_) (*(const LAS i32x4_*)(size_t)(lb_ + (unsigned)(off_)))
#define PG8_LDA(dst, b, h) do { _Pragma("unroll") for (int m = 0; m < 4; ++m) dst[m] = __builtin_shufflevector(PG8_LD16A(PG8_SA(b, h) + m * 2048), PG8_LD16A(PG8_SA(b, h) + m * 2048 + 1024), 0, 1, 2, 3, 4, 5, 6, 7); } while (0)
#define PG8_LDB(dst, b, h) do { _Pragma("unroll") for (int n = 0; n < 2; ++n) dst[n] = __builtin_shufflevector(PG8_LD16B(PG8_SA(b, h) + n * 2048), PG8_LD16B(PG8_SA(b, h) + n * 2048 + 1024), 0, 1, 2, 3, 4, 5, 6, 7); } while (0)
#define PG8_MMA(ai, bj, At, Bt) do { __builtin_amdgcn_s_setprio(1); _Pragma("unroll") for (int m = 0; m < 4; ++m) _Pragma("unroll") for (int n = 0; n < 2; ++n) { \
        if constexpr (FP8) acc[ai][bj][m][n] = __builtin_amdgcn_mfma_scale_f32_16x16x128_f8f6f4(Bt[n], At[m], acc[ai][bj][m][n], 0, 0, 0, 0x7f7f7f7f, 0, 0x7f7f7f7f); \
        else { acc[ai][bj][m][n] = __builtin_amdgcn_mfma_f32_16x16x32_bf16(__builtin_bit_cast(bf16x8, __builtin_shufflevector(Bt[n], Bt[n], 0, 1, 2, 3)), __builtin_bit_cast(bf16x8, __builtin_shufflevector(At[m], At[m], 0, 1, 2, 3)), acc[ai][bj][m][n], 0, 0, 0); \
               acc[ai][bj][m][n] = __builtin_amdgcn_mfma_f32_16x16x32_bf16(__builtin_bit_cast(bf16x8, __builtin_shufflevector(Bt[n], Bt[n], 4, 5, 6, 7)), __builtin_bit_cast(bf16x8, __builtin_shufflevector(At[m], At[m], 4, 5, 6, 7)), acc[ai][bj][m][n], 0, 0, 0); } } \
        __builtin_amdgcn_s_setprio(0); } while (0)
#define PG8_WAIT_V(n) asm volatile("s_waitcnt vmcnt(" #n ")" ::: "memory")
#define PG8_WAIT_L(n) asm volatile("s_waitcnt lgkmcnt(" #n ")" ::: "memory")
#define PG8_BAR __builtin_amdgcn_s_barrier()
#define PG8_SCHED __builtin_amdgcn_sched_barrier(0)
#define PG8_GATHER_OFFS(u_, o0, o1) do { if constexpr (GATHER) { const int tq_ = wid * 64 + lane_id_asm(); _Pragma("unroll") for (int _i = 0; _i < 2; ++_i) { \
        int sR_, sC_; stage_rc(tq_ * 16 + _i * 8192, sR_, sC_); sC_ *= 2; const int r0_ = sR_, r1_ = sR_ + HALF; const int i0_ = g.list[(u_).rl + (r0_ < (u_).valid ? r0_ : 0)], i1_ = g.list[(u_).rl + (r1_ < (u_).valid ? r1_ : 0)]; \
        o0[_i] = (unsigned)i0_ * (unsigned)g.lda + (unsigned)sC_; o1[_i] = (unsigned)i1_ * (unsigned)g.lda + (unsigned)sC_; } } } while (0)
    Unit cur, nxt; int ui = 0;
    if (!S.next(0, cur)) return;
    f32x4 acc[2][2][4][2];
#pragma unroll
    for (int a = 0; a < 2; ++a)
#pragma unroll
        for (int b = 0; b < 2; ++b)
#pragma unroll
            for (int m = 0; m < 4; ++m)
#pragma unroll
                for (int n = 0; n < 2; ++n) { f32x4 z_; asm volatile("v_mov_b32 %0, 0\n\tv_mov_b32 %1, 0\n\tv_mov_b32 %2, 0\n\tv_mov_b32 %3, 0" : "=v"(z_[0]), "=v"(z_[1]), "=v"(z_[2]), "=v"(z_[3])); acc[a][b][m][n] = z_; }
    typedef int i32x4_ __attribute__((ext_vector_type(4)));
    v8i32 At[4], B0[2], B1[2];
    const char* cA = g.A + cur.a; const char* cB = g.B + cur.b;
    PG8_GATHER_OFFS(cur, vA0, vA1);
    PG8_STAGE(PG8_SB(0, 0), cB, voffB); PG8_STAGE(PG8_SB(0, 1), cB + hstepB, voffB); PG8_STAGE(PG8_SA(0, 0), cA, vA0); PG8_STAGE(PG8_SA(0, 1), cA, vA1);
    if (wr == 1) PG8_BAR;
    PG8_WAIT_V(2); PG8_BAR;
    PG8_STAGE(PG8_SB(1, 0), cB + kstep, voffB); PG8_STAGE(PG8_SA(1, 0), cA + kstep, vA0); PG8_STAGE(PG8_SB(1, 1), cB + hstepB + kstep, voffB);
    PG8_WAIT_V(6); PG8_BAR;
    for (;;) {
        const bool has_next = S.next(ui + 1, nxt);
        const char* nA = has_next ? g.A + nxt.a : cA; const char* nB = has_next ? g.B + nxt.b : cB;
        if constexpr (GATHER) { if (has_next) { PG8_GATHER_OFFS(nxt, vN0, vN1); } else {
#pragma unroll
            for (int i = 0; i < 2; ++i) { vN0[i] = vA0[i]; vN1[i] = vA1[i]; } } }
        for (int t = 0; t < nt; t += 2) {
            const unsigned la_ = (unsigned)opaque_v((int)((unsigned)(size_t)lds + (unsigned)aoff)), lb_ = (unsigned)opaque_v((int)((unsigned)(size_t)lds + (unsigned)boff + 4u * HTB));
            const bool last = (t == nt - 2);
            const char* a1 = cA + (size_t)(t + 1) * kstep;
            const char* a2 = last ? nA : cA + (size_t)(t + 2) * kstep; const char* b2 = last ? nB : cB + (size_t)(t + 2) * kstep;
            const char* a3 = a2 + kstep; const char* b3 = b2 + kstep;
            PG8_LDB(B0, 0, 0); PG8_LDB(B1, 0, 1); PG8_SCHED; PG8_LDA(At, 0, 0); PG8_STAGE(PG8_SA(1, 1), a1, vA1);
            if constexpr (GATHER) { if (last) { _Pragma("unroll") for (int i = 0; i < 2; ++i) { vA0[i] = vN0[i]; vA1[i] = vN1[i]; } } }
            PG8_WAIT_V(8); PG8_WAIT_L(0); PG8_BAR; PG8_MMA(0, 0, At, B0); PG8_MMA(0, 1, At, B1); PG8_BAR; PG8_SCHED;
            PG8_LDA(At, 0, 1); PG8_STAGE(PG8_SB(0, 0), b2, voffB); PG8_STAGE(PG8_SB(0, 1), b2 + hstepB, voffB); PG8_STAGE(PG8_SA(0, 0), a2, vA0);
            PG8_WAIT_V(8); PG8_WAIT_L(0); PG8_BAR; PG8_MMA(1, 0, At, B0); PG8_MMA(1, 1, At, B1); PG8_BAR; PG8_SCHED;
            PG8_LDB(B0, 1, 0); PG8_LDB(B1, 1, 1); PG8_SCHED; PG8_LDA(At, 1, 0); PG8_STAGE(PG8_SA(0, 1), a2, vA1);
            PG8_WAIT_V(8); PG8_WAIT_L(0); PG8_BAR; PG8_MMA(0, 0, At, B0); PG8_MMA(0, 1, At, B1); PG8_BAR; PG8_SCHED;
            PG8_LDA(At, 1, 1); PG8_STAGE(PG8_SB(1, 0), b3, voffB); PG8_STAGE(PG8_SB(1, 1), b3 + hstepB, voffB); PG8_STAGE(PG8_SA(1, 0), a3, vA0);
            PG8_WAIT_V(8); PG8_WAIT_L(0); PG8_BAR; PG8_MMA(1, 0, At, B0); PG8_MMA(1, 1, At, B1); PG8_BAR; PG8_SCHED;
        }
        if (wr == 0) PG8_BAR;
        { const int l2_ = lane_id_asm(); E(acc, cur, wid >> 2, wid & 3, l2_ & 15, l2_ >> 4); }
        if (!has_next) break;
#pragma unroll
        for (int a = 0; a < 2; ++a)
#pragma unroll
            for (int b = 0; b < 2; ++b)
#pragma unroll
                for (int m = 0; m < 4; ++m)
#pragma unroll
                    for (int n = 0; n < 2; ++n) { f32x4 z_; asm volatile("v_mov_b32 %0, 0\n\tv_mov_b32 %1, 0\n\tv_mov_b32 %2, 0\n\tv_mov_b32 %3, 0" : "=v"(z_[0]), "=v"(z_[1]), "=v"(z_[2]), "=v"(z_[3])); acc[a][b][m][n] = z_; }
        cur = nxt; cA = nA; cB = nB; ++ui;
        if (wr == 1) PG8_BAR;
    }
    PG8_WAIT_V(0);
    PG8_BAR;
#undef PG8_SA
#undef PG8_SB
#undef PG8_STAGE
#undef PG8_LDA
#undef PG8_LD16A
#undef PG8_LD16B
#undef PG8_LDB
#undef PG8_MMA
#undef PG8_WAIT_V
#undef PG8_WAIT_L
#undef PG8_BAR
#undef PG8_SCHED
#undef PG8_GATHER_OFFS
}
#endif
}
using pg8::Unit;

struct SchedDense {
    pg8::DenseOrder o; int lda, kb;
    __device__ __forceinline__ bool next(int i, Unit& u) const { int pm, pn; if (!o.tile(i, pm, pn)) return false;
        u.pm = pm; u.pn = pn; u.e = 0; u.valid = 256; u.rl = 0; u.a = (unsigned)pm * 256u * (unsigned)lda; u.b = (unsigned)pn * 256u * (unsigned)kb; return true; }
};
struct SchedGates {
    pg8::DenseOrder o;
    __device__ __forceinline__ bool next(int i, Unit& u) const { int pm, pn; if (!o.tile(i, pm, pn)) return false;
        const int gi = pn >> 1, hf = pn & 1; u.pm = pm; u.pn = hf; u.e = gi; u.valid = 256; u.rl = 0;
        u.a = (unsigned)pm * 256u * (D * 2) + gi * 256 * 2; u.b = (unsigned)gi * (512 * 256 * 2) + (unsigned)hf * 256 * 256 * 2; return true; }
};
#define MOE_CNT(lds)    ((LAS int*)((lds) + MOE_OFF))
#define MOE_MTBASE(lds) ((LAS int*)((lds) + MOE_OFF + 128))
#define MOE_MTE(lds)    ((LAS int*)((lds) + MOE_OFF + 288))
struct SchedMoe {
    LAS unsigned char* lds; int total, NT, G, c; unsigned bstride, apitch; bool gather;
    __device__ __forceinline__ bool next(int i, Unit& u) const {
        const int L = i * G + c; if (L >= total * NT) return false;
        const int mt = L / NT, nt = L - mt * NT;
        const int e = __builtin_amdgcn_readfirstlane(MOE_MTE(lds)[mt]); const int ml = mt - __builtin_amdgcn_readfirstlane(MOE_MTBASE(lds)[e]);
        const int left = __builtin_amdgcn_readfirstlane(MOE_CNT(lds)[e]) - ml * 256;
        u.pm = mt; u.pn = nt; u.e = e; u.valid = left < 256 ? left : 256; u.rl = e * NTOK + ml * 256;
        u.a = gather ? 0u : (unsigned)mt * 256u * apitch; u.b = (unsigned)e * bstride + (unsigned)nt * 256u * apitch; return true; }
};
__device__ __forceinline__ int moe_tables(LAS unsigned char* lds, const unsigned* cntw, const int tid) {
    LAS int* cnt = MOE_CNT(lds); LAS int* mtbase = MOE_MTBASE(lds); LAS int* mte = MOE_MTE(lds);
    __syncthreads();
    if (tid < 32) cnt[tid] = (int)__hip_atomic_load(cntw + tid, RLX_AGENT);
    __syncthreads();
    if (tid == 0) { int s = 0; for (int e = 0; e < NE; ++e) { mtbase[e] = s; const int n = (cnt[e] + 255) >> 8; for (int j = 0; j < n; ++j) mte[s + j] = e; s += n; } mtbase[NE] = s; }
    __syncthreads();
    return __builtin_amdgcn_readfirstlane(mtbase[NE]);
}

typedef f32x4 Acc[2][2][4][2];
struct EpiQKV {
    bf16_t* q;
    __device__ __forceinline__ void operator()(const Acc& acc, const Unit& u, int wr, int wc, int fr, int fq) const {
        const int which = u.pn >> 2; const unsigned wo = (unsigned)which * (unsigned)(WS_K - WS_Q); const float sc = (which == 0 ? QSCALE : 1.0f) * (1.0f / (XS8 * WS8_QKV));
#pragma unroll
        for (int ai = 0; ai < 2; ++ai)
#pragma unroll
            for (int m = 0; m < 4; ++m) { const int ntok = u.pm * 256 + 128 * ai + 64 * wr + 16 * m + fr, b = ntok >> 12, t = ntok & 4095;
#pragma unroll
                for (int bj = 0; bj < 2; ++bj) { const int head = (u.pn & 3) * 2 + bj, d = 32 * wc + 8 * fq;
                    const f32x4 v0 = acc[ai][bj][m][0] * sc, v1 = acc[ai][bj][m][1] * sc;
                    u32x4 w; w.x = cvt_pk_bf16(v0[0], v0[1]); w.y = cvt_pk_bf16(v0[2], v0[3]); w.z = cvt_pk_bf16(v1[0], v1[1]); w.w = cvt_pk_bf16(v1[2], v1[3]);
                    *(u32x4*)((char*)q + (wo + (unsigned)(((b * NH + head) * T + t) * HD + d) * 2u)) = w; } }
    }
};
struct EpiResid {
    const bf16_t* X; bf16_t* Z; float sc;
    __device__ __forceinline__ void operator()(const Acc& acc, const Unit& u, int wr, int wc, int fr, int fq) const {
#pragma unroll
        for (int ai = 0; ai < 2; ++ai)
#pragma unroll
            for (int m = 0; m < 4; ++m) { const size_t row = (size_t)(u.pm * 256 + 128 * ai + 64 * wr + 16 * m + fr);
#pragma unroll
                for (int bj = 0; bj < 2; ++bj) { const size_t off = row * D + u.pn * 256 + 128 * bj + 32 * wc + 8 * fq;
                    const u32x4 xw = *(const u32x4*)(X + off); const f32x4 a0 = acc[ai][bj][m][0] * sc, a1 = acc[ai][bj][m][1] * sc;
                    u32x4 w; w.x = cvt_pk_bf16(bf_lo(xw.x) * ALPHA + a0[0], bf_hi(xw.x) * ALPHA + a0[1]); w.y = cvt_pk_bf16(bf_lo(xw.y) * ALPHA + a0[2], bf_hi(xw.y) * ALPHA + a0[3]);
                    w.z = cvt_pk_bf16(bf_lo(xw.z) * ALPHA + a1[0], bf_hi(xw.z) * ALPHA + a1[1]); w.w = cvt_pk_bf16(bf_lo(xw.w) * ALPHA + a1[2], bf_hi(xw.w) * ALPHA + a1[3]);
                    *(u32x4*)(Z + off) = w; }
                asm volatile("" ::: "memory"); }
    }
};
__device__ __forceinline__ float gelu_tanh(float x) { const float y = 0.7978845608028654f * (x + 0.044715f * x * x * x); return x * __builtin_amdgcn_rcpf(1.0f + __builtin_amdgcn_exp2f(-2.0f * LOG2E * y)); }
struct EpiLin {
    bf16_t* ybr; bf16_t* r;
    __device__ __forceinline__ void operator()(const Acc& acc, const Unit& u, int wr, int wc, int fr, int fq) const {
        const bool isy = u.pn < 4; bf16_t* base = isy ? ybr : r; const int ct = isy ? u.pn : u.pn - 4;
#pragma unroll
        for (int ai = 0; ai < 2; ++ai)
#pragma unroll
            for (int m = 0; m < 4; ++m) { const size_t row = (size_t)(u.pm * 256 + 128 * ai + 64 * wr + 16 * m + fr);
#pragma unroll
                for (int bj = 0; bj < 2; ++bj) { f32x4 v0 = acc[ai][bj][m][0] * (1.0f / (XS8 * WS8_IN)), v1 = acc[ai][bj][m][1] * (1.0f / (XS8 * WS8_IN));
                    if (isy) {
#pragma unroll
                        for (int j = 0; j < 4; ++j) { v0[j] = gelu_tanh(v0[j]); v1[j] = gelu_tanh(v1[j]); } }
                    u32x4 w; w.x = cvt_pk_bf16(v0[0], v0[1]); w.y = cvt_pk_bf16(v0[2], v0[3]); w.z = cvt_pk_bf16(v1[0], v1[1]); w.w = cvt_pk_bf16(v1[2], v1[3]);
                    *(u32x4*)(base + row * D + ct * 256 + 128 * bj + 32 * wc + 8 * fq) = w; } }
    }
};
struct EpiGates {
    const bf16_t* rc; const float* bgx; const float* bga; const float* spt; float* Aa; float* Uu;
    __device__ __forceinline__ void operator()(const Acc& acc, const Unit& u, int wr, int wc, int fr, int fq) const {
        const int ch = u.e * 256 + u.pn * 128 + 32 * wc + 8 * fq;
        const f32x4 bx0 = *(const f32x4*)(bgx + ch), bx1 = *(const f32x4*)(bgx + ch + 4), ba0 = *(const f32x4*)(bga + ch), ba1 = *(const f32x4*)(bga + ch + 4), sp0 = *(const f32x4*)(spt + ch), sp1 = *(const f32x4*)(spt + ch + 4);
#pragma unroll
        for (int ai = 0; ai < 2; ++ai)
#pragma unroll
            for (int m = 0; m < 4; ++m) { const size_t row = (size_t)(u.pm * 256 + 128 * ai + 64 * wr + 16 * m + fr);
                const u32x4 rw = *(const u32x4*)(rc + row * D + ch);
                const f32x4 r0 = {bf_lo(rw.x), bf_hi(rw.x), bf_lo(rw.y), bf_hi(rw.y)}, r1 = {bf_lo(rw.z), bf_hi(rw.z), bf_lo(rw.w), bf_hi(rw.w)};
                f32x4 a0, a1, u0, u1;
#pragma unroll
                for (int j = 0; j < 4; ++j) {
                    { const float gx = sigmoidf_(acc[ai][0][m][0][j] + bx0[j]), ga = sigmoidf_(acc[ai][1][m][0][j] + ba0[j]); const float la = ga * sp0[j], x = 2.0f * la;
                      a0[j] = __builtin_amdgcn_exp2f(la * LOG2E); const float om = (x > -0.02f) ? -x * (1.0f + x * (0.5f + x * (1.0f / 6.0f))) : 1.0f - __builtin_amdgcn_exp2f(x * LOG2E); u0[j] = __builtin_amdgcn_sqrtf(om) * gx * r0[j]; }
                    { const float gx = sigmoidf_(acc[ai][0][m][1][j] + bx1[j]), ga = sigmoidf_(acc[ai][1][m][1][j] + ba1[j]); const float la = ga * sp1[j], x = 2.0f * la;
                      a1[j] = __builtin_amdgcn_exp2f(la * LOG2E); const float om = (x > -0.02f) ? -x * (1.0f + x * (0.5f + x * (1.0f / 6.0f))) : 1.0f - __builtin_amdgcn_exp2f(x * LOG2E); u1[j] = __builtin_amdgcn_sqrtf(om) * gx * r1[j]; } }
                { const size_t ao = ((((row >> 12) * 64 + (size_t)(ch >> 4)) * T + (row & 4095)) * 32) + ((ch >> 3) & 1) * 8;
                  *(f32x4*)(Aa + ao) = a0; *(f32x4*)(Aa + ao + 4) = a1; *(f32x4*)(Aa + ao + 16) = u0; *(f32x4*)(Aa + ao + 20) = u1; }
                asm volatile("" ::: "memory"); }
    }
};
struct EpiSwiglu {
    const float* bg; const float* bu; unsigned char* hb;
    __device__ __forceinline__ void operator()(const Acc& acc, const Unit& u, int wr, int wc, int fr, int fq) const {
        const int col = u.pn * 128 + 32 * wc + 8 * fq;
        const f32x4 gA = *(const f32x4*)(bg + u.e * D + col), gB = *(const f32x4*)(bg + u.e * D + col + 4), uA = *(const f32x4*)(bu + u.e * D + col), uB = *(const f32x4*)(bu + u.e * D + col + 4);
        const float g0[8] = {gA[0], gA[1], gA[2], gA[3], gB[0], gB[1], gB[2], gB[3]}, u0[8] = {uA[0], uA[1], uA[2], uA[3], uB[0], uB[1], uB[2], uB[3]};
#pragma unroll
        for (int ai = 0; ai < 2; ++ai)
#pragma unroll
            for (int m = 0; m < 4; ++m) { const size_t row = (size_t)(u.pm * 256 + 128 * ai + 64 * wr + 16 * m + fr);
                float h[8];
#pragma unroll
                for (int j = 0; j < 8; ++j) { float gv = acc[ai][0][m][j >> 2][j & 3] * (1.0f / (XS8 * WS8_GU)) + g0[j], uv = acc[ai][1][m][j >> 2][j & 3] * (1.0f / (XS8 * WS8_GU)) + u0[j];
                    gv = fminf(gv, 7.0f); uv = fminf(fmaxf(uv, -7.0f), 7.0f); h[j] = gv * sigmoidf_(1.702f * gv) * (uv + 1.0f) * HS8; }
                int w0 = 0, w1 = 0; w0 = __builtin_amdgcn_cvt_pk_fp8_f32(h[0], h[1], w0, false); w0 = __builtin_amdgcn_cvt_pk_fp8_f32(h[2], h[3], w0, true); w1 = __builtin_amdgcn_cvt_pk_fp8_f32(h[4], h[5], w1, false); w1 = __builtin_amdgcn_cvt_pk_fp8_f32(h[6], h[7], w1, true);
                *(u32x2*)(hb + row * D + col) = (u32x2){(unsigned)w0, (unsigned)w1};
                asm volatile("" ::: "memory"); }
    }
};
struct EpiPlain {
    bf16_t* yb; float sc; const float* bias;
    __device__ __forceinline__ void operator()(const Acc& acc, const Unit& u, int wr, int wc, int fr, int fq) const {
        f32x4 bv[2][2];
#pragma unroll
        for (int bj = 0; bj < 2; ++bj) { const float* bp = bias + (size_t)u.e * D + u.pn * 256 + 128 * bj + 32 * wc + 8 * fq; bv[bj][0] = *(const f32x4*)bp; bv[bj][1] = *(const f32x4*)(bp + 4); }
#pragma unroll
        for (int ai = 0; ai < 2; ++ai)
#pragma unroll
            for (int m = 0; m < 4; ++m) { const size_t row = (size_t)(u.pm * 256 + 128 * ai + 64 * wr + 16 * m + fr);
#pragma unroll
                for (int bj = 0; bj < 2; ++bj) { const f32x4 v0 = acc[ai][bj][m][0] * sc + bv[bj][0], v1 = acc[ai][bj][m][1] * sc + bv[bj][1];
                    u32x4 w; w.x = cvt_pk_bf16(v0[0], v0[1]); w.y = cvt_pk_bf16(v0[2], v0[3]); w.z = cvt_pk_bf16(v1[0], v1[1]); w.w = cvt_pk_bf16(v1[2], v1[3]);
                    *(u32x4*)(yb + row * D + u.pn * 256 + 128 * bj + 32 * wc + 8 * fq) = w; } }
    }
};

__device__ __forceinline__ void xpose_item(const float* W, int K, int N, bf16_t* WT, int mode, LAS float* scr, int item, int lane) {
    const int nblk = N / 32, kb = item / nblk, nb = item % nblk, k0 = 64 * kb, n0 = 32 * nb;
    const int row0 = mode < 0 ? n0 : ((n0 >> 7) * 256 + mode * 128 + (n0 & 127));
#pragma unroll 8
    for (int i = 0; i < 32; ++i) { const int kk = 2 * i + (lane >> 5); scr[kk * 33 + (lane & 31)] = W[(size_t)(k0 + kk) * N + n0 + (lane & 31)]; }
    asm volatile("s_waitcnt lgkmcnt(0)" ::: "memory");
    const int c = lane & 7;
#pragma unroll
    for (int j = 0; j < 4; ++j) { const int n = (lane >> 3) + 8 * j; const LAS float* s = scr + (8 * c) * 33 + n;
        u32x4 o; o.x = cvt_pk_bf16(s[0 * 33], s[1 * 33]); o.y = cvt_pk_bf16(s[2 * 33], s[3 * 33]); o.z = cvt_pk_bf16(s[4 * 33], s[5 * 33]); o.w = cvt_pk_bf16(s[6 * 33], s[7 * 33]);
        *(u32x4*)(WT + (size_t)(row0 + n) * K + k0 + 8 * c) = o; }
    asm volatile("s_waitcnt lgkmcnt(0)" ::: "memory");
}
__device__ __forceinline__ void xpose_class(const float* src, int nmat, int K, int N, bf16_t* dst, size_t dstride, int mode, LAS float* scr, int gw, int NGW, int lane) {
    const int ipm = (K / 64) * (N / 32);
    for (int it = gw; it < nmat * ipm; it += NGW) { const int mat = it / ipm, r = it - mat * ipm;
        xpose_item(src + (size_t)mat * K * N, K, N, dst + (size_t)mat * dstride, mode, scr, r, lane); }
}

__device__ __forceinline__ void xpose_item8(const float* W, int K, int N, unsigned char* WT, int mode, float scale, LAS float* scr, int item, int lane) {
    const int nblk = N / 32, kb = item / nblk, nb = item % nblk, n0 = 32 * nb;
    const int row0 = mode < 0 ? n0 : ((n0 >> 7) * 256 + mode * 128 + (n0 & 127));
#pragma unroll 1
    for (int hf = 0; hf < 2; ++hf) { const int k0 = 128 * kb + 64 * hf;
#pragma unroll 8
        for (int i = 0; i < 32; ++i) { const int kk = 2 * i + (lane >> 5); scr[kk * 33 + (lane & 31)] = W[(size_t)(k0 + kk) * N + n0 + (lane & 31)] * scale; }
        asm volatile("s_waitcnt lgkmcnt(0)" ::: "memory");
        const int c = lane & 7;
#pragma unroll
        for (int j = 0; j < 4; ++j) { const int n = (lane >> 3) + 8 * j; const LAS float* s = scr + (8 * c) * 33 + n;
            int w0 = 0, w1 = 0; w0 = __builtin_amdgcn_cvt_pk_fp8_f32(s[0 * 33], s[1 * 33], w0, false); w0 = __builtin_amdgcn_cvt_pk_fp8_f32(s[2 * 33], s[3 * 33], w0, true);
            w1 = __builtin_amdgcn_cvt_pk_fp8_f32(s[4 * 33], s[5 * 33], w1, false); w1 = __builtin_amdgcn_cvt_pk_fp8_f32(s[6 * 33], s[7 * 33], w1, true);
            *(u32x2*)(WT + (size_t)(row0 + n) * K + k0 + 8 * c) = (u32x2){(unsigned)w0, (unsigned)w1}; }
        asm volatile("s_waitcnt lgkmcnt(0)" ::: "memory"); }
}
__device__ __forceinline__ void xpose_class8(const float* src, int nmat, int K, int N, unsigned char* dst, size_t dstride, int mode, float scale, LAS float* scr, int gw, int NGW, int lane) {
    const int ipm = (K / 128) * (N / 32);
    for (int it = gw; it < nmat * ipm; it += NGW) { const int mat = it / ipm, r = it - mat * ipm;
        xpose_item8(src + (size_t)mat * K * N, K, N, dst + (size_t)mat * dstride, mode, scale, scr, r, lane); }
}

struct Ctx {
    unsigned char* ws; LAS unsigned char* lds;
    int tid, lane, wave, G, vcu, bx;
};
struct Args { const float* in[25]; float* out; unsigned char* ws; int ph_lo, ph_hi; };

__device__ __forceinline__ void ph_prologue(const Ctx& c, const Args& A) {
    LAS float* scr = (LAS float*)(c.lds + c.wave * 16384);
    const int gw = c.vcu * 8 + c.wave, NGW = c.G * 8;
    unsigned char* ws = c.ws;
    xpose_class8(A.in[2], 2, D, 3 * D, (unsigned char*)(ws + WS_WQKV), (size_t)3 * D * D, -1, WS8_QKV, scr, gw, NGW, c.lane);
    xpose_class8(A.in[3], 2, D, D, (unsigned char*)(ws + WS_WO), (size_t)D * D, -1, WS8_O, scr, gw, NGW, c.lane);
    xpose_class8(A.in[4], 2, D, 2 * D, (unsigned char*)(ws + WS_WIN), (size_t)2 * D * D, -1, WS8_IN, scr, gw, NGW, c.lane);
    xpose_class(A.in[7], 8, 256, 256, (bf16_t*)(ws + WS_WG), (size_t)512 * 256, 0, scr, gw, NGW, c.lane);
    xpose_class(A.in[9], 8, 256, 256, (bf16_t*)(ws + WS_WG), (size_t)512 * 256, 1, scr, gw, NGW, c.lane);
    xpose_class8(A.in[12], 2, D, D, (unsigned char*)(ws + WS_WOUT), (size_t)D * D, -1, WS8_OUT, scr, gw, NGW, c.lane);
#if NAIVE_ATTN
    xpose_class8(A.in[15], DEPTH * NE, D, D, (unsigned char*)(ws + WS_WGU), (size_t)2 * D * D, 0, WS8_GU, scr, gw, NGW, c.lane);
    xpose_class8(A.in[17], DEPTH * NE, D, D, (unsigned char*)(ws + WS_WGU), (size_t)2 * D * D, 1, WS8_GU, scr, gw, NGW, c.lane);
    xpose_class8(A.in[19], DEPTH * NE, D, D, (unsigned char*)(ws + WS_WD), (size_t)D * D, -1, WS8_D, scr, gw, NGW, c.lane);
#endif
    for (int m = gw; m < NTOK; m += NGW) { const f32x4* xr = (const f32x4*)(A.in[0] + (size_t)m * D) + c.lane; u32x2* o = (u32x2*)((bf16_t*)(ws + WS_XB) + (size_t)m * D) + c.lane; int* o8 = (int*)((unsigned char*)(ws + WS_XB8) + (size_t)m * D) + c.lane;
#pragma unroll
        for (int j = 0; j < 4; ++j) { const f32x4 v = xr[64 * j]; u32x2 w; w.x = cvt_pk_bf16(v[0], v[1]); w.y = cvt_pk_bf16(v[2], v[3]); o[64 * j] = w;
            int w8 = 0; w8 = __builtin_amdgcn_cvt_pk_fp8_f32(v[0] * XS8, v[1] * XS8, w8, false); w8 = __builtin_amdgcn_cvt_pk_fp8_f32(v[2] * XS8, v[3] * XS8, w8, true); o8[64 * j] = w8; } }
    if (c.bx == 0) { float* bt = (float*)(ws + WS_BIAS);
        for (int i = c.tid; i < NH * BIAS_W; i += 512) { const int h = i / BIAS_W; int dist = i % BIAS_W - 64; if (dist < 0) dist = 0;
            int bucket;
            if (dist < 16) bucket = dist; else { const float n = (float)dist; int lg = 16 + (int)(logf(n / 16.0f) / 2.0794415416798357f * 16.0f); bucket = lg < 31 ? lg : 31; }
            bt[i] = A.in[1][bucket * NH + h] * LOG2E; }
        float* spt = (float*)(ws + WS_SPT);
        for (int i = c.tid; i < 2 * D; i += 512) { const float ap = -A.in[11][i]; spt[i] = -8.0f * (ap > 15.f ? ap : log1pf(expf(ap))); } }
}

__device__ __forceinline__ void ph_kmean(const Ctx& c) {
    const bf16_t* Kb = (const bf16_t*)(c.ws + WS_K); float* km = (float*)(c.ws + WS_KMEAN); LAS float* red = (LAS float*)c.lds;
    for (int u = c.vcu; u < NB * NH * NBLK; u += c.G) {
        const int bh = u / NBLK, j = u % NBLK; const bf16_t* Kp = Kb + ((size_t)bh * T + j * MBLK) * HD;
        const int c8 = c.tid & 15, rg = c.tid >> 4; float a[8] = {0, 0, 0, 0, 0, 0, 0, 0};
#pragma unroll
        for (int r = 0; r < 8; ++r) { const u32x4 w = *(const u32x4*)(Kp + (size_t)(rg * 8 + r) * HD + c8 * 8);
            a[0] += bf_lo(w.x); a[1] += bf_hi(w.x); a[2] += bf_lo(w.y); a[3] += bf_hi(w.y); a[4] += bf_lo(w.z); a[5] += bf_hi(w.z); a[6] += bf_lo(w.w); a[7] += bf_hi(w.w); }
#pragma unroll
        for (int i = 0; i < 8; ++i) red[rg * 128 + c8 * 8 + i] = a[i];
        __syncthreads();
        if (c.tid < 128) { float s = 0.f; for (int g = 0; g < 32; ++g) s += red[g * 128 + c.tid]; km[(size_t)u * HD + c.tid] = s * (1.0f / MBLK); }
        __syncthreads();
    }
}
__device__ __forceinline__ void ph_select(const Ctx& c) {
    const bf16_t* Qb = (const bf16_t*)(c.ws + WS_Q); const float* km = (const float*)(c.ws + WS_KMEAN); unsigned* sel = (unsigned*)(c.ws + WS_SEL); LAS float* kl = (LAS float*)c.lds;
    for (int u = c.vcu; u < NB * NH * (T / 512); u += c.G) {
        const int bh = u / (T / 512), ch = u % (T / 512);
        __syncthreads();
        for (int i = c.tid; i < NBLK * HD; i += 512) kl[i] = km[(size_t)bh * NBLK * HD + i];
        __syncthreads();
        const int t = ch * 512 + c.tid, qb = t >> 8;
        float q[HD];
        const u32x4* qp = (const u32x4*)(Qb + ((size_t)bh * T + t) * HD);
#pragma unroll
        for (int i = 0; i < 16; ++i) { const u32x4 w = qp[i]; q[8 * i] = bf_lo(w.x); q[8 * i + 1] = bf_hi(w.x); q[8 * i + 2] = bf_lo(w.y); q[8 * i + 3] = bf_hi(w.y); q[8 * i + 4] = bf_lo(w.z); q[8 * i + 5] = bf_hi(w.z); q[8 * i + 6] = bf_lo(w.w); q[8 * i + 7] = bf_hi(w.w); }
        float v0 = -__builtin_inff(), v1 = v0, v2 = v0; int i0 = -1, i1 = -1, i2 = -1;
        for (int j = 0; j < qb; ++j) {
            float s = 0.f; const LAS f32x4* kp = (const LAS f32x4*)(kl + j * HD);
#pragma unroll
            for (int i = 0; i < 32; ++i) { const f32x4 kv = kp[i]; s += q[4 * i] * kv[0] + q[4 * i + 1] * kv[1] + q[4 * i + 2] * kv[2] + q[4 * i + 3] * kv[3]; }
            if (s > v0) { v2 = v1; i2 = i1; v1 = v0; i1 = i0; v0 = s; i0 = j; }
            else if (s > v1) { v2 = v1; i2 = i1; v1 = s; i1 = j; }
            else if (s > v2) { v2 = s; i2 = j; }
        }
        unsigned m = 0; if (i0 >= 0) m |= 1u << i0; if (i1 >= 0) m |= 1u << i1; if (i2 >= 0) m |= 1u << i2;
        sel[(size_t)bh * T + t] = m;
    }
}

#if NAIVE_ATTN
__device__ __forceinline__ void ph_attn(const Ctx& c, const float*, const float*, const float*, int) {
    const bf16_t* Qb = (const bf16_t*)(c.ws + WS_Q); const bf16_t* Kb = (const bf16_t*)(c.ws + WS_K); const bf16_t* Vb = (const bf16_t*)(c.ws + WS_V);
    const unsigned* sel = (const unsigned*)(c.ws + WS_SEL); const float* bt = (const float*)(c.ws + WS_BIAS); bf16_t* O = (bf16_t*)(c.ws + WS_O);
    LAS float* ql = (LAS float*)(c.lds + c.wave * 1024); LAS float* pl = ql + 128;
    const int gw = c.vcu * 8 + c.wave, NGW = c.G * 8, lane = c.lane;
    for (int r = gw; r < NB * NH * T; r += NGW) {
        const int bh = r / T, t = r % T, qb = t >> 8, h = bh % NH, b = bh / NH;
        const unsigned w = *(const unsigned*)(Qb + ((size_t)bh * T + t) * HD + 2 * lane);
        ql[2 * lane] = bf_lo(w); ql[2 * lane + 1] = bf_hi(w);
        asm volatile("s_waitcnt lgkmcnt(0)" ::: "memory");
        const unsigned mask = sel[(size_t)bh * T + t] | (1u << qb);
        float mrun = -1e30f, lrun = 0.f, o0 = 0.f, o1 = 0.f;
        for (int jb = 0; jb <= qb; ++jb) {
            if (!((mask >> jb) & 1u)) continue;
            for (int kc = 0; kc < 4; ++kc) {
                const int key = jb * MBLK + kc * 64 + lane;
                const u32x4* kp = (const u32x4*)(Kb + ((size_t)bh * T + key) * HD);
                float s = 0.f;
#pragma unroll
                for (int i = 0; i < 16; ++i) { const u32x4 kw = kp[i]; const LAS float* qq = ql + 8 * i;
                    s += qq[0] * bf_lo(kw.x) + qq[1] * bf_hi(kw.x) + qq[2] * bf_lo(kw.y) + qq[3] * bf_hi(kw.y) + qq[4] * bf_lo(kw.z) + qq[5] * bf_hi(kw.z) + qq[6] * bf_lo(kw.w) + qq[7] * bf_hi(kw.w); }
                const int dist = t - key;
                if (dist < 0) s = -__builtin_inff(); else s += bt[h * BIAS_W + 64 + (dist > 600 ? 600 : dist)];
                const float cm = wave_max(s), mn = fmaxf(mrun, cm), al = exp2f(mrun - mn), p = exp2f(s - mn);
                lrun = lrun * al + wave_sum(p); o0 *= al; o1 *= al; mrun = mn;
                pl[lane] = p;
                asm volatile("s_waitcnt lgkmcnt(0)" ::: "memory");
                const bf16_t* vp = Vb + ((size_t)bh * T + jb * MBLK + kc * 64) * HD + 2 * lane;
                for (int kk = 0; kk < 64; ++kk) { const unsigned vw = *(const unsigned*)(vp + (size_t)kk * HD); const float pk = pl[kk]; o0 += pk * bf_lo(vw); o1 += pk * bf_hi(vw); }
                asm volatile("s_waitcnt lgkmcnt(0)" ::: "memory");
            }
        }
        const float inv = 1.0f / lrun;
        *(unsigned*)(O + ((size_t)(b * T + t)) * D + h * HD + 2 * lane) = cvt_pk_bf16(o0 * inv, o1 * inv);
    }
}
#endif


struct ConvJob { const float* wg; const float* wu; const float* wd; unsigned char* wgu8; unsigned char* wd8; int Lb; int NGW; };
constexpr int CONV_ITEMS = 3 * 64 * 256;
struct ConvState { int cj, half; bool pend; unsigned char* pdst; float pscale; };
__device__ __forceinline__ void conv_consume(ConvState& S, unsigned cvs_b  , int lane) {
    const int c = lane & 7, n4 = lane >> 3;
    if (S.pend) {
        asm volatile("s_waitcnt vmcnt(0)" ::: "memory");
        const unsigned rb = cvs_b + (unsigned)(c * 1040 + n4 * 128);
        const float sc = S.pscale;
        f32x4 v[8];
#pragma unroll
        for (int i = 0; i < 8; ++i) v[i] = *(const LAS f32x4*)(size_t)(rb + (unsigned)(i * 16)) * sc;
#pragma unroll
        for (int q = 0; q < 4; ++q) {
            int w0 = 0, w1 = 0; w0 = __builtin_amdgcn_cvt_pk_fp8_f32(v[0][q], v[1][q], w0, false); w0 = __builtin_amdgcn_cvt_pk_fp8_f32(v[2][q], v[3][q], w0, true);
            w1 = __builtin_amdgcn_cvt_pk_fp8_f32(v[4][q], v[5][q], w1, false); w1 = __builtin_amdgcn_cvt_pk_fp8_f32(v[6][q], v[7][q], w1, true);
            *(u32x2*)(S.pdst + (unsigned)((4 * n4 + q) * D + 8 * c)) = (u32x2){(unsigned)w0, (unsigned)w1}; }
        asm volatile("s_waitcnt lgkmcnt(0)" ::: "memory");
        S.pend = false;
    }
}
__device__ __forceinline__ void conv_issue(const ConvJob& J, ConvState& S, unsigned cvs_b, int lane) {
    const int c = lane & 7, nn = lane >> 3;
    if (S.cj < CONV_ITEMS) {
        const int j = S.cj, cls = j >> 14, r = j & 16383, mat = J.Lb * NE + (r >> 8), it = r & 255, kb = it >> 5, nb = it & 31, n0 = 32 * nb, k0 = 128 * kb + 64 * S.half;
        const float* Wb = J.wd; if (cls == 0) Wb = opaque_p(J.wg); if (cls == 1) Wb = opaque_p(J.wu);
        const float* W = Wb + (size_t)mat * D * D + (size_t)k0 * D + n0;
        const int row0 = cls == 2 ? n0 : ((n0 >> 7) * 256 + cls * 128 + (n0 & 127));
        unsigned char* db = J.wgu8 + (size_t)mat * 2 * D * D; if (cls == 2) db = opaque_p(J.wd8) + (size_t)mat * D * D;
        S.pdst = db + (size_t)row0 * D + k0;
        S.pscale = cls == 2 ? WS8_D : WS8_GU;
        const unsigned voff = (unsigned)(c * (D * 4) + nn * 16);
#pragma unroll
        for (int g = 0; g < 8; ++g)
            asm volatile("s_mov_b32 m0, %2\n\ts_nop 0\n\tglobal_load_lds_dwordx4 %0, %1" :: "v"(voff), "s"((const char*)(W + (size_t)g * 8 * D)), "s"(cvs_b + (unsigned)(g * 1040)) : "memory", "m0");
        S.pend = true;
        if (S.half) { S.half = 0; S.cj += J.NGW; } else S.half = 1;
    }
}

#if !NAIVE_ATTN
namespace att {
typedef short s16x4 __attribute__((ext_vector_type(4)));
typedef float f32x16 __attribute__((ext_vector_type(16)));
constexpr int SHM_K = 64 * 128 * 2, SHM_V = SHM_K;
constexpr int OFF_V = 0, OFF_K = 2 * SHM_V, OFF_WS = 2 * SHM_V + 2 * SHM_K, OFF_TB = OFF_WS + 8 * 256, OFF_CV = 73728;
constexpr float THR_L2 = 11.5f;
#define KSWZ(row, colB) ((row) * 256 + ((colB) ^ (((row) & 7) << 4)))
__device__ __forceinline__ int v_st(int k, int c) { const int kk = (k & ~0xC) | ((k & 4) << 1) | ((k & 8) >> 1); return ((kk >> 3) * 4 + (c >> 5)) * 512 + ((kk & 7) * 32 + (c & 31)) * 2; }
__device__ __forceinline__ int v_rd_base(int lane) { return ((lane & 3) << 3) | (((lane >> 2) & 3) << 6) | (((lane >> 4) & 1) << 5) | (((lane >> 5) & 1) << 8); }
constexpr int v_rd_off(int d0, int ks, int half) { return d0 * 512 + ks * 4096 + half * 2048; }
__device__ __forceinline__ int crow(int r, int hi) { return (r & 3) + 8 * (r >> 2) + 4 * hi; }
template <int KB>
__device__ __forceinline__ void qkt(f32x16& p0, f32x16& p1, LAS const char* K_lds, int r32, int hi, const bf16x8* qr) {
#pragma unroll
    for (int r = 0; r < 16; ++r) { p0[r] = 0.f; p1[r] = 0.f; }
    LAS const char* kb[4];
#pragma unroll
    for (int dd = 0; dd < 4; ++dd) kb[dd] = K_lds + KB * SHM_K + KSWZ(r32, (dd * 16 + hi * 8) * 2);
#pragma unroll
    for (int d0 = 0; d0 < 8; ++d0) { LAS const char* a = kb[d0 & 3] + (d0 >> 2) * 128;
        const bf16x8 b0 = *(LAS const bf16x8*)a, b1 = *(LAS const bf16x8*)(a + 32 * 256);
        p0 = __builtin_amdgcn_mfma_f32_32x32x16_bf16(b0, qr[d0], p0, 0, 0, 0);
        p1 = __builtin_amdgcn_mfma_f32_32x32x16_bf16(b1, qr[d0], p1, 0, 0, 0); }
}
template <int VB>
__device__ __forceinline__ void pv_tile(f32x16* o, int vb0, bf16x8 pa0, bf16x8 pa1, bf16x8 pa2, bf16x8 pa3) {
#define TRRD(dst, off) asm volatile("ds_read_b64_tr_b16 %0, %1 offset:%2" : "=&v"(dst) : "v"(vb0), "i"(off) : "memory")
#define PV_D0(d0) do { s16x4 l0, l1, l2, l3, h0, h1, h2, h3; constexpr int b_ = VB * SHM_V + v_rd_off(d0, 0, 0); \
        TRRD(l0, b_); TRRD(h0, b_ + 2048); TRRD(l1, b_ + 4096); TRRD(h1, b_ + 6144); TRRD(l2, b_ + 8192); TRRD(h2, b_ + 10240); TRRD(l3, b_ + 12288); TRRD(h3, b_ + 14336); \
        asm volatile("s_waitcnt lgkmcnt(0)" ::: "memory"); __builtin_amdgcn_sched_barrier(0); \
        o[d0] = __builtin_amdgcn_mfma_f32_32x32x16_bf16(pa0, (bf16x8){l0[0], l0[1], l0[2], l0[3], h0[0], h0[1], h0[2], h0[3]}, o[d0], 0, 0, 0); \
        o[d0] = __builtin_amdgcn_mfma_f32_32x32x16_bf16(pa1, (bf16x8){l1[0], l1[1], l1[2], l1[3], h1[0], h1[1], h1[2], h1[3]}, o[d0], 0, 0, 0); \
        o[d0] = __builtin_amdgcn_mfma_f32_32x32x16_bf16(pa2, (bf16x8){l2[0], l2[1], l2[2], l2[3], h2[0], h2[1], h2[2], h2[3]}, o[d0], 0, 0, 0); \
        o[d0] = __builtin_amdgcn_mfma_f32_32x32x16_bf16(pa3, (bf16x8){l3[0], l3[1], l3[2], l3[3], h3[0], h3[1], h3[2], h3[3]}, o[d0], 0, 0, 0); } while (0)
    PV_D0(0); PV_D0(1); PV_D0(2); PV_D0(3);
#undef PV_D0
#undef TRRD
}
__device__ __forceinline__ void unit(LAS char* lds, const bf16_t* __restrict__ Qh, const bf16_t* __restrict__ Kh, const bf16_t* __restrict__ Vh, const unsigned* __restrict__ selh,
                                     const float* __restrict__ bth, bf16_t* Oq, int qb, int tid, const ConvJob& J, ConvState& CS) {
    const int wid = __builtin_amdgcn_readfirstlane(tid >> 6), lane = tid & 63, r32 = lane & 31, hi = lane >> 5;
    LAS char* V_lds = lds + OFF_V; LAS char* K_lds = lds + OFF_K;
    LAS float* wsl = (LAS float*)(lds + OFF_WS) + wid * 64; LAS float* li_l = wsl; LAS float* al_l = wsl + 32;
    LAS float* tb = (LAS float*)(lds + OFF_TB); const unsigned cvs_b = (unsigned)(size_t)(lds + OFF_CV) + (unsigned)wid * 8448u;
    const int NT = 4 * (qb + 1);
    const int qlo = qb * 256 + wid * 32, qpos = qlo + r32;
    const int sr = tid >> 4, sc = (tid & 15) * 8, vst0 = v_st(sr, sc), vst1 = v_st(32 + sr, sc), kws = KSWZ(sr, sc * 2);
    const int vb0 = (int)(unsigned)(size_t)V_lds + v_rd_base(lane);
    for (int i = tid; i < BIAS_W; i += 512) tb[i] = bth[i];
    bf16x8 qr[8];
#pragma unroll
    for (int d0 = 0; d0 < 8; ++d0) qr[d0] = *(const bf16x8*)((const char*)Qh + ((unsigned)(qpos * HD + hi * 8) * 2u + (unsigned)d0 * 32u));
    const unsigned selm = selh[qpos];
    const float cfar = bth[BIAS_W - 1];
    bf16x8 st_v0, st_v1, st_k0, st_k1;
    const unsigned so0 = (unsigned)(sr * HD + sc) * 2u, so1 = so0 + 32u * HD * 2u;
#define SLOAD(k0) do { const char* vb_ = (const char*)Vh + (size_t)(k0) * (HD * 2); const char* kb_ = (const char*)Kh + (size_t)(k0) * (HD * 2); \
                       st_v0 = *(const bf16x8*)(vb_ + so0); st_v1 = *(const bf16x8*)(vb_ + so1); st_k0 = *(const bf16x8*)(kb_ + so0); st_k1 = *(const bf16x8*)(kb_ + so1); } while (0)
#define SWRITE(bf) do { *(LAS bf16x8*)(V_lds + (bf) * SHM_V + vst0) = st_v0; *(LAS bf16x8*)(V_lds + (bf) * SHM_V + vst1) = st_v1; \
                        *(LAS bf16x8*)(K_lds + (bf) * SHM_K + kws) = st_k0; *(LAS bf16x8*)(K_lds + (bf) * SHM_K + kws + 32 * 256) = st_k1; } while (0)
    SLOAD(0); SWRITE(0);
    __syncthreads();
    float m_reg = -1e30f, l_reg = 0.f; f32x16 o[4];
#pragma unroll
    for (int d = 0; d < 4; ++d)
#pragma unroll
        for (int r = 0; r < 16; ++r) o[d][r] = 0.f;
    const float NEG = -__builtin_inff();
#define TILE(t, BUF) do { \
        const int kbase = (t) * 64, jb = (t) >> 2; \
        if ((t) + 1 < NT) SLOAD(kbase + 64); \
        const bool own = (jb == qb); \
        if (!own || kbase <= qlo + 31) { \
            f32x16 p0, p1; \
            qkt<BUF>(p0, p1, K_lds, r32, hi, qr); \
            float addc; \
            if (jb + 1 >= qb) { \
                int bi = qpos - kbase + 1; bi = bi < 0 ? 0 : bi; \
                LAS const float* tp = tb + bi - 4 * hi; \
                _Pragma("unroll") for (int r = 0; r < 8; ++r) { const int c0 = (r & 3) + 8 * (r >> 2); p0[r] += tp[63 - c0]; p1[r] += tp[31 - c0]; } \
                asm volatile("" ::: "memory"); \
                _Pragma("unroll") for (int r = 8; r < 16; ++r) { const int c0 = (r & 3) + 8 * (r >> 2); p0[r] += tp[63 - c0]; p1[r] += tp[31 - c0]; } \
                if (own) { addc = 0.f; \
                    if (kbase + 63 > qlo) { const int dq = qpos - kbase - 4 * hi; \
                        _Pragma("unroll") for (int r = 0; r < 16; ++r) { const int c0 = (r & 3) + 8 * (r >> 2); if (dq - c0 < 0) p0[r] = NEG; if (dq - c0 - 32 < 0) p1[r] = NEG; } } } \
                else addc = ((selm >> jb) & 1u) ? 0.f : NEG; \
            } else addc = ((selm >> jb) & 1u) ? cfar : NEG; \
            float pmax = p0[0]; \
            _Pragma("unroll") for (int r = 1; r < 16; ++r) pmax = fmaxf(pmax, p0[r]); \
            _Pragma("unroll") for (int r = 0; r < 16; ++r) pmax = fmaxf(pmax, p1[r]); \
            { auto rr = __builtin_amdgcn_permlane32_swap(__float_as_uint(pmax), __float_as_uint(pmax), false, false); pmax = fmaxf(__uint_as_float(rr[0]), __uint_as_float(rr[1])); } \
            pmax += addc; \
            float mn, alpha; \
            if (__all(pmax - m_reg <= THR_L2)) { mn = m_reg; alpha = 1.f; } \
            else { mn = fmaxf(m_reg, pmax); alpha = __builtin_amdgcn_exp2f(m_reg - mn); m_reg = mn; } \
            const float offc = addc - mn; \
            _Pragma("unroll") for (int r = 0; r < 16; ++r) { p0[r] = __builtin_amdgcn_exp2f(p0[r] + offc); p1[r] = __builtin_amdgcn_exp2f(p1[r] + offc); } \
            float ps = 0.f; \
            _Pragma("unroll") for (int r = 0; r < 16; ++r) ps += p0[r]; \
            _Pragma("unroll") for (int r = 0; r < 16; ++r) ps += p1[r]; \
            { auto rr = __builtin_amdgcn_permlane32_swap(__float_as_uint(ps), __float_as_uint(ps), false, false); ps = __uint_as_float(rr[0]) + __uint_as_float(rr[1]); } \
            l_reg = l_reg * alpha + ps; \
            bf16x8 pa0, pa1, pa2, pa3; \
            PK4(p0, 0, pa0); PK4(p0, 8, pa1); PK4(p1, 0, pa2); PK4(p1, 8, pa3); \
            if (__any(alpha < 1.f)) { if (hi == 0) al_l[r32] = alpha; asm volatile("s_waitcnt lgkmcnt(0)" ::: "memory"); \
                _Pragma("unroll") for (int d_ = 0; d_ < 4; ++d_) _Pragma("unroll") for (int r = 0; r < 16; ++r) o[d_][r] *= al_l[crow(r, hi)]; } \
            pv_tile<BUF>(o, vb0, pa0, pa1, pa2, pa3); \
        } \
        if ((t) + 1 < NT) { asm volatile("s_waitcnt vmcnt(0)" ::: "memory"); SWRITE((BUF) ^ 1); } \
        conv_consume(CS, cvs_b, lane); conv_issue(J, CS, cvs_b, lane); \
        __syncthreads(); } while (0)
#define PK4(P, B_, OUT) do { const unsigned a0 = cvt_pk_bf16(P[B_ + 0], P[B_ + 1]), a1 = cvt_pk_bf16(P[B_ + 2], P[B_ + 3]), b0 = cvt_pk_bf16(P[B_ + 4], P[B_ + 5]), b1 = cvt_pk_bf16(P[B_ + 6], P[B_ + 7]); \
        auto r0 = __builtin_amdgcn_permlane32_swap(a0, b0, false, false); auto r1 = __builtin_amdgcn_permlane32_swap(a1, b1, false, false); \
        u32x4 w_ = {r0[0], r1[0], r0[1], r1[1]}; OUT = *reinterpret_cast<bf16x8*>(&w_); } while (0)
    for (int t = 0; t < NT; t += 2) { TILE(t, 0); TILE(t + 1, 1); }
#undef TILE
#undef PK4
#undef SLOAD
#undef SWRITE
    if (hi == 0) li_l[r32] = l_reg;
    asm volatile("s_waitcnt lgkmcnt(0)" ::: "memory");
    const unsigned ob = (unsigned)((wid * 32 + 4 * hi) * D + r32);
#pragma unroll
    for (int r = 0; r < 16; ++r) { const int orow = crow(r, hi); const float rl = __builtin_amdgcn_rcpf(li_l[orow]) * OS8;
#pragma unroll
        for (int d0 = 0; d0 < 4; ++d0) { const float v = o[d0][r] * rl; const float vn = __shfl_xor(v, 1);
            int p = __builtin_amdgcn_cvt_pk_fp8_f32(v, vn, 0, false); const int pn = __shfl_xor(p, 2);
            if ((r32 & 3) == 0) *(unsigned*)((unsigned char*)Oq + (ob + (unsigned)(((r & 3) + 8 * (r >> 2)) * D + d0 * 32))) = ((unsigned)p & 0xffffu) | ((unsigned)pn << 16); } }
    __syncthreads();
}
#undef KSWZ
}
__device__ __forceinline__ void ph_attn(const Ctx& c, const float* wg, const float* wu, const float* wd, int Lb) {
    const bf16_t* Qb = (const bf16_t*)(c.ws + WS_Q); const bf16_t* Kb = (const bf16_t*)(c.ws + WS_K); const bf16_t* Vb = (const bf16_t*)(c.ws + WS_V);
    const unsigned* sel = (const unsigned*)(c.ws + WS_SEL); const float* bt = (const float*)(c.ws + WS_BIAS); bf16_t* O = (bf16_t*)(c.ws + WS_O);
    const ConvJob J{wg, wu, wd, (unsigned char*)(c.ws + WS_WGU), (unsigned char*)(c.ws + WS_WD), Lb, c.G * 8};
    ConvState CS{c.vcu * 8 + c.wave, 0, false, nullptr, 0.f};
    for (int u = c.vcu; u < NB * NH * (NBLK / 2); u += c.G) {
        const int bh = u / (NBLK / 2), pi = u % (NBLK / 2), b = bh / NH, h = bh % NH;
#pragma unroll 1
        for (int pass = 0; pass < 2; ++pass) { const int qb = pass == 0 ? NBLK - 1 - pi : pi;
            att::unit((LAS char*)c.lds, Qb + (size_t)bh * T * HD, Kb + (size_t)bh * T * HD, Vb + (size_t)bh * T * HD, sel + (size_t)bh * T, bt + h * BIAS_W,
                      (bf16_t*)((unsigned char*)O + ((size_t)(b * T + qb * 256)) * D + h * HD), qb, c.tid, J, CS); }
    }
    { const unsigned cvs_b = (unsigned)(size_t)(c.lds + att::OFF_CV) + (unsigned)c.wave * 8448u;
      while (CS.pend || CS.cj < CONV_ITEMS) { conv_consume(CS, cvs_b, c.lane); conv_issue(J, CS, cvs_b, c.lane); } }
}
#endif

__device__ __forceinline__ void ph_conv(const Ctx& c, const float* cw, const float* cb) {
    const bf16_t* R = (const bf16_t*)(c.ws + WS_R); bf16_t* RC = (bf16_t*)(c.ws + WS_RC);
    for (int i = c.vcu * 512 + c.tid; i < NTOK * (D / 8); i += c.G * 512) {
        const int n = i >> 7, c8 = (i & 127) * 8, t = n & (T - 1);
        float a[8];
#pragma unroll
        for (int j = 0; j < 8; ++j) a[j] = cb[c8 + j];
#pragma unroll
        for (int k = 0; k < 4; ++k) { const int tt = t - 3 + k; if (tt < 0) continue;
            const u32x4 w = *(const u32x4*)(R + (size_t)(n - 3 + k) * D + c8); const f32x4 w0 = *(const f32x4*)(cw + k * D + c8), w1 = *(const f32x4*)(cw + k * D + c8 + 4);
            a[0] += w0[0] * bf_lo(w.x); a[1] += w0[1] * bf_hi(w.x); a[2] += w0[2] * bf_lo(w.y); a[3] += w0[3] * bf_hi(w.y);
            a[4] += w1[0] * bf_lo(w.z); a[5] += w1[1] * bf_hi(w.z); a[6] += w1[2] * bf_lo(w.w); a[7] += w1[3] * bf_hi(w.w); }
        u32x4 o; o.x = cvt_pk_bf16(a[0], a[1]); o.y = cvt_pk_bf16(a[2], a[3]); o.z = cvt_pk_bf16(a[4], a[5]); o.w = cvt_pk_bf16(a[6], a[7]);
        *(u32x4*)(RC + (size_t)n * D + c8) = o;
    }
}
__device__ __forceinline__ void ph_scan(const Ctx& c) {
    const float* Aa = (const float*)(c.ws + WS_AA); const float* Uu = (const float*)(c.ws + WS_UU); const bf16_t* Y = (const bf16_t*)(c.ws + WS_YBR); bf16_t* Gq = (bf16_t*)(c.ws + WS_G);
    LAS float* cA = (LAS float*)c.lds; LAS float* cH = cA + 512;
    for (int u = c.vcu; u < NB * (D / 16); u += c.G) {
        const int b = u / (D / 16), cg = u % (D / 16), ch = c.wave * 4 + (c.lane >> 4), col = cg * 16 + (c.lane & 15);
        const size_t base = ((size_t)b * T + ch * 128) * D + col;
        const float* au = Aa + ((((size_t)b * 64 + cg) * T + ch * 128) * 32) + (c.lane & 15);
        float A = 1.f, H = 0.f;
#pragma unroll 1
        for (int s0 = 0; s0 < 128; s0 += 28) {
            float av[28], xv[28];
#pragma unroll
            for (int i = 0; i < 28; ++i) { const int s = s0 + i < 128 ? s0 + i : 127; av[i] = au[s * 32]; xv[i] = au[s * 32 + 16]; }
#pragma unroll
            for (int i = 0; i < 28; ++i) if (s0 + i < 128) { A *= av[i]; H = av[i] * H + xv[i]; } }
        __syncthreads();
        cA[ch * 16 + (c.lane & 15)] = A; cH[ch * 16 + (c.lane & 15)] = H;
        __syncthreads();
        float h = 0.f;
        for (int p = 0; p < ch; ++p) h = cA[p * 16 + (c.lane & 15)] * h + cH[p * 16 + (c.lane & 15)];
#pragma unroll 1
        for (int s0 = 0; s0 < 128; s0 += 16) {
            float av[16], xv[16]; unsigned short yv[16];
#pragma unroll
            for (int i = 0; i < 16; ++i) { const int s = s0 + i; av[i] = au[s * 32]; xv[i] = au[s * 32 + 16]; yv[i] = Y[base + (size_t)s * D]; }
#pragma unroll
            for (int i = 0; i < 16; ++i) { const int s = s0 + i; h = av[i] * h + xv[i]; const float gv = h * __uint_as_float(((unsigned)yv[i]) << 16);
                const int p8 = __builtin_amdgcn_cvt_pk_fp8_f32(gv * GS8, 0.f, 0, false); ((unsigned char*)Gq)[base + (size_t)s * D] = (unsigned char)(p8 & 0xff); } }
    }
}

__device__ __forceinline__ void ln_affine(f32x4 (&v)[4], const float* g, const float* bta, int lane) {
    float s = 0.f;
#pragma unroll
    for (int j = 0; j < 4; ++j) s += (v[j][0] + v[j][1]) + (v[j][2] + v[j][3]);
    const float mean = wave_sum(s) * (1.0f / D); float s2 = 0.f;
#pragma unroll
    for (int j = 0; j < 4; ++j) { v[j] = v[j] - mean; s2 += (v[j][0] * v[j][0] + v[j][1] * v[j][1]) + (v[j][2] * v[j][2] + v[j][3] * v[j][3]); }
    const float rstd = 1.0f / sqrtf(wave_sum(s2) * (1.0f / D) + LN_EPS);
#pragma unroll
    for (int j = 0; j < 4; ++j) { const f32x4 gg = *(const f32x4*)(g + 4 * lane + 256 * j), bb = *(const f32x4*)(bta + 4 * lane + 256 * j); v[j] = v[j] * rstd * gg + bb; }
}
__device__ __forceinline__ void store_row(const f32x4 (&v)[4], float* xf, bf16_t* xb, int lane) {
#pragma unroll
    for (int j = 0; j < 4; ++j) { *(f32x4*)(xf + 4 * lane + 256 * j) = v[j]; u32x2 w; w.x = cvt_pk_bf16(v[j][0], v[j][1]); w.y = cvt_pk_bf16(v[j][2], v[j][3]); *(u32x2*)(xb + 4 * lane + 256 * j) = w; }
}

#ifndef LNR_R
#define LNR_R 2
#endif
__device__ __forceinline__ void ph_lnr(const Ctx& c, int layer, const float* g, const float* bta, const float* wr, const float* br) {
    const bf16_t* Z = (const bf16_t*)(c.ws + WS_Z); bf16_t* XB = (bf16_t*)(c.ws + WS_XB); unsigned char* XB8 = (unsigned char*)(c.ws + WS_XB8);
    int* tope = (int*)(c.ws + WS_TOPE); int* tops = (int*)(c.ws + WS_TOPS); float* topg = (float*)(c.ws + WS_TOPG);
    int* list = (int*)(c.ws + WS_LIST) + (size_t)layer * NE * NTOK; unsigned* cntw = (unsigned*)(c.ws + WS_CTL) + CW_CNT + layer * 64;
    LAS float* wl = (LAS float*)c.lds;
    LAS int* be = (LAS int*)(c.lds + LNR_OFF); LAS int* brk = be + 256; LAS int* bbase = brk + 256; LAS int* bcnt = bbase + 32;
    const int lane = c.lane;
    __syncthreads();
    for (int idx = c.tid; idx < D * 8; idx += 512) { const int d = idx >> 3, e4 = idx & 7; const int slot = ((d & 255) >> 2) + 64 * ((d >> 8) * 4 + (d & 3));
        *(LAS f32x4*)(wl + slot * 36 + e4 * 4) = *(const f32x4*)(wr + d * NE + e4 * 4); }
    __syncthreads();
    for (int tile = c.vcu; tile < NTOK / 64; tile += c.G) {
#pragma unroll 1
        for (int grp = 0; grp < 8 / LNR_R; ++grp) {
            const int rit0 = c.wave * 8 + grp * LNR_R, n0 = tile * 64 + rit0;
            f32x4 v[LNR_R][4];
#pragma unroll
            for (int r = 0; r < LNR_R; ++r)
#pragma unroll
                for (int j = 0; j < 4; ++j) { const u32x2 zw = *(const u32x2*)(Z + (size_t)(n0 + r) * D + 4 * lane + 256 * j); v[r][j] = (f32x4){bf_lo(zw.x), bf_hi(zw.x), bf_lo(zw.y), bf_hi(zw.y)}; }
#pragma unroll
            for (int r = 0; r < LNR_R; ++r) { ln_affine(v[r], g, bta, lane);
#pragma unroll
                for (int j = 0; j < 4; ++j) { { u32x2 wb; wb.x = cvt_pk_bf16(v[r][j][0], v[r][j][1]); wb.y = cvt_pk_bf16(v[r][j][2], v[r][j][3]); *(u32x2*)(XB + (size_t)(n0 + r) * D + 4 * lane + 256 * j) = wb; }
                    int w = 0; w = __builtin_amdgcn_cvt_pk_fp8_f32(v[r][j][0] * XS8, v[r][j][1] * XS8, w, false); w = __builtin_amdgcn_cvt_pk_fp8_f32(v[r][j][2] * XS8, v[r][j][3] * XS8, w, true);
                    *(int*)(XB8 + (size_t)(n0 + r) * D + 4 * lane + 256 * j) = w; } }
            float acc[LNR_R][32];
#pragma unroll
            for (int r = 0; r < LNR_R; ++r)
#pragma unroll
                for (int e = 0; e < 32; ++e) acc[r][e] = 0.f;
#pragma unroll 1
            for (int j = 0; j < 4; ++j) {
                f32x4 xj[LNR_R];
#pragma unroll
                for (int r = 0; r < LNR_R; ++r) xj[r] = j == 0 ? v[r][0] : (j == 1 ? v[r][1] : (j == 2 ? v[r][2] : v[r][3]));
#pragma unroll
                for (int q = 0; q < 4; ++q) { const LAS f32x4* wp = (const LAS f32x4*)(wl + (lane + 64 * (4 * j + q)) * 36);
#pragma unroll
                    for (int e4 = 0; e4 < 8; ++e4) { const f32x4 w = wp[e4];
#pragma unroll
                        for (int r = 0; r < LNR_R; ++r) { const float xv = xj[r][q]; acc[r][4 * e4] += xv * w[0]; acc[r][4 * e4 + 1] += xv * w[1]; acc[r][4 * e4 + 2] += xv * w[2]; acc[r][4 * e4 + 3] += xv * w[3]; } } } }
            const float brv = br[lane & 31];
#pragma unroll
            for (int r = 0; r < LNR_R; ++r) {
                float a1[16], a2[8], a3[4], a4[2], a5;
#pragma unroll
                for (int k = 0; k < 16; ++k) { const bool hi = lane & 1; const float keep = hi ? acc[r][2 * k + 1] : acc[r][2 * k], send = hi ? acc[r][2 * k] : acc[r][2 * k + 1]; a1[k] = keep + __shfl_xor(send, 1); }
#pragma unroll
                for (int k = 0; k < 8; ++k) { const bool hi = lane & 2; const float keep = hi ? a1[2 * k + 1] : a1[2 * k], send = hi ? a1[2 * k] : a1[2 * k + 1]; a2[k] = keep + __shfl_xor(send, 2); }
#pragma unroll
                for (int k = 0; k < 4; ++k) { const bool hi = lane & 4; const float keep = hi ? a2[2 * k + 1] : a2[2 * k], send = hi ? a2[2 * k] : a2[2 * k + 1]; a3[k] = keep + __shfl_xor(send, 4); }
#pragma unroll
                for (int k = 0; k < 2; ++k) { const bool hi = lane & 8; const float keep = hi ? a3[2 * k + 1] : a3[2 * k], send = hi ? a3[2 * k] : a3[2 * k + 1]; a4[k] = keep + __shfl_xor(send, 8); }
                { const bool hi = lane & 16; const float keep = hi ? a4[1] : a4[0], send = hi ? a4[0] : a4[1]; a5 = keep + __shfl_xor(send, 16); }
                float val = a5 + __shfl_xor(a5, 32) + brv;
                float tv[4]; int te[4];
#pragma unroll
                for (int k = 0; k < 4; ++k) { const float m = wave_max(val); const unsigned long long bal = __ballot(val == m); const int idx = __ffsll((long long)bal) - 1; tv[k] = m; te[k] = idx & 31; if ((lane & 31) == (idx & 31)) val = -__builtin_inff(); }
                const float e1 = __expf(tv[1] - tv[0]), e2 = __expf(tv[2] - tv[0]), e3 = __expf(tv[3] - tv[0]), inv = 1.0f / (1.0f + e1 + e2 + e3);
                if (lane == 0) { const int rit = rit0 + r; be[rit * 4 + 0] = te[0]; be[rit * 4 + 1] = te[1]; be[rit * 4 + 2] = te[2]; be[rit * 4 + 3] = te[3];
                    *(f32x4*)(topg + (size_t)(n0 + r) * 4) = (f32x4){inv, e1 * inv, e2 * inv, e3 * inv}; }
            }
        }
        __syncthreads();
        if (c.tid < NE) bcnt[c.tid] = 0;
        __syncthreads();
        int myrank = 0;
        if (c.tid < 256) { const int e = be[c.tid]; typedef int i32x4v __attribute__((ext_vector_type(4)));
#pragma unroll 2
            for (int j4 = 0; j4 < 64; ++j4) { const i32x4v w = *(const LAS i32x4v*)(be + 4 * j4); const int jb = 4 * j4;
                myrank += (w[0] == e && jb + 0 < c.tid) + (w[1] == e && jb + 1 < c.tid) + (w[2] == e && jb + 2 < c.tid) + (w[3] == e && jb + 3 < c.tid); }
            atomicAdd((int*)(bcnt + e), 1); }
        __syncthreads();
        if (c.tid < NE) { const int cnt = bcnt[c.tid]; bbase[c.tid] = cnt ? (int)__hip_atomic_fetch_add(cntw + c.tid, (unsigned)cnt, RLX_AGENT) : 0; }
        __syncthreads();
        if (c.tid < 256) { const int e = be[c.tid], slot = bbase[e] + myrank, n = tile * 64 + (c.tid >> 2);
            list[(size_t)e * NTOK + slot] = n; tope[(size_t)n * 4 + (c.tid & 3)] = e; tops[(size_t)n * 4 + (c.tid & 3)] = slot; }
        __syncthreads();
    }
}

__device__ __forceinline__ void ph_comb(const Ctx& c, int layer, float* xout, const float* g, const float* bta) {
    bf16_t* XB = (bf16_t*)(c.ws + WS_XB); const bf16_t* YB = (const bf16_t*)(c.ws + WS_YB);
    const int* tope = (const int*)(c.ws + WS_TOPE); const int* tops = (const int*)(c.ws + WS_TOPS); const float* topg = (const float*)(c.ws + WS_TOPG);
    (void)moe_tables(c.lds, (const unsigned*)(c.ws + WS_CTL) + CW_CNT + layer * 64, c.tid);
    const int gw = c.vcu * 8 + c.wave, NGW = c.G * 8, lane = c.lane;
    for (int n0 = gw * 8; n0 < NTOK; n0 += NGW * 8) {
        const int ie = tope[(size_t)n0 * 4 + (lane & 31)], is = tops[(size_t)n0 * 4 + (lane & 31)]; const float ig = topg[(size_t)n0 * 4 + (lane & 31)];
        const int rowv = (MOE_MTBASE(c.lds)[ie] << 8) + is;
#pragma unroll 1
        for (int grp = 0; grp < 2; ++grp) {
            u32x2 xw[4][4], yw[4][4][4]; float gt[4][4];
#pragma unroll
            for (int r = 0; r < 4; ++r) { const int n = n0 + grp * 4 + r;
#pragma unroll
                for (int j = 0; j < 4; ++j) xw[r][j] = *(const u32x2*)(XB + (size_t)n * D + 4 * lane + 256 * j);
#pragma unroll
                for (int k = 0; k < 4; ++k) { const int row = __builtin_amdgcn_readfirstlane(__shfl(rowv, grp * 16 + r * 4 + k)); gt[r][k] = __shfl(ig, grp * 16 + r * 4 + k);
#pragma unroll
                    for (int j = 0; j < 4; ++j) yw[r][k][j] = *(const u32x2*)(YB + (size_t)row * D + 4 * lane + 256 * j); } }
#pragma unroll
            for (int r = 0; r < 4; ++r) { const int n = n0 + grp * 4 + r;
                f32x4 v[4];
#pragma unroll
                for (int j = 0; j < 4; ++j) { v[j] = (f32x4){bf_lo(xw[r][j].x), bf_hi(xw[r][j].x), bf_lo(xw[r][j].y), bf_hi(xw[r][j].y)} * ALPHA;
#pragma unroll
                    for (int k = 0; k < 4; ++k) { const u32x2 w = yw[r][k][j]; const float g_ = gt[r][k]; v[j][0] += g_ * bf_lo(w.x); v[j][1] += g_ * bf_hi(w.x); v[j][2] += g_ * bf_lo(w.y); v[j][3] += g_ * bf_hi(w.y); } }
                ln_affine(v, g, bta, lane);
                if (xout) {
#pragma unroll
                    for (int j = 0; j < 4; ++j) *(f32x4*)(xout + (size_t)n * D + 4 * lane + 256 * j) = v[j]; }
                else {
#pragma unroll
                    for (int j = 0; j < 4; ++j) { u32x2 w; w.x = cvt_pk_bf16(v[j][0], v[j][1]); w.y = cvt_pk_bf16(v[j][2], v[j][3]); *(u32x2*)(XB + (size_t)n * D + 4 * lane + 256 * j) = w;
                        int w8 = 0; w8 = __builtin_amdgcn_cvt_pk_fp8_f32(v[j][0] * XS8, v[j][1] * XS8, w8, false); w8 = __builtin_amdgcn_cvt_pk_fp8_f32(v[j][2] * XS8, v[j][3] * XS8, w8, true);
                        *(int*)((unsigned char*)(c.ws + WS_XB8) + (size_t)n * D + 4 * lane + 256 * j) = w8; } }
            }
        }
    }
}

constexpr int PH_PER_LAYER = 9, N_PHASES = 1 + DEPTH * PH_PER_LAYER;

__global__ void __launch_bounds__(512, 2) mk_fwd(Args args) {
    extern __shared__ __attribute__((aligned(16))) unsigned char lds_raw[];
    Ctx c0;
    c0.ws = args.ws; c0.lds = (LAS unsigned char*)lds_raw;
    c0.tid = threadIdx.x; c0.lane = c0.tid & 63; c0.wave = __builtin_amdgcn_readfirstlane(c0.tid >> 6);
    c0.G = gridDim.x; c0.bx = blockIdx.x; { const int bx = blockIdx.x; c0.vcu = (c0.G % 8 == 0) ? (bx % 8) * (c0.G / 8) + bx / 8 : bx; }
    volatile LAS unsigned* MISC = (volatile LAS unsigned*)(c0.lds + MISC_OFF);
    if (c0.tid < 64) MISC[c0.tid] = 0u;
    __syncthreads();
    unsigned* ctl = (unsigned*)(c0.ws + WS_CTL);
#if MK_PER_PHASE
#define GRID_BAR() do { } while (0)
#else
    XcdBarrier bar = xcd_barrier_post(ctl + CW_BAR, MISC + 8);
#define GRID_BAR() xcd_barrier(bar)
#endif
    const int lo = args.ph_lo, hi = args.ph_hi;
#ifndef PMASK
#define PMASK 0xFFFF
#endif
#define EN(b) ((PMASK >> (b)) & 1)
#ifndef REPMASK
#define REPMASK 0
#endif
#define REPS(b) (1 + ((REPMASK >> (b)) & 1))
#define IN(k) (lo <= (k) && (k) < hi)
#ifndef PROBE_PH
#define PROBE_PH -1
#endif
#ifndef PROBE_MODE
#define PROBE_MODE 2
#endif
    unsigned long long pr_t0 = 0, pr_t1 = 0, pr_c0 = 0, pr_c1 = 0;
#define SEAM(k) do { if (IN(k) && IN((k) + 1)) GRID_BAR(); \
        if (PROBE_PH >= 0 && (k) == PROBE_PH - 1) { pr_t0 = __builtin_amdgcn_s_memrealtime(); pr_c0 = (unsigned long long)clock64(); } \
        if (PROBE_PH >= 0 && (k) == PROBE_PH) { pr_t1 = __builtin_amdgcn_s_memrealtime(); pr_c1 = (unsigned long long)clock64(); } } while (0)
#define INP(i) (args.in[opaque_i(i)] + (size_t)(unsigned)opaque_i(0))
#define WSP() Ctx c = c0; c.ws = c0.ws + (size_t)(unsigned)opaque_i(0); c.wave = opaque_i(c0.wave); c.lane = lane_id_asm(); c.tid = c.wave * 64 + c.lane; c.G = opaque_i(c0.G); c.vcu = opaque_i(c0.vcu); c.bx = opaque_i(c0.bx); unsigned char* ws = c.ws

    if (EN(15) && IN(0)) for (int rep_ = 0; rep_ < REPS(15); ++rep_) { WSP(); (void)ws; ph_prologue(c, args); } SEAM(0);

#define LAYER(L_) do { \
        constexpr int L = L_; constexpr int p0 = 1 + L * PH_PER_LAYER, jm = L >> 1; \
        if constexpr ((L & 1) == 0) { \
            if (EN(0) && IN(p0 + 0)) for (int rep_ = 0; rep_ < REPS(0); ++rep_) { WSP(); SchedDense S; S.o.init(NTOK, 3 * D, c.G, c.bx); S.lda = D; S.kb = D; \
                const pg8::Gemm g{(const char*)(ws + WS_XB8), (const char*)(ws + WS_WQKV) + (size_t)jm * 3 * D * D, nullptr, D, opaque_i(D)}; \
                EpiQKV E{(bf16_t*)(ws + WS_Q)}; \
                pg8::gemm_phase<EpiQKV, SchedDense, false, true>(c.lds, g, S, E, c.tid); } SEAM(p0 + 0); \
            if (EN(1) && IN(p0 + 1)) for (int rep_ = 0; rep_ < REPS(1); ++rep_) { WSP(); (void)ws; ph_kmean(c); } SEAM(p0 + 1); \
            if (EN(2) && IN(p0 + 2)) for (int rep_ = 0; rep_ < REPS(2); ++rep_) { WSP(); (void)ws; ph_select(c); } SEAM(p0 + 2); \
            if (EN(3) && IN(p0 + 3)) for (int rep_ = 0; rep_ < REPS(3); ++rep_) { WSP(); (void)ws; ph_attn(c, INP(15), INP(17), INP(19), L); } SEAM(p0 + 3); \
            if (EN(4) && IN(p0 + 4)) for (int rep_ = 0; rep_ < REPS(4); ++rep_) { WSP(); SchedDense S; S.o.init(NTOK, D, c.G, c.bx); S.lda = D; S.kb = D; \
                const pg8::Gemm g{(const char*)(ws + WS_O), (const char*)(ws + WS_WO) + (size_t)jm * D * D, nullptr, D, opaque_i(D)}; \
                EpiResid E{(const bf16_t*)(ws + WS_XB), (bf16_t*)(ws + WS_Z), 1.0f / (OS8 * WS8_O)}; \
                pg8::gemm_phase<EpiResid, SchedDense, false, true>(c.lds, g, S, E, c.tid); } SEAM(p0 + 4); \
        } else { \
            if (EN(5) && IN(p0 + 0)) for (int rep_ = 0; rep_ < REPS(5); ++rep_) { WSP(); SchedDense S; S.o.init(NTOK, 2 * D, c.G, c.bx); S.lda = D; S.kb = D; \
                const pg8::Gemm g{(const char*)(ws + WS_XB8), (const char*)(ws + WS_WIN) + (size_t)jm * 2 * D * D, nullptr, D, opaque_i(D)}; \
                EpiLin E{(bf16_t*)(ws + WS_YBR), (bf16_t*)(ws + WS_R)}; \
                pg8::gemm_phase<EpiLin, SchedDense, false, true>(c.lds, g, S, E, c.tid); } SEAM(p0 + 0); \
            if (EN(6) && IN(p0 + 1)) for (int rep_ = 0; rep_ < REPS(6); ++rep_) { WSP(); (void)ws; ph_conv(c, INP(5) + (size_t)jm * 4 * D, INP(6) + (size_t)jm * D); } SEAM(p0 + 1); \
            if (EN(7) && IN(p0 + 2)) for (int rep_ = 0; rep_ < REPS(7); ++rep_) { WSP(); SchedGates S; S.o.init(NTOK, 2 * D, c.G, c.bx); \
                const pg8::Gemm g{(const char*)(ws + WS_RC), (const char*)(ws + WS_WG) + (size_t)jm * 4 * 512 * 256 * 2, nullptr, D * 2, opaque_i(512)}; \
                EpiGates E{(const bf16_t*)(ws + WS_RC), INP(8) + (size_t)jm * D, INP(10) + (size_t)jm * D, (const float*)(ws + WS_SPT) + (size_t)jm * D, (float*)(ws + WS_AA), (float*)(ws + WS_UU)}; \
                pg8::gemm_phase<EpiGates, SchedGates, false>(c.lds, g, S, E, c.tid); } SEAM(p0 + 2); \
            if (EN(8) && IN(p0 + 3)) for (int rep_ = 0; rep_ < REPS(8); ++rep_) { WSP(); (void)ws; ph_scan(c); } SEAM(p0 + 3); \
            if (EN(9) && IN(p0 + 4)) for (int rep_ = 0; rep_ < REPS(9); ++rep_) { WSP(); SchedDense S; S.o.init(NTOK, D, c.G, c.bx); S.lda = D; S.kb = D; \
                const pg8::Gemm g{(const char*)(ws + WS_G), (const char*)(ws + WS_WOUT) + (size_t)jm * D * D, nullptr, D, opaque_i(D)}; \
                EpiResid E{(const bf16_t*)(ws + WS_XB), (bf16_t*)(ws + WS_Z), 1.0f / (GS8 * WS8_OUT)}; \
                pg8::gemm_phase<EpiResid, SchedDense, false, true>(c.lds, g, S, E, c.tid); } SEAM(p0 + 4); \
        } \
        if (EN(10) && IN(p0 + 5)) for (int rep_ = 0; rep_ < REPS(10); ++rep_) { WSP(); (void)ws; ph_lnr(c, L, INP(21) + L * D, INP(22) + L * D, INP(13) + (size_t)L * D * NE, INP(14) + L * NE); } SEAM(p0 + 5); \
        if (EN(11) && IN(p0 + 6)) for (int rep_ = 0; rep_ < REPS(11); ++rep_) { WSP(); const int total = moe_tables(c.lds, (unsigned*)(ws + WS_CTL) + CW_CNT + L * 64, c.tid); \
            SchedMoe S{c.lds, total, 8, c.G, c.vcu, (unsigned)(2 * D * D), (unsigned)D, true}; \
            const pg8::Gemm g{(const char*)(ws + WS_XB8), (const char*)(ws + WS_WGU) + (size_t)L * NE * 2 * D * D, (const int*)(ws + WS_LIST) + (size_t)L * NE * NTOK, D, opaque_i(D)}; \
            EpiSwiglu E{INP(16) + (size_t)L * NE * D, INP(18) + (size_t)L * NE * D, (unsigned char*)(ws + WS_HB)}; \
            pg8::gemm_phase<EpiSwiglu, SchedMoe, true, true>(c.lds, g, S, E, c.tid); } SEAM(p0 + 6); \
        if (EN(12) && IN(p0 + 7)) for (int rep_ = 0; rep_ < REPS(12); ++rep_) { WSP(); const int total = moe_tables(c.lds, (unsigned*)(ws + WS_CTL) + CW_CNT + L * 64, c.tid); \
            SchedMoe S{c.lds, total, 4, c.G, c.vcu, (unsigned)(D * D), (unsigned)D, false}; \
            const pg8::Gemm g{(const char*)(ws + WS_HB), (const char*)(ws + WS_WD) + (size_t)L * NE * D * D, nullptr, D, opaque_i(D)}; \
            EpiPlain E{(bf16_t*)(ws + WS_YB), 1.0f / (HS8 * WS8_D), INP(20) + (size_t)L * NE * D}; \
            pg8::gemm_phase<EpiPlain, SchedMoe, false, true>(c.lds, g, S, E, c.tid); } SEAM(p0 + 7); \
        if (EN(13) && IN(p0 + 8)) for (int rep_ = 0; rep_ < REPS(13); ++rep_) { WSP(); ph_comb(c, L, (L == DEPTH - 1) ? args.out : (float*)nullptr, INP(23) + L * D, INP(24) + L * D); } SEAM(p0 + 8); \
    } while (0)
    LAYER(0); LAYER(1); LAYER(2); LAYER(3);
    if (PROBE_PH >= 0 && c0.bx == 0) { const unsigned long long dt = pr_t1 - pr_t0, dc = pr_c1 - pr_c0; const unsigned long long spin_us = PROBE_MODE == 1 ? (dt ? dc * 100ull / dt : 0ull) : dt * 5ull / 100ull;
        const unsigned long long w0 = __builtin_amdgcn_s_memrealtime(); while (__builtin_amdgcn_s_memrealtime() - w0 < spin_us * 100ull) __builtin_amdgcn_s_sleep(8); }
#undef IN
#undef SEAM
}

extern "C" void kernel_launch(void* const* d_in, const int* in_sizes, int n_in, void* d_out, int out_size, void* d_ws, size_t ws_size, hipStream_t stream) {
    static int grid = 0;
    if (grid == 0) {
        if (n_in != 25 || out_size != NTOK * D || ws_size < WS_END) { fprintf(stderr, "kernel_launch: unexpected shapes (n_in %d out %d ws %zu)\n", n_in, out_size, ws_size); grid = -1; return; }
        int dev = 0, cus = 0;
        if (hipGetDevice(&dev) != hipSuccess || hipDeviceGetAttribute(&cus, hipDeviceAttributeMultiprocessorCount, dev) != hipSuccess) { grid = -1; return; }
        if (hipFuncSetAttribute((const void*)mk_fwd, hipFuncAttributeMaxDynamicSharedMemorySize, LDS_BYTES) != hipSuccess) { fprintf(stderr, "kernel_launch: hipFuncSetAttribute failed\n"); grid = -1; return; }
        int per_cu = 0;
        if (hipOccupancyMaxActiveBlocksPerMultiprocessor(&per_cu, (const void*)mk_fwd, 512, LDS_BYTES) != hipSuccess || per_cu < 1) fprintf(stderr, "kernel_launch: occupancy query says %d\n", per_cu);
        (void)hipGetLastError();
        grid = cus;
    }
    if (grid < 0) return;
    (void)hipMemsetAsync((char*)d_ws + WS_CTL, 0, CTL_BYTES, stream);
    Args a{};
    for (int i = 0; i < 25; ++i) a.in[i] = (const float*)d_in[i];
    a.out = (float*)d_out; a.ws = (unsigned char*)d_ws;
#if MK_PER_PHASE
    for (int p = 0; p < N_PHASES; ++p) {
        const int L = (p - 1) / PH_PER_LAYER, k = (p - 1) % PH_PER_LAYER; (void)L; (void)k;
        a.ph_lo = p; a.ph_hi = p + 1;
        hipLaunchKernelGGL(mk_fwd, dim3(grid), dim3(512), LDS_BYTES, stream, a);
    }
#else
    a.ph_lo = 0; a.ph_hi = N_PHASES;
    hipLaunchKernelGGL(mk_fwd, dim3(grid), dim3(512), LDS_BYTES, stream, a);
#endif
}
```
